# Optimizing an MI355X kernel written in HIP

```python
import jax, jax.numpy as jnp
from jax import lax
import numpy as np

D_MODEL = 2048
BATCH = 4
SEQ = 4096
DEPTH = 1

GRID_W = 64
CTX_LEN = 256
MLA_HEADS = 8
Q_LORA = 512
KV_LORA = 256
NOPE_DIM = 128
ROPE_DIM = 64
V_DIM = 128
QK_DIM = NOPE_DIM + ROPE_DIM
ROPE_THETA = 10000.0
Q_BLOCK = 128
CHUNK = 128
SGU_GROUPS = 8
SGU_WIDTH = 1024
SGU_GROUP_DIM = SGU_WIDTH // SGU_GROUPS
D_FF = ((8 * D_MODEL // 3 + 255) // 256) * 256
N_BRANCH = 2
N_MOD = 6
EPS = 1e-6
OFF_KVC = Q_LORA
OFF_U = OFF_KVC + KV_LORA + ROPE_DIM
OFF_V = OFF_U + SGU_WIDTH
OFF_GATE = OFF_V + SGU_WIDTH
IN_COLS = OFF_GATE + N_BRANCH * D_MODEL

kernel_name = "hybrid_mla_sgu_prefix_dit_block"


def _rms(x, g):
    xf = x.astype(jnp.float32)
    y = xf * lax.rsqrt(jnp.mean(xf * xf, axis=-1, keepdims=True) + EPS)
    return (y * g.astype(jnp.float32)).astype(x.dtype)


def _modulate(h, shift, scale):
    return h * (1 + scale) + shift


def _axial_angles(n):
    rows = n // GRID_W
    row = jnp.repeat(jnp.arange(rows, dtype=jnp.float32), GRID_W)
    col = jnp.tile(jnp.arange(GRID_W, dtype=jnp.float32), rows)
    nf = ROPE_DIM // 4
    freqs = ROPE_THETA ** (-jnp.arange(nf, dtype=jnp.float32) / nf)
    return row[:, None] * freqs[None, :], col[:, None] * freqs[None, :]


def _rotate(t, ang):
    t1, t2 = jnp.split(t, 2, axis=-1)
    cos = jnp.cos(ang)[:, None, :]
    sin = jnp.sin(ang)[:, None, :]
    return jnp.concatenate([t1 * cos - t2 * sin, t2 * cos + t1 * sin], axis=-1)


def _rope_tail(t, ang_r, ang_c):
    nope, rope = t[..., :NOPE_DIM], t[..., NOPE_DIM:].astype(jnp.float32)
    rot = jnp.concatenate([_rotate(rope[..., :ROPE_DIM // 2], ang_r),
                           _rotate(rope[..., ROPE_DIM // 2:], ang_c)], axis=-1)
    return jnp.concatenate([nope, rot.astype(t.dtype)], axis=-1)


def _mla_queries(qc, q_norm_g, w_uq, qk_norm_q):
    q = _rms(qc, q_norm_g) @ w_uq
    q = q.reshape(q.shape[:-1] + (MLA_HEADS, QK_DIM))
    return _rms(q, qk_norm_q)


def _mla_keys_values(kv_in, kv_norm_g, w_ukv, qk_norm_k):
    kvc, k_rope = kv_in[..., :KV_LORA], kv_in[..., KV_LORA:]
    kv = _rms(kvc, kv_norm_g) @ w_ukv
    kv = kv.reshape(kv.shape[:-1] + (MLA_HEADS, NOPE_DIM + V_DIM))
    k_nope, v = kv[..., :NOPE_DIM], kv[..., NOPE_DIM:]
    k_rope = jnp.broadcast_to(k_rope[..., None, :], k_nope.shape[:-1] + (ROPE_DIM,))
    k = _rms(jnp.concatenate([k_nope, k_rope], axis=-1), qk_norm_k)
    return k, v


def _attention(q, k, v):
    b, n = q.shape[0], q.shape[1]
    nblk = n // Q_BLOCK
    qb = q.reshape(b, nblk, Q_BLOCK, MLA_HEADS, QK_DIM).transpose(1, 0, 2, 3, 4)
    scale = QK_DIM ** -0.5

    def one_block(qi):
        s = jnp.einsum('bqhd,bkhd->bhqk', qi, k, preferred_element_type=jnp.float32) * scale
        p = jax.nn.softmax(s, axis=-1)
        o = jnp.einsum('bhqk,bkhd->bqhd', p.astype(v.dtype), v, preferred_element_type=jnp.float32)
        return o.astype(v.dtype)

    o = lax.map(one_block, qb)
    return o.transpose(1, 0, 2, 3, 4).reshape(b, n, MLA_HEADS * V_DIM)


def _sgu(u_in, v_in, norm_g, norm_b, w_s, b_s):
    u = jax.nn.gelu(u_in, approximate=False)
    v = jax.nn.gelu(v_in, approximate=False)
    vf = v.astype(jnp.float32)
    mu = jnp.mean(vf, axis=-1, keepdims=True)
    var = jnp.mean(jnp.square(vf - mu), axis=-1, keepdims=True)
    vn = ((vf - mu) * lax.rsqrt(var + EPS) * norm_g.astype(jnp.float32)
          + norm_b.astype(jnp.float32)).astype(v.dtype)
    b, n = v.shape[0], v.shape[1]
    nc = n // CHUNK
    vs = vn.reshape(b, nc, CHUNK, SGU_GROUPS, SGU_GROUP_DIM)
    mixed = jnp.einsum('gij,bnjgc->bnigc', w_s, vs) + b_s.T[:, :, None]
    out = u.reshape(b, nc, CHUNK, SGU_GROUPS, SGU_GROUP_DIM) * mixed
    return out.reshape(b, n, SGU_WIDTH)


def _merge(attn_o, sgu_o, gate_in, w_br_attn, w_br_sgu, w_out):
    g = jax.nn.sigmoid(gate_in.astype(jnp.float32)).astype(attn_o.dtype)
    merged = g[..., :D_MODEL] * (attn_o @ w_br_attn) + g[..., D_MODEL:] * (sgu_o @ w_br_sgu)
    return merged @ w_out


def _swiglu(h, w_ffn_in, w_ffn_out):
    a, b = jnp.split(h @ w_ffn_in, 2, axis=-1)
    return (jax.nn.silu(a) * b) @ w_ffn_out


def setup_inputs(seed: int = 0) -> dict:
    key = jax.random.key(seed)
    ks = jax.random.split(key, 26)
    f32 = jnp.float32

    def dense(k, shape, fan_in, gain=1.0):
        return jax.random.normal(k, shape, f32) * (gain * fan_in ** -0.5)

    def gain_vec(k, shape):
        return 1.0 + 0.02 * jax.random.normal(k, shape, f32)

    def bias_vec(k, shape):
        return 0.02 * jax.random.normal(k, shape, f32)

    L = DEPTH
    return {
        "x": jax.random.normal(ks[0], (BATCH, SEQ, D_MODEL), f32),
        "c": jax.random.normal(ks[1], (BATCH, D_MODEL), f32),
        "ctx": jax.random.normal(ks[2], (BATCH, CTX_LEN, D_MODEL), f32),
        "c_ctx": jax.random.normal(ks[3], (D_MODEL,), f32),
        "w_mod": dense(ks[4], (L, D_MODEL, N_MOD * D_MODEL), D_MODEL, 0.5),
        "b_mod": bias_vec(ks[5], (L, N_MOD * D_MODEL)),
        "norm1_g": gain_vec(ks[6], (L, D_MODEL)),
        "w_in": dense(ks[7], (L, D_MODEL, IN_COLS), D_MODEL),
        "q_norm_g": gain_vec(ks[8], (L, Q_LORA)),
        "kv_norm_g": gain_vec(ks[9], (L, KV_LORA)),
        "w_uq": dense(ks[10], (L, Q_LORA, MLA_HEADS * QK_DIM), Q_LORA),
        "w_ukv": dense(ks[11], (L, KV_LORA, MLA_HEADS * (NOPE_DIM + V_DIM)), KV_LORA),
        "qk_norm_q": gain_vec(ks[12], (L, QK_DIM)),
        "qk_norm_k": gain_vec(ks[13], (L, QK_DIM)),
        "sgu_norm_g": gain_vec(ks[14], (L, SGU_WIDTH)),
        "sgu_norm_b": bias_vec(ks[15], (L, SGU_WIDTH)),
        "w_spatial": dense(ks[16], (L, SGU_GROUPS, CHUNK, CHUNK), CHUNK),
        "b_spatial": gain_vec(ks[17], (L, SGU_GROUPS, CHUNK)),
        "w_br_attn": dense(ks[18], (L, MLA_HEADS * V_DIM, D_MODEL), MLA_HEADS * V_DIM),
        "w_br_sgu": dense(ks[19], (L, SGU_WIDTH, D_MODEL), SGU_WIDTH),
        "w_out": dense(ks[20], (L, D_MODEL, D_MODEL), D_MODEL),
        "norm2_g": gain_vec(ks[21], (L, D_MODEL)),
        "w_ffn_in": dense(ks[22], (L, D_MODEL, 2 * D_FF), D_MODEL),
        "w_ffn_out": dense(ks[23], (L, D_FF, D_MODEL), D_FF),
    }


def reference(x, c, ctx, c_ctx, w_mod, b_mod, norm1_g, w_in, q_norm_g, kv_norm_g, w_uq,
              w_ukv, qk_norm_q, qk_norm_k, sgu_norm_g, sgu_norm_b, w_spatial, b_spatial,
              w_br_attn, w_br_sgu, w_out, norm2_g, w_ffn_in, w_ffn_out):
    n = x.shape[1]
    ang_r, ang_c = _axial_angles(n)
    silu_c = jax.nn.silu(c)
    silu_cc = jax.nn.silu(c_ctx)
    for l in range(DEPTH):
        mod = silu_c @ w_mod[l] + b_mod[l]
        sh1, sc1, g1, sh2, sc2, g2 = [m[:, None, :] for m in jnp.split(mod, N_MOD, axis=-1)]
        mod_c = silu_cc @ w_mod[l][:, :2 * D_MODEL] + b_mod[l][:2 * D_MODEL]
        sh1c, sc1c = jnp.split(mod_c, 2)
        ctx_h = _modulate(_rms(ctx, norm1_g[l]), sh1c, sc1c)
        k_ctx, v_ctx = _mla_keys_values(ctx_h @ w_in[l][:, OFF_KVC:OFF_U],
                                        kv_norm_g[l], w_ukv[l], qk_norm_k[l])

        h = _modulate(_rms(x, norm1_g[l]), sh1, sc1)
        proj = h @ w_in[l]
        q = _rope_tail(_mla_queries(proj[..., :OFF_KVC], q_norm_g[l], w_uq[l], qk_norm_q[l]),
                       ang_r, ang_c)
        k_lat, v_lat = _mla_keys_values(proj[..., OFF_KVC:OFF_U], kv_norm_g[l], w_ukv[l],
                                        qk_norm_k[l])
        k_lat = _rope_tail(k_lat, ang_r, ang_c)
        attn_o = _attention(q, jnp.concatenate([k_lat, k_ctx], axis=1),
                            jnp.concatenate([v_lat, v_ctx], axis=1))
        sgu_o = _sgu(proj[..., OFF_U:OFF_V], proj[..., OFF_V:OFF_GATE], sgu_norm_g[l],
                     sgu_norm_b[l], w_spatial[l], b_spatial[l])
        x_new = x + g1 * _merge(attn_o, sgu_o, proj[..., OFF_GATE:], w_br_attn[l],
                                w_br_sgu[l], w_out[l])
        h2 = _modulate(_rms(x_new, norm2_g[l]), sh2, sc2)
        x_new = x_new + g2 * _swiglu(h2, w_ffn_in[l], w_ffn_out[l])

        if l + 1 < DEPTH:
            mod_r = silu_cc @ w_mod[l][:, 2 * D_MODEL:] + b_mod[l][2 * D_MODEL:]
            g1c, sh2c, sc2c, g2c = jnp.split(mod_r, 4)
            proj_c = ctx_h @ w_in[l]
            q_c = _mla_queries(proj_c[..., :OFF_KVC], q_norm_g[l], w_uq[l], qk_norm_q[l])
            attn_c = _attention(q_c, k_ctx, v_ctx)
            sgu_c = _sgu(proj_c[..., OFF_U:OFF_V], proj_c[..., OFF_V:OFF_GATE], sgu_norm_g[l],
                         sgu_norm_b[l], w_spatial[l], b_spatial[l])
            ctx = ctx + g1c * _merge(attn_c, sgu_c, proj_c[..., OFF_GATE:], w_br_attn[l],
                                     w_br_sgu[l], w_out[l])
            ctx = ctx + g2c * _swiglu(_modulate(_rms(ctx, norm2_g[l]), sh2c, sc2c),
                                      w_ffn_in[l], w_ffn_out[l])
        x = x_new
    return x
```

```cpp
#include <hip/hip_runtime.h>
#include <hip/hip_cooperative_groups.h>
#include <cstdio>
#include <cstdint>
namespace cg = cooperative_groups;

#ifndef MK_LAUNCH_PER_PHASE
#define MK_LAUNCH_PER_PHASE 1
#endif

#define LAS __attribute__((address_space(3)))
typedef unsigned short bf16_t;
typedef short bf16x8 __attribute__((ext_vector_type(8)));
typedef short s16x4 __attribute__((ext_vector_type(4)));
typedef float f32x2 __attribute__((ext_vector_type(2)));
typedef float f32x4 __attribute__((ext_vector_type(4)));
typedef float f32x16 __attribute__((ext_vector_type(16)));
typedef unsigned u32x2 __attribute__((ext_vector_type(2)));
typedef unsigned u32x4 __attribute__((ext_vector_type(4)));

constexpr int DM = 2048, NB = 4, SEQ = 4096, NTOK = NB * SEQ, CTXL = 256, NCTX = NB * CTXL, MROWS = NTOK + NCTX;
constexpr int NH = 8, QL = 512, KVL = 256, QKD = 192, VD = 128;
constexpr int DFF = 5632, NMOD = 6 * DM;
constexpr int SKV = SEQ + CTXL;
constexpr int PCOLS = 7168;
constexpr int PC_KV = 512, PC_KR = 768, PC_U = 1024, PC_V = 2048, PC_GA = 3072, PC_GS = 5120;
constexpr int IN_COLS = 6976;
constexpr float EPS = 1e-6f;

constexpr size_t MiB = 1u << 20;
constexpr size_t WS_MOD = 0;
constexpr size_t WS_WIN = 1 * MiB;
constexpr size_t WS_WUQ = 29 * MiB;
constexpr size_t WS_WUKV = 31 * MiB;
constexpr size_t WS_WBRA = 32 * MiB;
constexpr size_t WS_WBRS = 36 * MiB;
constexpr size_t WS_WOUT = 40 * MiB;
constexpr size_t WS_WFI = 48 * MiB;
constexpr size_t WS_WFO = 92 * MiB;
constexpr size_t WS_WSP = 114 * MiB;
constexpr size_t WS_H = 116 * MiB;
constexpr size_t WS_P = 184 * MiB;
constexpr size_t WS_KF = 422 * MiB;
constexpr size_t WS_VF = 473 * MiB;
constexpr size_t WS_MERGED = 422 * MiB;
constexpr size_t WS_END = 512 * MiB;
constexpr size_t DO_QF = 48 * MiB;

constexpr int LDS_BYTES = 139264;

__device__ __forceinline__ unsigned f2bf(float f) { unsigned u = __builtin_bit_cast(unsigned, f); return (u + 0x7fffu + ((u >> 16) & 1u)) >> 16; }
__device__ __forceinline__ unsigned pk2(float lo, float hi) { return f2bf(lo) | (f2bf(hi) << 16); }
__device__ __forceinline__ float bf2f(unsigned short b) { return __builtin_bit_cast(float, ((unsigned)b) << 16); }
__device__ __forceinline__ float bflo(unsigned w) { return __builtin_bit_cast(float, w << 16); }
__device__ __forceinline__ float bfhi(unsigned w) { return __builtin_bit_cast(float, w & 0xffff0000u); }
__device__ __forceinline__ float wave_sum(float v) {
#pragma unroll
    for (int o = 1; o < 64; o <<= 1) v += __shfl_xor(v, o);
    return v;
}
#define LDS_WAIT() asm volatile("s_waitcnt lgkmcnt(0)" ::: "memory")

namespace pg8 {
#define PG8_LAS __attribute__((address_space(3)))
constexpr int BM = 256, BK = 64, HALF = 128, HTB = HALF * BK * 2, STAGE_BYTES = 8 * HTB, NXCD = 8, WGM = 8;
__host__ __device__ __forceinline__ int lds_byte(int r, int c) { const int st = (r >> 4) * 2 + (c >> 5), rr = r & 15, cc = c & 31, ob = rr * 64 + cc * 2; return st * 1024 + (ob ^ (((ob >> 9) & 1) << 5)); }
__host__ __device__ __forceinline__ void stage_rc(int b, int& R, int& C) { const int st = b / 1024, sb = b % 1024, swz = sb ^ (((sb >> 9) & 1) << 5); R = (st >> 1) * 16 + swz / 64; C = (st & 1) * 32 + (swz % 64) / 2; }
__host__ __device__ __forceinline__ int perm32(int rho) { const int n = rho >> 4, i = rho & 15; return 8 * (i >> 2) + 4 * n + (i & 3); }

struct Unit { int pm, pn; };
struct Gemm { const bf16_t* A; const bf16_t* Bt; int M, N, K, lda, ldb; };

struct StaticOrder {
    int nM, nN, nwg, G, c;
    __device__ void init(int M, int N, int G_, int c_) { nM = M / BM; nN = N / BM; nwg = nM * nN; G = G_; c = c_; }
    __device__ bool next(int i, Unit& u) const {
        const long L = (long)i * G + c; if (L >= nwg) return false;
        int wgid = (int)L; { const int q = nwg / NXCD, r = nwg % NXCD, xcd = wgid % NXCD, off = wgid / NXCD; wgid = (xcd < r ? xcd * (q + 1) : r * (q + 1) + (xcd - r) * q) + off; }
        const int nig = WGM * nN, gid = wgid / nig, fm = gid * WGM, gsz = (nM - fm) < WGM ? (nM - fm) : WGM;
        u.pm = fm + ((wgid % nig) % gsz); u.pn = (wgid % nig) / gsz; return true;
    }
    __device__ __forceinline__ void a_ready(const Unit&) const {}
    __device__ __forceinline__ void done(const Unit&) const {}
};
struct ProjOrder {
    StaticOrder S; int G, c;
    __device__ void init(int G_, int c_) { S.init(NTOK, PCOLS, G_, c_); G = G_; c = c_; }
    __device__ bool next(int i, Unit& u) const {
        const long L = (long)i * G + c;
        if (L < S.nwg) return S.next(i, u);
        const int j = (int)(L - S.nwg); if (j >= 8) return false;
        u.pm = 64 + (j >> 1); u.pn = 2 + (j & 1); return true;
    }
    __device__ __forceinline__ void a_ready(const Unit&) const {}
    __device__ __forceinline__ void done(const Unit&) const {}
};

__device__ __forceinline__ unsigned cvt_pk_bf16(float lo, float hi) { unsigned r; asm volatile("v_cvt_pk_bf16_f32 %0, %1, %2" : "=v"(r) : "v"(lo), "v"(hi)); return r; }
__device__ __forceinline__ f32x2 gelu_pk(f32x2 v) {
    const f32x2 av = __builtin_elementwise_abs(v), d = av * 0.2316418882f + 1.0f;
    f32x2 t; t.x = __builtin_amdgcn_rcpf(d.x); t.y = __builtin_amdgcn_rcpf(d.y);
    f32x2 q = t * 0.5307027145f + (-0.7265760135f); q = q * t + 0.7107068705f; q = q * t + (-0.142248368f); q = q * t + 0.127414796f; q = q * t;
    const f32x2 s = (v * v) * (-0.72134752044f);
    f32x2 e; e.x = __builtin_amdgcn_exp2f(s.x); e.y = __builtin_amdgcn_exp2f(s.y);
    const f32x2 m = v * (q * e), r = v - m;
    f32x2 o; o.x = v.x < 0.f ? m.x : r.x; o.y = v.y < 0.f ? m.y : r.y; return o;
}
__device__ __forceinline__ float sigm(float x) { return __builtin_amdgcn_rcpf(1.0f + __builtin_amdgcn_exp2f(-1.4426950408889634f * x)); }

struct EpiProj {
    static constexpr bool PERM = true, AFTER_DRAIN = false;
    bf16_t* O; int ldc;
    __device__ __forceinline__ void operator()(const f32x4 (&acc)[2][2][4][2], const Unit& u, int wr, int wc, int fr, int fq) const {
        const int row0 = u.pm * BM + wr * 64 + fr, col0 = u.pn * BM + wc * 32 + 8 * fq;
        const int act = (u.pn < 4) ? 0 : (u.pn < 12 ? 1 : 2);
#pragma unroll
        for (int ai = 0; ai < 2; ++ai)
#pragma unroll
            for (int m = 0; m < 4; ++m) { bf16_t* rowp = O + (size_t)(row0 + ai * HALF + m * 16) * ldc + col0;
#pragma unroll
                for (int bj = 0; bj < 2; ++bj) { f32x4 v0 = acc[ai][bj][m][0], v1 = acc[ai][bj][m][1];
                    if (act == 1) { f32x2 a = gelu_pk((f32x2){v0[0], v0[1]}), b = gelu_pk((f32x2){v0[2], v0[3]}), c = gelu_pk((f32x2){v1[0], v1[1]}), d = gelu_pk((f32x2){v1[2], v1[3]});
                        v0 = (f32x4){a.x, a.y, b.x, b.y}; v1 = (f32x4){c.x, c.y, d.x, d.y}; }
                    else if (act == 2) {
#pragma unroll
                        for (int j = 0; j < 4; ++j) { v0[j] = sigm(v0[j]); v1[j] = sigm(v1[j]); } }
                    u32x4 w; w.x = cvt_pk_bf16(v0[0], v0[1]); w.y = cvt_pk_bf16(v0[2], v0[3]); w.z = cvt_pk_bf16(v1[0], v1[1]); w.w = cvt_pk_bf16(v1[2], v1[3]);
                    *(u32x4*)(rowp + bj * HALF) = w; } }
    }
};
struct EpiBf16 {
    static constexpr bool PERM = true, AFTER_DRAIN = false;
    bf16_t* O; int ldc;
    __device__ __forceinline__ void operator()(const f32x4 (&acc)[2][2][4][2], const Unit& u, int wr, int wc, int fr, int fq) const {
        const int row0 = u.pm * BM + wr * 64 + fr, col0 = u.pn * BM + wc * 32 + 8 * fq;
#pragma unroll
        for (int ai = 0; ai < 2; ++ai)
#pragma unroll
            for (int m = 0; m < 4; ++m) { bf16_t* rowp = O + (size_t)(row0 + ai * HALF + m * 16) * ldc + col0;
#pragma unroll
                for (int bj = 0; bj < 2; ++bj) { const f32x4 v0 = acc[ai][bj][m][0], v1 = acc[ai][bj][m][1];
                    u32x4 w; w.x = cvt_pk_bf16(v0[0], v0[1]); w.y = cvt_pk_bf16(v0[2], v0[3]); w.z = cvt_pk_bf16(v1[0], v1[1]); w.w = cvt_pk_bf16(v1[2], v1[3]);
                    *(u32x4*)(rowp + bj * HALF) = w; } }
    }
};
struct EpiM1 {
    static constexpr bool PERM = false, AFTER_DRAIN = false;
    float* T; const bf16_t* G; int ldg;
    __device__ __forceinline__ void operator()(const f32x4 (&acc)[2][2][4][2], const Unit& u, int wr, int wc, int fr, int fq) const {
        const int row0 = u.pm * BM + wr * 64 + fr, col0 = u.pn * BM + wc * 32 + 4 * fq;
#pragma unroll
        for (int ai = 0; ai < 2; ++ai)
#pragma unroll
            for (int m = 0; m < 4; ++m) { const size_t r = (size_t)(row0 + ai * HALF + m * 16); float* rowp = T + r * DM + col0; const bf16_t* gp = G + r * ldg + col0;
#pragma unroll
                for (int bj = 0; bj < 2; ++bj)
#pragma unroll
                    for (int n = 0; n < 2; ++n) { const u32x2 g = *(const u32x2*)(gp + bj * HALF + n * 16); const f32x4 a = acc[ai][bj][m][n];
                        *(f32x4*)(rowp + bj * HALF + n * 16) = (f32x4){a[0] * bflo(g.x), a[1] * bfhi(g.x), a[2] * bflo(g.y), a[3] * bfhi(g.y)}; } }
    }
};
struct EpiM2 {
    static constexpr bool PERM = true, AFTER_DRAIN = false;
    const float* T; const bf16_t* G; int ldg; bf16_t* O;
    __device__ __forceinline__ void operator()(const f32x4 (&acc)[2][2][4][2], const Unit& u, int wr, int wc, int fr, int fq) const {
        const int row0 = u.pm * BM + wr * 64 + fr, col0 = u.pn * BM + wc * 32 + 8 * fq;
#pragma unroll
        for (int ai = 0; ai < 2; ++ai)
#pragma unroll
            for (int m = 0; m < 4; ++m) { const size_t r = (size_t)(row0 + ai * HALF + m * 16);
#pragma unroll
                for (int bj = 0; bj < 2; ++bj) { const int c = col0 + bj * HALF;
                    const u32x4 g = *(const u32x4*)(G + r * ldg + c); const f32x4 t0 = *(const f32x4*)(T + r * DM + c), t1 = *(const f32x4*)(T + r * DM + c + 4);
                    const f32x4 a0 = acc[ai][bj][m][0], a1 = acc[ai][bj][m][1];
                    u32x4 w; w.x = cvt_pk_bf16(t0[0] + a0[0] * bflo(g.x), t0[1] + a0[1] * bfhi(g.x)); w.y = cvt_pk_bf16(t0[2] + a0[2] * bflo(g.y), t0[3] + a0[3] * bfhi(g.y));
                    w.z = cvt_pk_bf16(t1[0] + a1[0] * bflo(g.z), t1[1] + a1[1] * bfhi(g.z)); w.w = cvt_pk_bf16(t1[2] + a1[2] * bflo(g.w), t1[3] + a1[3] * bfhi(g.w));
                    *(u32x4*)(O + r * DM + c) = w; } }
    }
};
struct EpiRes {
    static constexpr bool PERM = false, AFTER_DRAIN = false;
    const float* base; float* out; const float* gate;
    __device__ __forceinline__ void operator()(const f32x4 (&acc)[2][2][4][2], const Unit& u, int wr, int wc, int fr, int fq) const {
        const int row0 = u.pm * BM + wr * 64 + fr, col0 = u.pn * BM + wc * 32 + 4 * fq;
        const float* gp = gate + (size_t)(u.pm >> 4) * NMOD + col0;
        f32x4 gv[2][2];
#pragma unroll
        for (int bj = 0; bj < 2; ++bj)
#pragma unroll
            for (int n = 0; n < 2; ++n) gv[bj][n] = *(const f32x4*)(gp + bj * HALF + n * 16);
#pragma unroll
        for (int ai = 0; ai < 2; ++ai)
#pragma unroll
            for (int m = 0; m < 4; ++m) { const size_t off = (size_t)(row0 + ai * HALF + m * 16) * DM + col0;
#pragma unroll
                for (int bj = 0; bj < 2; ++bj)
#pragma unroll
                    for (int n = 0; n < 2; ++n) { const f32x4 b = *(const f32x4*)(base + off + bj * HALF + n * 16);
                        *(f32x4*)(out + off + bj * HALF + n * 16) = b + gv[bj][n] * acc[ai][bj][m][n]; } }
    }
};
struct EpiFfnIn {
    static constexpr bool PERM = true, AFTER_DRAIN = false;
    bf16_t* O;
    __device__ __forceinline__ void operator()(const f32x4 (&acc)[2][2][4][2], const Unit& u, int wr, int wc, int fr, int fq) const {
        const int row0 = u.pm * BM + wr * 64 + fr, col0 = u.pn * HALF + wc * 32 + 8 * fq;
#pragma unroll
        for (int ai = 0; ai < 2; ++ai)
#pragma unroll
            for (int m = 0; m < 4; ++m) { bf16_t* rowp = O + (size_t)(row0 + ai * HALF + m * 16) * DFF + col0;
                float o[8];
#pragma unroll
                for (int n = 0; n < 2; ++n)
#pragma unroll
                    for (int j = 0; j < 4; ++j) { const float a = acc[ai][0][m][n][j], b = acc[ai][1][m][n][j]; o[n * 4 + j] = a * sigm(a) * b; }
                u32x4 w; w.x = cvt_pk_bf16(o[0], o[1]); w.y = cvt_pk_bf16(o[2], o[3]); w.z = cvt_pk_bf16(o[4], o[5]); w.w = cvt_pk_bf16(o[6], o[7]);
                *(u32x4*)rowp = w; }
    }
};

template <class Epi, class Sched, bool ALIGN_EPI = true, bool SP2 = true>
__device__ __forceinline__ void gemm_phase(PG8_LAS unsigned char* lds, const Gemm g, const Sched& S, const Epi& E) {
    const int tid = threadIdx.x, wid = __builtin_amdgcn_readfirstlane(tid >> 6), lane = tid & 63, wr = wid >> 2, wc = wid & 3, fr = lane & 15, fq = lane >> 4;
    const int K = g.K, nt = K / BK;
    unsigned voffA[2], voffB[2];
#pragma unroll
    for (int i = 0; i < 2; ++i) { int R, C; stage_rc(tid * 16 + i * 8192, R, C); const int Rb = Epi::PERM ? ((R & ~31) + perm32(R & 31)) : R;
        voffA[i] = (unsigned)(R * g.lda + C) * 2u; voffB[i] = (unsigned)(Rb * g.ldb + C) * 2u; }
    const size_t kstep = (size_t)(BK * 2);
    const size_t hstepA = (size_t)HALF * g.lda * 2, hstepB = (size_t)HALF * g.ldb * 2;
    const size_t tstepA = 2 * hstepA, tstepB = 2 * hstepB;
    const unsigned ldsw = (unsigned)wid * 1024u;
    const int aoff = lds_byte(wr * 64 + fr, fq * 8), boff = lds_byte(wc * 32 + fr, fq * 8);
#define PG8_SA(b, h) (((b) * 2 + (h)) * HTB)
#define PG8_SB(b, h) ((4 + (b) * 2 + (h)) * HTB)
#define PG8_STAGE(bufoff, gbase, voff) do { _Pragma("unroll") for (int _i = 0; _i < 2; ++_i) \
        __builtin_amdgcn_global_load_lds((const unsigned*)((const char*)(gbase) + (voff)[_i]), (PG8_LAS unsigned*)(lds + (bufoff) + ldsw + _i * 8192), 16, 0, 0); } while (0)
#define PG8_LDA(dst, b, h) do { _Pragma("unroll") for (int m = 0; m < 4; ++m) _Pragma("unroll") for (int k = 0; k < 2; ++k) dst[m][k] = *(const PG8_LAS bf16x8*)(lds + PG8_SA(b, h) + aoff + m * 2048 + k * 1024); } while (0)
#define PG8_LDB(dst, b, h) do { _Pragma("unroll") for (int n = 0; n < 2; ++n) _Pragma("unroll") for (int k = 0; k < 2; ++k) dst[n][k] = *(const PG8_LAS bf16x8*)(lds + PG8_SB(b, h) + boff + n * 2048 + k * 1024); } while (0)
#define PG8_MMA(ai, bj, At, Bt) do { __builtin_amdgcn_s_setprio(1); _Pragma("unroll") for (int m = 0; m < 4; ++m) _Pragma("unroll") for (int n = 0; n < 2; ++n) _Pragma("unroll") for (int k = 0; k < 2; ++k) \
        acc[ai][bj][m][n] = __builtin_amdgcn_mfma_f32_16x16x32_bf16(Bt[n][k], At[m][k], acc[ai][bj][m][n], 0, 0, 0); __builtin_amdgcn_s_setprio(0); } while (0)
#define PG8_WAIT_V(n) asm volatile("s_waitcnt vmcnt(" #n ")" ::: "memory")
#define PG8_WAIT_L(n) asm volatile("s_waitcnt lgkmcnt(" #n ")" ::: "memory")
#define PG8_BAR __builtin_amdgcn_s_barrier()
#define PG8_SCHED __builtin_amdgcn_sched_barrier(0)
    Unit cur, nxt; int ui = 0;
    if (!S.next(0, cur)) return;
    f32x4 acc[2][2][4][2];
#pragma unroll
    for (int a = 0; a < 2; ++a)
#pragma unroll
        for (int b = 0; b < 2; ++b)
#pragma unroll
            for (int m = 0; m < 4; ++m)
#pragma unroll
                for (int n = 0; n < 2; ++n) acc[a][b][m][n] = (f32x4){0.f, 0.f, 0.f, 0.f};
    bf16x8 At[4][2], B0[2][2], B1[2][2];
    const char* cA = (const char*)g.A + (size_t)cur.pm * tstepA; const char* cB = (const char*)g.Bt + (size_t)cur.pn * tstepB;
    S.a_ready(cur);
    if constexpr (SP2) {
        PG8_STAGE(PG8_SB(0, 0), cB, voffB); PG8_STAGE(PG8_SB(0, 1), cB + hstepB, voffB); PG8_STAGE(PG8_SA(0, 0), cA, voffA); PG8_STAGE(PG8_SA(0, 1), cA + hstepA, voffA);
        if (wr == 1) PG8_BAR;
        PG8_WAIT_V(2); PG8_BAR;
        PG8_STAGE(PG8_SB(1, 0), cB + kstep, voffB); PG8_STAGE(PG8_SA(1, 0), cA + kstep, voffA); PG8_STAGE(PG8_SB(1, 1), cB + hstepB + kstep, voffB);
        PG8_WAIT_V(6); PG8_BAR;
    } else {
        PG8_STAGE(PG8_SB(0, 0), cB, voffB); PG8_STAGE(PG8_SA(0, 0), cA, voffA); PG8_STAGE(PG8_SB(0, 1), cB + hstepB, voffB); PG8_STAGE(PG8_SA(0, 1), cA + hstepA, voffA);
        if (wr == 1) PG8_BAR;
        PG8_WAIT_V(4); PG8_BAR;
        PG8_STAGE(PG8_SB(1, 0), cB + kstep, voffB); PG8_STAGE(PG8_SA(1, 0), cA + kstep, voffA); PG8_STAGE(PG8_SB(1, 1), cB + hstepB + kstep, voffB);
        PG8_WAIT_V(6); PG8_BAR;
    }
    for (;;) {
        const bool has_next = S.next(ui + 1, nxt);
        const char* nA = has_next ? (const char*)g.A + (size_t)nxt.pm * tstepA : cA; const char* nB = has_next ? (const char*)g.Bt + (size_t)nxt.pn * tstepB : cB;
        for (int t = 0; t < nt; t += 2) {
            const bool last = (t == nt - 2);
            const char* a1 = cA + (size_t)(t + 1) * kstep;
            const char* a2 = last ? nA : cA + (size_t)(t + 2) * kstep; const char* b2 = last ? nB : cB + (size_t)(t + 2) * kstep;
            const char* a3 = a2 + kstep; const char* b3 = b2 + kstep;
            if (last && has_next) S.a_ready(nxt);
            if constexpr (SP2) {
            PG8_LDB(B0, 0, 0); PG8_LDB(B1, 0, 1); PG8_SCHED; PG8_LDA(At, 0, 0); PG8_STAGE(PG8_SA(1, 1), a1 + hstepA, voffA);
            PG8_WAIT_V(8); PG8_WAIT_L(0); PG8_BAR; PG8_MMA(0, 0, At, B0); PG8_MMA(0, 1, At, B1); PG8_BAR; PG8_SCHED;
            PG8_LDA(At, 0, 1); PG8_STAGE(PG8_SB(0, 0), b2, voffB); PG8_STAGE(PG8_SB(0, 1), b2 + hstepB, voffB); PG8_STAGE(PG8_SA(0, 0), a2, voffA);
            PG8_WAIT_V(8); PG8_WAIT_L(0); PG8_BAR; PG8_MMA(1, 0, At, B0); PG8_MMA(1, 1, At, B1); PG8_BAR; PG8_SCHED;
            PG8_LDB(B0, 1, 0); PG8_LDB(B1, 1, 1); PG8_SCHED; PG8_LDA(At, 1, 0); PG8_STAGE(PG8_SA(0, 1), a2 + hstepA, voffA);
            PG8_WAIT_V(8); PG8_WAIT_L(0); PG8_BAR; PG8_MMA(0, 0, At, B0); PG8_MMA(0, 1, At, B1); PG8_BAR; PG8_SCHED;
            PG8_LDA(At, 1, 1); PG8_STAGE(PG8_SB(1, 0), b3, voffB); PG8_STAGE(PG8_SB(1, 1), b3 + hstepB, voffB); PG8_STAGE(PG8_SA(1, 0), a3, voffA);
            PG8_WAIT_V(8); PG8_WAIT_L(0); PG8_BAR; PG8_MMA(1, 0, At, B0); PG8_MMA(1, 1, At, B1); PG8_BAR; PG8_SCHED;
            } else {
            PG8_LDB(B0, 0, 0); PG8_SCHED; PG8_LDA(At, 0, 0); PG8_STAGE(PG8_SA(1, 1), a1 + hstepA, voffA);
            PG8_WAIT_L(8); PG8_BAR; PG8_WAIT_L(0); PG8_MMA(0, 0, At, B0); PG8_BAR; PG8_SCHED;
            PG8_LDB(B1, 0, 1); PG8_STAGE(PG8_SB(0, 0), b2, voffB);
            PG8_BAR; PG8_WAIT_L(0); PG8_MMA(0, 1, At, B1); PG8_BAR;
            PG8_LDA(At, 0, 1); PG8_STAGE(PG8_SA(0, 0), a2, voffA);
            PG8_BAR; PG8_WAIT_L(0); PG8_MMA(1, 0, At, B0); PG8_BAR; PG8_SCHED;
            PG8_STAGE(PG8_SB(0, 1), b2 + hstepB, voffB);
            PG8_WAIT_V(6); PG8_BAR; PG8_MMA(1, 1, At, B1); PG8_BAR;
            PG8_LDB(B0, 1, 0); PG8_SCHED; PG8_LDA(At, 1, 0); PG8_STAGE(PG8_SA(0, 1), a2 + hstepA, voffA);
            PG8_WAIT_L(8); PG8_BAR; PG8_WAIT_L(0); PG8_MMA(0, 0, At, B0); PG8_BAR; PG8_SCHED;
            PG8_LDB(B1, 1, 1); PG8_STAGE(PG8_SB(1, 0), b3, voffB);
            PG8_BAR; PG8_WAIT_L(0); PG8_MMA(0, 1, At, B1); PG8_BAR;
            PG8_LDA(At, 1, 1); PG8_STAGE(PG8_SA(1, 0), a3, voffA);
            PG8_BAR; PG8_WAIT_L(0); PG8_MMA(1, 0, At, B0); PG8_BAR; PG8_SCHED;
            PG8_STAGE(PG8_SB(1, 1), b3 + hstepB, voffB);
            PG8_WAIT_V(6); PG8_BAR; PG8_MMA(1, 1, At, B1); PG8_BAR;
            }
        }
        if constexpr (ALIGN_EPI) { if (wr == 0) PG8_BAR; }
        if constexpr (!Epi::AFTER_DRAIN) { E(acc, cur, wr, wc, fr, fq); S.done(cur); }
        if (!has_next) break;
#pragma unroll
        for (int a = 0; a < 2; ++a)
#pragma unroll
            for (int b = 0; b < 2; ++b)
#pragma unroll
                for (int m = 0; m < 4; ++m)
#pragma unroll
                    for (int n = 0; n < 2; ++n) acc[a][b][m][n] = (f32x4){0.f, 0.f, 0.f, 0.f};
        cur = nxt; cA = nA; cB = nB; ++ui;
        if constexpr (ALIGN_EPI) { if (wr == 1) PG8_BAR; }
    }
    PG8_WAIT_V(0);
    if constexpr (!ALIGN_EPI) { if (wr == 0) PG8_BAR; }
    PG8_BAR;
#undef PG8_SA
#undef PG8_SB
#undef PG8_STAGE
#undef PG8_LDA
#undef PG8_LDB
#undef PG8_MMA
#undef PG8_WAIT_V
#undef PG8_WAIT_L
#undef PG8_BAR
#undef PG8_SCHED
}
}

namespace att {
constexpr int NW = 8, QBLK = 32, KVBLK = 64;
constexpr float SCALE = 0.07216878364870323f;
constexpr float THR = 8.f;
constexpr size_t SHM_V = KVBLK * VD * 2, SHM_K = KVBLK * QKD * 2;
constexpr size_t SHM_ATTN = 2 * SHM_V + 2 * SHM_K + NW * 64 * 4;
#define KSWZ(row, colB) ((row) * 384 + ((colB) ^ (((row) & 7) << 4)))
#define SBAR() __builtin_amdgcn_sched_barrier(0)
__device__ __forceinline__ int crow(int r, int hi) { return (r & 3) + 8 * (r >> 2) + 4 * hi; }
__device__ __forceinline__ unsigned cvtpk(float lo, float hi) { unsigned r; asm volatile("v_cvt_pk_bf16_f32 %0, %1, %2" : "=v"(r) : "v"(lo), "v"(hi)); return r; }

__device__ __forceinline__ void partialSM(f32x16& p0, f32x16& p1, float& m_reg, float& mn, float& alpha) {
  constexpr float C = SCALE * 1.4426950408889634f;
  float pmax = p0[0];
#pragma unroll
  for (int r = 1; r < 16; ++r) pmax = fmaxf(pmax, p0[r]);
#pragma unroll
  for (int r = 0; r < 16; ++r) pmax = fmaxf(pmax, p1[r]);
  { auto rr = __builtin_amdgcn_permlane32_swap(__float_as_uint(pmax), __float_as_uint(pmax), false, false);
    pmax = fmaxf(__uint_as_float(rr[0]), __uint_as_float(rr[1])); }
  if (__builtin_expect(__all(pmax - m_reg <= THR / SCALE), 1)) { mn = m_reg; alpha = 1.f; }
  else { mn = fmaxf(m_reg, pmax); alpha = __builtin_amdgcn_exp2f((m_reg - mn) * C); m_reg = mn; }
  float mnC = -mn * C;
#pragma unroll
  for (int r = 0; r < 16; ++r) p0[r] = fmaf(p0[r], C, mnC);
#pragma unroll
  for (int r = 0; r < 16; ++r) p1[r] = fmaf(p1[r], C, mnC);
#pragma unroll
  for (int r = 0; r < 16; ++r) p0[r] = __builtin_amdgcn_exp2f(p0[r]);
}
__device__ __forceinline__ void finishSM(f32x16& p0, f32x16& p1, float alpha, float& l_reg, bf16x8& pa0, bf16x8& pa1, bf16x8& pa2, bf16x8& pa3) {
#pragma unroll
  for (int r = 0; r < 16; ++r) p1[r] = __builtin_amdgcn_exp2f(p1[r]);
  float ps = 0;
#pragma unroll
  for (int r = 0; r < 16; ++r) ps += p0[r];
#pragma unroll
  for (int r = 0; r < 16; ++r) ps += p1[r];
  { auto rr = __builtin_amdgcn_permlane32_swap(__float_as_uint(ps), __float_as_uint(ps), false, false);
    ps = __uint_as_float(rr[0]) + __uint_as_float(rr[1]); }
  l_reg = l_reg * alpha + ps;
#define PK4(P, BASE, OUT) do { unsigned a0 = cvtpk(P[BASE + 0], P[BASE + 1]), a1 = cvtpk(P[BASE + 2], P[BASE + 3]);   \
    unsigned b0 = cvtpk(P[BASE + 4], P[BASE + 5]), b1 = cvtpk(P[BASE + 6], P[BASE + 7]);                              \
    auto r0 = __builtin_amdgcn_permlane32_swap(a0, b0, false, false); auto r1 = __builtin_amdgcn_permlane32_swap(a1, b1, false, false); \
    u32x4 w = {r0[0], r1[0], r0[1], r1[1]}; OUT = *reinterpret_cast<bf16x8*>(&w); } while (0)
  PK4(p0, 0, pa0); PK4(p0, 8, pa1); PK4(p1, 0, pa2); PK4(p1, 8, pa3);
#undef PK4
}
__device__ __forceinline__ void qkt(f32x16& p0, f32x16& p1, const char* Ks, const bf16x8* qr, int r32, int hi) {
  p0 = f32x16{}; p1 = f32x16{};
#pragma unroll
  for (int d0 = 0; d0 < 12; ++d0) { int cb = (d0 * 16 + hi * 8) * 2;
    bf16x8 b0 = *reinterpret_cast<const bf16x8*>(Ks + KSWZ(r32, cb));
    bf16x8 b1 = *reinterpret_cast<const bf16x8*>(Ks + KSWZ(32 + r32, cb));
    p0 = __builtin_amdgcn_mfma_f32_32x32x16_bf16(b0, qr[d0], p0, 0, 0, 0);
    p1 = __builtin_amdgcn_mfma_f32_32x32x16_bf16(b1, qr[d0], p1, 0, 0, 0); }
}
__device__ __forceinline__ int v_st(int k, int c) { const int kk = (k & ~0xC) | ((k & 4) << 1) | ((k & 8) >> 1); return ((kk >> 3) * 4 + (c >> 5)) * 512 + ((kk & 7) * 32 + (c & 31)) * 2; }
__device__ __forceinline__ int v_rd_base(int lane) { return ((lane & 3) << 3) | (((lane >> 2) & 3) << 6) | (((lane >> 4) & 1) << 5) | (((lane >> 5) & 1) << 8); }
constexpr int v_rd_off(int d0, int ks, int half) { return d0 * 512 + ks * 4096 + half * 2048; }
template <int OFF> __device__ __forceinline__ s16x4 tr_read(int vb) {
  s16x4 r; asm volatile("ds_read_b64_tr_b16 %0, %1 offset:%2" : "=&v"(r) : "v"(vb), "i"(OFF) : "memory"); return r;
}
template <int D0> __device__ __forceinline__ void pv_one(f32x16& od, int vb, bf16x8 pa0, bf16x8 pa1, bf16x8 pa2, bf16x8 pa3) {
  const s16x4 l0 = tr_read<v_rd_off(D0, 0, 0)>(vb), h0 = tr_read<v_rd_off(D0, 0, 1)>(vb), l1 = tr_read<v_rd_off(D0, 1, 0)>(vb), h1 = tr_read<v_rd_off(D0, 1, 1)>(vb);
  const s16x4 l2 = tr_read<v_rd_off(D0, 2, 0)>(vb), h2 = tr_read<v_rd_off(D0, 2, 1)>(vb), l3 = tr_read<v_rd_off(D0, 3, 0)>(vb), h3 = tr_read<v_rd_off(D0, 3, 1)>(vb);
  asm volatile("s_waitcnt lgkmcnt(0)" ::: "memory"); SBAR();
#define PK(L, H) (bf16x8){L[0], L[1], L[2], L[3], H[0], H[1], H[2], H[3]}
  od = __builtin_amdgcn_mfma_f32_32x32x16_bf16(pa0, PK(l0, h0), od, 0, 0, 0);
  od = __builtin_amdgcn_mfma_f32_32x32x16_bf16(pa1, PK(l1, h1), od, 0, 0, 0);
  od = __builtin_amdgcn_mfma_f32_32x32x16_bf16(pa2, PK(l2, h2), od, 0, 0, 0);
  od = __builtin_amdgcn_mfma_f32_32x32x16_bf16(pa3, PK(l3, h3), od, 0, 0, 0);
#undef PK
}
__device__ __forceinline__ void pv_d0(f32x16* o, int vb, bf16x8 pa0, bf16x8 pa1, bf16x8 pa2, bf16x8 pa3) {
  pv_one<0>(o[0], vb, pa0, pa1, pa2, pa3); pv_one<1>(o[1], vb, pa0, pa1, pa2, pa3); pv_one<2>(o[2], vb, pa0, pa1, pa2, pa3); pv_one<3>(o[3], vb, pa0, pa1, pa2, pa3);
}

__device__ __forceinline__ void attn_unit(const bf16_t* __restrict__ Qb, const bf16_t* __restrict__ Kh, const bf16_t* __restrict__ Vh, bf16_t* __restrict__ Ob, char* lds) {
  const int tid = threadIdx.x, wid = tid >> 6, lane = tid & 63, r32 = lane & 31, hi = lane >> 5;
  char* V_lds = lds; char* K_lds = lds + 2 * SHM_V;
  float* wsf = (float*)(lds + 2 * SHM_V + 2 * SHM_K) + wid * 64; float* li_l = wsf; float* al_l = wsf + 32;
  float m_reg = -1e30f, l_reg = 0; f32x16 o[4] = {}; bf16x8 qr[12];
  const bf16_t* Qw = Qb + (long)(wid * QBLK + r32) * QKD + hi * 8;
#pragma unroll
  for (int d0 = 0; d0 < 12; ++d0) qr[d0] = *reinterpret_cast<const bf16x8*>(Qw + d0 * 16);
  const int sr = tid >> 4, sc = (tid & 15) * 8, vst0 = v_st(sr, sc), vst1 = v_st(32 + sr, sc);
  int kst[3];
#pragma unroll
  for (int i = 0; i < 3; ++i) { const int q = tid + i * 512; kst[i] = KSWZ(q / 24, (q % 24) * 16); }
  const int vb0 = (int)(uintptr_t)V_lds + v_rd_base(lane);
  bf16x8 vs0, vs1, ks0, ks1, ks2;
#define SLOAD(k0) do { vs0 = *reinterpret_cast<const bf16x8*>(&Vh[(long)((k0) + sr) * VD + sc]); vs1 = *reinterpret_cast<const bf16x8*>(&Vh[(long)((k0) + 32 + sr) * VD + sc]); \
    const bf16_t* kt_ = Kh + (long)(k0) * QKD + tid * 8; ks0 = *reinterpret_cast<const bf16x8*>(kt_); ks1 = *reinterpret_cast<const bf16x8*>(kt_ + 4096); ks2 = *reinterpret_cast<const bf16x8*>(kt_ + 8192); } while (0)
#define SWRITE(b) do { *(bf16x8*)(V_lds + (b) * SHM_V + vst0) = vs0; *(bf16x8*)(V_lds + (b) * SHM_V + vst1) = vs1; \
    *(bf16x8*)(K_lds + (b) * SHM_K + kst[0]) = ks0; *(bf16x8*)(K_lds + (b) * SHM_K + kst[1]) = ks1; *(bf16x8*)(K_lds + (b) * SHM_K + kst[2]) = ks2; } while (0)
#define SWAIT() asm volatile("s_waitcnt vmcnt(0)" ::: "memory")
#define RESC(a) do { if (__any((a) < 1.f)) { if (hi == 0) al_l[r32] = (a); asm volatile("s_waitcnt lgkmcnt(0)" ::: "memory"); \
    _Pragma("unroll") for (int d = 0; d < 4; ++d) _Pragma("unroll") for (int r = 0; r < 16; ++r) o[d][r] *= al_l[crow(r, hi)]; } } while (0)
  f32x16 p0, p1; float mn, al; bf16x8 pa0, pa1, pa2, pa3; const int NT = SKV / KVBLK;
  SLOAD(0); SWAIT(); SWRITE(0); __syncthreads();
  for (int j = 0; j < NT; ++j) {
    const int cur = j & 1;
    if (j + 1 < NT) SLOAD((j + 1) * KVBLK);
    SBAR(); qkt(p0, p1, K_lds + cur * SHM_K, qr, r32, hi);
    partialSM(p0, p1, m_reg, mn, al);
    RESC(al);
    finishSM(p0, p1, al, l_reg, pa0, pa1, pa2, pa3); SBAR();
    pv_d0(o, vb0 + cur * (int)SHM_V, pa0, pa1, pa2, pa3);
    if (j + 1 < NT) { SWAIT(); SWRITE(cur ^ 1); }
    __syncthreads();
  }
  if (hi == 0) li_l[r32] = l_reg; asm volatile("s_waitcnt lgkmcnt(0)" ::: "memory");
  float rli[16];
#pragma unroll
  for (int r = 0; r < 16; ++r) rli[r] = __builtin_amdgcn_rcpf(li_l[crow(r, hi)]);
  bf16_t* Ow = Ob + (long)(wid * QBLK) * DM;
#pragma unroll
  for (int r = 0; r < 16; ++r) { int orow = crow(r, hi);
#pragma unroll
    for (int d0 = 0; d0 < 4; ++d0) Ow[(long)orow * DM + d0 * 32 + r32] = (bf16_t)f2bf(o[d0][r] * rli[r]); }
  __syncthreads();
#undef SLOAD
#undef SWRITE
#undef SWAIT
#undef RESC
}
}

struct Args { const float* in[24]; float* out; unsigned char* ws; int ph_lo, ph_hi; };

__device__ __forceinline__ void tr_item(const float* __restrict__ W, int ldw, int k0, int c0, bf16_t* __restrict__ WT, int ldt, int r0, const float* __restrict__ gk, LAS float* scr, int lane) {
#pragma unroll 8
    for (int i = 0; i < 32; ++i) { const int kk = 2 * i + (lane >> 5); float v = 0.f;
        if (c0 >= 0) { v = W[(size_t)(k0 + kk) * ldw + c0 + (lane & 31)]; if (gk) v *= gk[k0 + kk]; }
        scr[kk * 33 + (lane & 31)] = v; }
    LDS_WAIT();
    const int c = lane & 7;
#pragma unroll
    for (int j = 0; j < 4; ++j) { const int n = (lane >> 3) + 8 * j; const LAS float* s = scr + (8 * c) * 33 + n;
        u32x4 o; o.x = pk2(s[0 * 33], s[1 * 33]); o.y = pk2(s[2 * 33], s[3 * 33]); o.z = pk2(s[4 * 33], s[5 * 33]); o.w = pk2(s[6 * 33], s[7 * 33]);
        *(u32x4*)(WT + (size_t)(r0 + n) * ldt + k0 + 8 * c) = o; }
    LDS_WAIT();
}

__global__ void __launch_bounds__(512, 2) fwd_kernel(Args args) {
    extern __shared__ __attribute__((aligned(16))) unsigned char lds[];
    const int tid = threadIdx.x, lane = tid & 63, wave = __builtin_amdgcn_readfirstlane(tid >> 6);
    const int G = gridDim.x, bx = blockIdx.x;
    const int vcu = (G % 8 == 0) ? (bx % 8) * (G / 8) + bx / 8 : bx;
    const int gw = vcu * 8 + wave, NGW = G * 8;
    unsigned char* ws = args.ws;
    const float* x = args.in[0]; const float* cvec = args.in[1]; const float* ctx = args.in[2]; const float* c_ctx = args.in[3];
    const float* w_mod = args.in[4]; const float* b_mod = args.in[5]; const float* norm1_g = args.in[6]; const float* w_in = args.in[7];
    const float* q_norm_g = args.in[8]; const float* kv_norm_g = args.in[9]; const float* w_uq = args.in[10]; const float* w_ukv = args.in[11];
    const float* qk_norm_q = args.in[12]; const float* qk_norm_k = args.in[13]; const float* sgu_norm_g = args.in[14]; const float* sgu_norm_b = args.in[15];
    const float* w_spatial = args.in[16]; const float* b_spatial = args.in[17]; const float* w_br_attn = args.in[18]; const float* w_br_sgu = args.in[19];
    const float* w_out = args.in[20]; const float* norm2_g = args.in[21]; const float* w_ffn_in = args.in[22]; const float* w_ffn_out = args.in[23];
    float* out = args.out;
    float* MOD = (float*)(ws + WS_MOD);
    bf16_t* WIN = (bf16_t*)(ws + WS_WIN); bf16_t* WUQ = (bf16_t*)(ws + WS_WUQ); bf16_t* WUKV = (bf16_t*)(ws + WS_WUKV);
    bf16_t* WBRA = (bf16_t*)(ws + WS_WBRA); bf16_t* WBRS = (bf16_t*)(ws + WS_WBRS); bf16_t* WOUT = (bf16_t*)(ws + WS_WOUT);
    bf16_t* WFI = (bf16_t*)(ws + WS_WFI); bf16_t* WFO = (bf16_t*)(ws + WS_WFO); bf16_t* WSP = (bf16_t*)(ws + WS_WSP);
    bf16_t* H = (bf16_t*)(ws + WS_H); bf16_t* KVUP = H; bf16_t* AO = H; bf16_t* H2 = H;
    bf16_t* P = (bf16_t*)(ws + WS_P); bf16_t* ACT = P;
    bf16_t* KF = (bf16_t*)(ws + WS_KF); bf16_t* VF = (bf16_t*)(ws + WS_VF); bf16_t* MERGED = (bf16_t*)(ws + WS_MERGED);
    bf16_t* QUP = (bf16_t*)out; bf16_t* QF = (bf16_t*)((unsigned char*)out + DO_QF); float* TMP = out;
    const int lo = args.ph_lo, hi = args.ph_hi;
#ifndef PH_MASK
#define PH_MASK 0x7ff
#endif
#define IN(k) ((((PH_MASK) >> (k)) & 1) && lo <= (k) && (k) < hi)
#define SEAM(k) do { if (IN(k) && IN((k) + 1)) { cg::this_grid().sync(); } } while (0)

    if (IN(0)) {
        LAS float* sact = (LAS float*)lds;
        LAS float* red = (LAS float*)(lds + 40960);
        for (int i = tid; i < 5 * DM; i += 512) { const float v = (i < 4 * DM) ? cvec[i] : c_ctx[i - 4 * DM]; sact[i] = v / (1.0f + __expf(-v)); }
        __syncthreads();
        for (int cb = bx; cb < NMOD / 48; cb += G) {
            const int n0 = cb * 48, c4 = tid % 12, kg = tid / 12;
            if (kg < 42) {
                f32x4 a[5];
#pragma unroll
                for (int r = 0; r < 5; ++r) a[r] = (f32x4){0.f, 0.f, 0.f, 0.f};
                for (int k = kg; k < DM; k += 42) { const f32x4 w = *(const f32x4*)(w_mod + (size_t)k * NMOD + n0 + c4 * 4);
#pragma unroll
                    for (int r = 0; r < 5; ++r) a[r] += w * sact[r * DM + k]; }
#pragma unroll
                for (int r = 0; r < 5; ++r)
#pragma unroll
                    for (int j = 0; j < 4; ++j) red[(kg * 5 + r) * 48 + c4 * 4 + j] = a[r][j];
            }
            __syncthreads();
            if (tid < 240) { const int r = tid / 48, col = tid % 48; float s = 0.f;
                for (int k2 = 0; k2 < 42; ++k2) s += red[(k2 * 5 + r) * 48 + col];
                MOD[(size_t)r * NMOD + n0 + col] = s + b_mod[n0 + col]; }
            __syncthreads();
        }
        LAS float* scr = (LAS float*)(lds + wave * 16384);
        constexpr int I_IN = 32 * 224, I_UQ = 8 * 48, I_UKV = 4 * 64, I_BR = 16 * 64, I_OUT = 32 * 64, I_FI = 32 * 352, I_FO = 88 * 64;
        constexpr int NITEMS = I_IN + I_UQ + I_UKV + 2 * I_BR + I_OUT + I_FI + I_FO;
        for (int it = gw; it < NITEMS; it += NGW) {
            int r = it;
            if (r < I_IN) { const int kb = r / 224, nb = r % 224, r0 = nb * 32; const int c0 = r0 < 832 ? r0 : (r0 < 1024 ? -1 : r0 - 192);
                tr_item(w_in, IN_COLS, kb * 64, c0, WIN, DM, r0, nullptr, scr, lane); continue; } r -= I_IN;
            if (r < I_UQ) { const int kb = r / 48, nb = r % 48; tr_item(w_uq, NH * QKD, kb * 64, nb * 32, WUQ, QL, nb * 32, q_norm_g, scr, lane); continue; } r -= I_UQ;
            if (r < I_UKV) { const int kb = r / 64, nb = r % 64; tr_item(w_ukv, 2048, kb * 64, nb * 32, WUKV, KVL, nb * 32, kv_norm_g, scr, lane); continue; } r -= I_UKV;
            if (r < I_BR) { const int kb = r / 64, nb = r % 64; tr_item(w_br_attn, DM, kb * 64, nb * 32, WBRA, 1024, nb * 32, nullptr, scr, lane); continue; } r -= I_BR;
            if (r < I_BR) { const int kb = r / 64, nb = r % 64; tr_item(w_br_sgu, DM, kb * 64, nb * 32, WBRS, 1024, nb * 32, nullptr, scr, lane); continue; } r -= I_BR;
            if (r < I_OUT) { const int kb = r / 64, nb = r % 64; tr_item(w_out, DM, kb * 64, nb * 32, WOUT, DM, nb * 32, nullptr, scr, lane); continue; } r -= I_OUT;
            if (r < I_FI) { const int kb = r / 352, nb = r % 352, r0 = nb * 32, pn = r0 >> 8, j = r0 & 255; const int c0 = j < 128 ? pn * 128 + j : DFF + pn * 128 + (j - 128);
                tr_item(w_ffn_in, 2 * DFF, kb * 64, c0, WFI, DM, r0, nullptr, scr, lane); continue; } r -= I_FI;
            { const int kb = r / 64, nb = r % 64; tr_item(w_ffn_out, DM, kb * 64, nb * 32, WFO, DFF, nb * 32, nullptr, scr, lane); }
        }
        for (int i = (bx * 512 + tid); i < 8 * 128 * 128 / 2; i += G * 512) { const f32x2 v = *(const f32x2*)(w_spatial + 2 * (size_t)i); ((unsigned*)WSP)[i] = pk2(v.x, v.y); }
    }
    SEAM(0);

    if (IN(1)) {
        for (int row = gw; row < MROWS; row += NGW) {
            const float* src = row < NTOK ? x + (size_t)row * DM : ctx + (size_t)(row - NTOK) * DM;
            const int b = row < NTOK ? row / SEQ : 4;
            const float* sh = MOD + (size_t)b * NMOD; const float* scp = sh + DM;
            f32x4 v[8]; float ss = 0.f;
#pragma unroll
            for (int j = 0; j < 8; ++j) { v[j] = *(const f32x4*)(src + (lane + 64 * j) * 4); ss += (v[j].x * v[j].x + v[j].y * v[j].y) + (v[j].z * v[j].z + v[j].w * v[j].w); }
            const float r = 1.0f / sqrtf(wave_sum(ss) * (1.0f / DM) + EPS);
#pragma unroll
            for (int j = 0; j < 8; ++j) { const int idx = (lane + 64 * j) * 4; const f32x4 g = *(const f32x4*)(norm1_g + idx), s1 = *(const f32x4*)(scp + idx), s0 = *(const f32x4*)(sh + idx);
                const f32x4 o = (v[j] * r * g) * (s1 + 1.0f) + s0;
                u32x2 w; w.x = pk2(o.x, o.y); w.y = pk2(o.z, o.w); *(u32x2*)(H + (size_t)row * DM + idx) = w; }
        }
    }
    SEAM(1);

    if (IN(2)) {
        pg8::Gemm g{H, WIN, MROWS, PCOLS, DM, DM, DM}; pg8::ProjOrder S; S.init(G, bx);
        pg8::EpiProj E{P, PCOLS};
        pg8::gemm_phase<pg8::EpiProj, pg8::ProjOrder>((LAS unsigned char*)lds, g, S, E);
    }
    SEAM(2);

    if (IN(3)) {
        { pg8::Gemm g{P, WUQ, NTOK, NH * QKD, QL, PCOLS, QL}; pg8::StaticOrder S; S.init(NTOK, NH * QKD, G, bx);
          pg8::EpiBf16 E{QUP, NH * QKD};
          pg8::gemm_phase<pg8::EpiBf16, pg8::StaticOrder>((LAS unsigned char*)lds, g, S, E); }
        { pg8::Gemm g{P + PC_KV, WUKV, MROWS, 2048, KVL, PCOLS, KVL}; pg8::StaticOrder S; S.init(MROWS, 2048, G, bx);
          pg8::EpiBf16 E{KVUP, 2048};
          pg8::gemm_phase<pg8::EpiBf16, pg8::StaticOrder>((LAS unsigned char*)lds, g, S, E); }
    }
    SEAM(3);

    if (IN(4)) {
        for (int t = gw; t < MROWS; t += NGW) {
            const bool lat = t < NTOK;
            const bf16_t* Prow = P + (size_t)t * PCOLS;
            int b, n, m;
            if (lat) { b = t / SEQ; n = t % SEQ; m = n; } else { const int tc = t - NTOK; b = tc / CTXL; n = 0; m = SEQ + tc % CTXL; }
            float r_kv;
            { const u32x2 w = *(const u32x2*)(Prow + PC_KV + lane * 4); const float a0 = bflo(w.x), a1 = bfhi(w.x), a2 = bflo(w.y), a3 = bfhi(w.y);
              r_kv = 1.0f / sqrtf(wave_sum((a0 * a0 + a1 * a1) + (a2 * a2 + a3 * a3)) * (1.0f / KVL) + EPS); }
            const float kr = bf2f(Prow[PC_KR + lane]);
            float cs = 1.f, sn = 0.f;
            if (lat) { const int i = lane & 15; const float pos = (float)((lane < 32) ? (n >> 6) : (n & 63));
                const float freq = exp2f(-(float)i * (13.287712379549449f / 16.0f));
                float rev = pos * freq * 0.15915494309189535f; rev -= floorf(rev);
                cs = __builtin_amdgcn_cosf(rev); sn = __builtin_amdgcn_sinf(rev); }
            const bool first = (lane & 16) == 0;
            const float gk0 = qk_norm_k[lane], gk1 = qk_norm_k[64 + lane], gk2 = qk_norm_k[128 + lane];
            const bf16_t* kvrow = KVUP + (size_t)t * 2048;
#pragma unroll 2
            for (int h = 0; h < NH; ++h) {
                const float e0 = bf2f(kvrow[h * 256 + lane]) * r_kv, e1 = bf2f(kvrow[h * 256 + 64 + lane]) * r_kv;
                const float v0 = bf2f(kvrow[h * 256 + 128 + lane]) * r_kv, v1 = bf2f(kvrow[h * 256 + 192 + lane]) * r_kv;
                const float rn = 1.0f / sqrtf(wave_sum(e0 * e0 + e1 * e1 + kr * kr) * (1.0f / QKD) + EPS);
                const float k0 = e0 * rn * gk0, k1 = e1 * rn * gk1; float k2 = kr * rn * gk2;
                if (lat) { const float pr = __shfl_xor(k2, 16); k2 = first ? k2 * cs - pr * sn : k2 * cs + pr * sn; }
                bf16_t* kd = KF + ((size_t)(b * NH + h) * SKV + m) * QKD;
                kd[lane] = (bf16_t)f2bf(k0); kd[64 + lane] = (bf16_t)f2bf(k1); kd[128 + lane] = (bf16_t)f2bf(k2);
                bf16_t* vd = VF + ((size_t)(b * NH + h) * SKV + m) * VD;
                vd[lane] = (bf16_t)f2bf(v0); vd[64 + lane] = (bf16_t)f2bf(v1);
            }
            if (lat) {
                float r_q;
                { const u32x4 w = *(const u32x4*)(Prow + lane * 8); float s = 0.f;
                  s += bflo(w.x) * bflo(w.x) + bfhi(w.x) * bfhi(w.x); s += bflo(w.y) * bflo(w.y) + bfhi(w.y) * bfhi(w.y);
                  s += bflo(w.z) * bflo(w.z) + bfhi(w.z) * bfhi(w.z); s += bflo(w.w) * bflo(w.w) + bfhi(w.w) * bfhi(w.w);
                  r_q = 1.0f / sqrtf(wave_sum(s) * (1.0f / QL) + EPS); }
                const float gq0 = qk_norm_q[lane], gq1 = qk_norm_q[64 + lane], gq2 = qk_norm_q[128 + lane];
                const bf16_t* qrow = QUP + (size_t)t * (NH * QKD);
#pragma unroll 2
                for (int h = 0; h < NH; ++h) {
                    const float e0 = bf2f(qrow[h * QKD + lane]) * r_q, e1 = bf2f(qrow[h * QKD + 64 + lane]) * r_q, e2 = bf2f(qrow[h * QKD + 128 + lane]) * r_q;
                    const float rn = 1.0f / sqrtf(wave_sum(e0 * e0 + e1 * e1 + e2 * e2) * (1.0f / QKD) + EPS);
                    const float q0 = e0 * rn * gq0, q1 = e1 * rn * gq1; float q2 = e2 * rn * gq2;
                    const float pr = __shfl_xor(q2, 16); q2 = first ? q2 * cs - pr * sn : q2 * cs + pr * sn;
                    bf16_t* qd = QF + ((size_t)(b * NH + h) * SEQ + n) * QKD;
                    qd[lane] = (bf16_t)f2bf(q0); qd[64 + lane] = (bf16_t)f2bf(q1); qd[128 + lane] = (bf16_t)f2bf(q2);
                }
                bf16_t* vp = (bf16_t*)Prow + PC_V;
                float f[16]; float s = 0.f;
#pragma unroll
                for (int j = 0; j < 2; ++j) { const u32x4 w = *(const u32x4*)(vp + j * 512 + lane * 8);
                    f[j * 8 + 0] = bflo(w.x); f[j * 8 + 1] = bfhi(w.x); f[j * 8 + 2] = bflo(w.y); f[j * 8 + 3] = bfhi(w.y);
                    f[j * 8 + 4] = bflo(w.z); f[j * 8 + 5] = bfhi(w.z); f[j * 8 + 6] = bflo(w.w); f[j * 8 + 7] = bfhi(w.w); }
#pragma unroll
                for (int j = 0; j < 16; ++j) s += f[j];
                const float mu = wave_sum(s) * (1.0f / 1024.0f); float q = 0.f;
#pragma unroll
                for (int j = 0; j < 16; ++j) { f[j] -= mu; q += f[j] * f[j]; }
                const float rstd = 1.0f / sqrtf(wave_sum(q) * (1.0f / 1024.0f) + EPS);
#pragma unroll
                for (int j = 0; j < 2; ++j) { const int c0 = j * 512 + lane * 8; float o[8];
#pragma unroll
                    for (int e = 0; e < 8; ++e) o[e] = f[j * 8 + e] * rstd * sgu_norm_g[c0 + e] + sgu_norm_b[c0 + e];
                    u32x4 w; w.x = pk2(o[0], o[1]); w.y = pk2(o[2], o[3]); w.z = pk2(o[4], o[5]); w.w = pk2(o[6], o[7]);
                    *(u32x4*)(vp + c0) = w; }
            }
        }
    }
    SEAM(4);

    if (IN(5)) {
        LAS bf16_t* vt = (LAS bf16_t*)lds;
        for (int un = vcu; un < 1024; un += G) {
            const int ck = un >> 3, g = un & 7; const size_t t0 = (size_t)ck * 128;
#pragma unroll
            for (int i = 0; i < 4; ++i) { const int q = tid + i * 512, j = q >> 4, c0 = (q & 15) * 8;
                const u32x4 w = *(const u32x4*)(P + (t0 + j) * PCOLS + PC_V + g * 128 + c0);
                vt[(c0 + 0) * 136 + j] = (bf16_t)(w.x & 0xffff); vt[(c0 + 1) * 136 + j] = (bf16_t)(w.x >> 16);
                vt[(c0 + 2) * 136 + j] = (bf16_t)(w.y & 0xffff); vt[(c0 + 3) * 136 + j] = (bf16_t)(w.y >> 16);
                vt[(c0 + 4) * 136 + j] = (bf16_t)(w.z & 0xffff); vt[(c0 + 5) * 136 + j] = (bf16_t)(w.z >> 16);
                vt[(c0 + 6) * 136 + j] = (bf16_t)(w.w & 0xffff); vt[(c0 + 7) * 136 + j] = (bf16_t)(w.w >> 16); }
            __syncthreads();
            const int fr = lane & 15, fq = lane >> 4;
            bf16x8 af[4];
#pragma unroll
            for (int kk = 0; kk < 4; ++kk) af[kk] = *(const bf16x8*)(WSP + ((size_t)g * 128 + wave * 16 + fr) * 128 + kk * 32 + fq * 8);
            float bs[4];
#pragma unroll
            for (int j = 0; j < 4; ++j) bs[j] = b_spatial[g * 128 + wave * 16 + fq * 4 + j];
#pragma unroll
            for (int nb = 0; nb < 8; ++nb) {
                f32x4 acc = (f32x4){0.f, 0.f, 0.f, 0.f};
#pragma unroll
                for (int kk = 0; kk < 4; ++kk) { const bf16x8 bfr = *(const LAS bf16x8*)(vt + (nb * 16 + fr) * 136 + kk * 32 + fq * 8);
                    acc = __builtin_amdgcn_mfma_f32_16x16x32_bf16(af[kk], bfr, acc, 0, 0, 0); }
#pragma unroll
                for (int j = 0; j < 4; ++j) { const size_t t = t0 + wave * 16 + fq * 4 + j; const int c = g * 128 + nb * 16 + fr;
                    const float u = bf2f(P[t * PCOLS + PC_U + c]);
                    AO[t * DM + 1024 + c] = (bf16_t)f2bf(u * (acc[j] + bs[j])); }
            }
            __syncthreads();
        }
        for (int un = vcu; un < NB * NH * (SEQ / 256); un += G) {
            const int bh = un >> 4, qb = un & 15, b = bh >> 3, h = bh & 7;
            att::attn_unit(QF + ((size_t)bh * SEQ + qb * 256) * QKD, KF + (size_t)bh * SKV * QKD, VF + (size_t)bh * SKV * VD,
                           AO + ((size_t)b * SEQ + qb * 256) * DM + h * VD, (char*)lds);
        }
    }
    SEAM(5);

    if (IN(6)) {
        { pg8::Gemm g{AO, WBRA, NTOK, DM, 1024, DM, 1024}; pg8::StaticOrder S; S.init(NTOK, DM, G, bx);
          pg8::EpiM1 E{TMP, P + PC_GA, PCOLS};
          pg8::gemm_phase<pg8::EpiM1, pg8::StaticOrder>((LAS unsigned char*)lds, g, S, E); }
        { pg8::Gemm g{AO + 1024, WBRS, NTOK, DM, 1024, DM, 1024}; pg8::StaticOrder S; S.init(NTOK, DM, G, bx);
          pg8::EpiM2 E{TMP, P + PC_GS, PCOLS, MERGED};
          pg8::gemm_phase<pg8::EpiM2, pg8::StaticOrder>((LAS unsigned char*)lds, g, S, E); }
    }
    SEAM(6);

    if (IN(7)) {
        pg8::Gemm g{MERGED, WOUT, NTOK, DM, DM, DM, DM}; pg8::StaticOrder S; S.init(NTOK, DM, G, bx);
        pg8::EpiRes E{x, out, MOD + 2 * DM};
        pg8::gemm_phase<pg8::EpiRes, pg8::StaticOrder>((LAS unsigned char*)lds, g, S, E);
    }
    SEAM(7);

    if (IN(8)) {
        for (int row = gw; row < NTOK; row += NGW) {
            const float* src = out + (size_t)row * DM; const int b = row / SEQ;
            const float* sh = MOD + (size_t)b * NMOD + 3 * DM; const float* scp = sh + DM;
            f32x4 v[8]; float ss = 0.f;
#pragma unroll
            for (int j = 0; j < 8; ++j) { v[j] = *(const f32x4*)(src + (lane + 64 * j) * 4); ss += (v[j].x * v[j].x + v[j].y * v[j].y) + (v[j].z * v[j].z + v[j].w * v[j].w); }
            const float r = 1.0f / sqrtf(wave_sum(ss) * (1.0f / DM) + EPS);
#pragma unroll
            for (int j = 0; j < 8; ++j) { const int idx = (lane + 64 * j) * 4; const f32x4 g = *(const f32x4*)(norm2_g + idx), s1 = *(const f32x4*)(scp + idx), s0 = *(const f32x4*)(sh + idx);
                const f32x4 o = (v[j] * r * g) * (s1 + 1.0f) + s0;
                u32x2 w; w.x = pk2(o.x, o.y); w.y = pk2(o.z, o.w); *(u32x2*)(H2 + (size_t)row * DM + idx) = w; }
        }
    }
    SEAM(8);

    if (IN(9)) {
        pg8::Gemm g{H2, WFI, NTOK, 2 * DFF, DM, DM, DM}; pg8::StaticOrder S; S.init(NTOK, 2 * DFF, G, bx);
        pg8::EpiFfnIn E{ACT};
        pg8::gemm_phase<pg8::EpiFfnIn, pg8::StaticOrder>((LAS unsigned char*)lds, g, S, E);
    }
    SEAM(9);

    if (IN(10)) {
        pg8::Gemm g{ACT, WFO, NTOK, DM, DFF, DFF, DFF}; pg8::StaticOrder S; S.init(NTOK, DM, G, bx);
        pg8::EpiRes E{out, out, MOD + 5 * DM};
        pg8::gemm_phase<pg8::EpiRes, pg8::StaticOrder>((LAS unsigned char*)lds, g, S, E);
    }
#undef IN
#undef SEAM
}

constexpr int N_PHASES = 11;

extern "C" void kernel_launch(void* const* d_in, const int* in_sizes, int n_in, void* d_out, int out_size, void* d_ws, size_t ws_size, hipStream_t stream) {
    static int grid = 0;
    if (grid == 0) {
        if (n_in != 24 || out_size != NTOK * DM || ws_size < WS_END) { fprintf(stderr, "kernel_launch: unexpected shapes n_in %d out %d ws %zu\n", n_in, out_size, ws_size); grid = -1; return; }
        int dev = 0, cus = 0, per_cu = 0;
        hipGetDevice(&dev); hipDeviceGetAttribute(&cus, hipDeviceAttributeMultiprocessorCount, dev);
        if (hipFuncSetAttribute((const void*)fwd_kernel, hipFuncAttributeMaxDynamicSharedMemorySize, LDS_BYTES) != hipSuccess) { fprintf(stderr, "kernel_launch: hipFuncSetAttribute failed\n"); grid = -1; return; }
        if (hipOccupancyMaxActiveBlocksPerMultiprocessor(&per_cu, (const void*)fwd_kernel, 512, LDS_BYTES) != hipSuccess || per_cu < 1) { fprintf(stderr, "kernel_launch: occupancy query says %d\n", per_cu); per_cu = 1; }
        (void)hipGetLastError();
        grid = cus * per_cu;
    }
    if (grid < 0) return;
    Args a{};
    for (int i = 0; i < 24; ++i) a.in[i] = (const float*)d_in[i];
    a.out = (float*)d_out; a.ws = (unsigned char*)d_ws;
#if MK_LAUNCH_PER_PHASE
    for (int p = 0; p < N_PHASES; ++p) { a.ph_lo = p; a.ph_hi = p + 1;
        hipLaunchKernelGGL(fwd_kernel, dim3(grid), dim3(512), LDS_BYTES, stream, a); }
#else
    a.ph_lo = 0; a.ph_hi = N_PHASES;
    void* kargs[] = {&a};
    hipError_t e = hipLaunchCooperativeKernel((const void*)fwd_kernel, dim3(grid), dim3(512), kargs, LDS_BYTES, stream);
    if (e != hipSuccess) fprintf(stderr, "cooperative launch failed: %s (grid %d)\n", hipGetErrorString(e), grid);
#endif
}
```

```cpp
#include <hip/hip_runtime.h>
#include <hip/hip_cooperative_groups.h>
#include <cstdio>
#include <cstdint>
namespace cg = cooperative_groups;

#ifndef MK_LAUNCH_PER_PHASE
#define MK_LAUNCH_PER_PHASE 0
#endif

#define LAS __attribute__((address_space(3)))
typedef unsigned short bf16_t;
typedef short bf16x8 __attribute__((ext_vector_type(8)));
typedef short s16x4 __attribute__((ext_vector_type(4)));
typedef float f32x2 __attribute__((ext_vector_type(2)));
typedef float f32x4 __attribute__((ext_vector_type(4)));
typedef float f32x16 __attribute__((ext_vector_type(16)));
typedef unsigned u32x2 __attribute__((ext_vector_type(2)));
typedef unsigned u32x4 __attribute__((ext_vector_type(4)));

constexpr int DM = 2048, NB = 4, SEQ = 4096, NTOK = NB * SEQ, CTXL = 256, NCTX = NB * CTXL, MROWS = NTOK + NCTX;
constexpr int NH = 8, QL = 512, KVL = 256, QKD = 192, VD = 128;
constexpr int DFF = 5632, NMOD = 6 * DM;
constexpr int SKV = SEQ + CTXL;
constexpr int PCOLS = 7168;
constexpr int PC_KV = 512, PC_KR = 768, PC_U = 1024, PC_V = 2048, PC_GA = 3072, PC_GS = 5120;
constexpr int IN_COLS = 6976;
constexpr float EPS = 1e-6f;

constexpr size_t MiB = 1u << 20;
constexpr size_t WS_MOD = 0;
constexpr size_t WS_WIN = 1 * MiB;
constexpr size_t WS_WUQ = 29 * MiB;
constexpr size_t WS_WUKV = 31 * MiB;
constexpr size_t WS_WBRA = 32 * MiB;
constexpr size_t WS_WBRS = 36 * MiB;
constexpr size_t WS_WOUT = 40 * MiB;
constexpr size_t WS_WFI = 48 * MiB;
constexpr size_t WS_WFO = 92 * MiB;
constexpr size_t WS_WSP = 114 * MiB;
constexpr size_t WS_H = 116 * MiB;
constexpr size_t WS_P = 184 * MiB;
constexpr size_t WS_KF = 422 * MiB;
constexpr size_t WS_VF = 473 * MiB;
constexpr size_t WS_MERGED = 422 * MiB;
constexpr size_t WS_END = 512 * MiB;
constexpr size_t DO_QF = 48 * MiB;

constexpr int LDS_BYTES = 139264;

__device__ __forceinline__ unsigned f2bf(float f) { unsigned u = __builtin_bit_cast(unsigned, f); return (u + 0x7fffu + ((u >> 16) & 1u)) >> 16; }
__device__ __forceinline__ unsigned pk2(float lo, float hi) { return f2bf(lo) | (f2bf(hi) << 16); }
__device__ __forceinline__ float bf2f(unsigned short b) { return __builtin_bit_cast(float, ((unsigned)b) << 16); }
__device__ __forceinline__ float bflo(unsigned w) { return __builtin_bit_cast(float, w << 16); }
__device__ __forceinline__ float bfhi(unsigned w) { return __builtin_bit_cast(float, w & 0xffff0000u); }
__device__ __forceinline__ float wave_sum(float v) {
#pragma unroll
    for (int o = 1; o < 64; o <<= 1) v += __shfl_xor(v, o);
    return v;
}
#define LDS_WAIT() asm volatile("s_waitcnt lgkmcnt(0)" ::: "memory")

namespace pg8 {
#define PG8_LAS __attribute__((address_space(3)))
constexpr int BM = 256, BK = 64, HALF = 128, HTB = HALF * BK * 2, STAGE_BYTES = 8 * HTB, NXCD = 8, WGM = 8;
__host__ __device__ __forceinline__ int lds_byte(int r, int c) { const int st = (r >> 4) * 2 + (c >> 5), rr = r & 15, cc = c & 31, ob = rr * 64 + cc * 2; return st * 1024 + (ob ^ (((ob >> 9) & 1) << 5)); }
__host__ __device__ __forceinline__ void stage_rc(int b, int& R, int& C) { const int st = b / 1024, sb = b % 1024, swz = sb ^ (((sb >> 9) & 1) << 5); R = (st >> 1) * 16 + swz / 64; C = (st & 1) * 32 + (swz % 64) / 2; }
__host__ __device__ __forceinline__ int perm32(int rho) { const int n = rho >> 4, i = rho & 15; return 8 * (i >> 2) + 4 * n + (i & 3); }

struct Unit { int pm, pn; };
struct Gemm { const bf16_t* A; const bf16_t* Bt; int M, N, K, lda, ldb; };

struct StaticOrder {
    int nM, nN, nwg, G, c;
    __device__ void init(int M, int N, int G_, int c_) { nM = M / BM; nN = N / BM; nwg = nM * nN; G = G_; c = c_; }
    __device__ bool next(int i, Unit& u) const {
        const long L = (long)i * G + c; if (L >= nwg) return false;
        int wgid = (int)L; { const int q = nwg / NXCD, r = nwg % NXCD, xcd = wgid % NXCD, off = wgid / NXCD; wgid = (xcd < r ? xcd * (q + 1) : r * (q + 1) + (xcd - r) * q) + off; }
        const int nig = WGM * nN, gid = wgid / nig, fm = gid * WGM, gsz = (nM - fm) < WGM ? (nM - fm) : WGM;
        u.pm = fm + ((wgid % nig) % gsz); u.pn = (wgid % nig) / gsz; return true;
    }
    __device__ __forceinline__ void a_ready(const Unit&) const {}
    __device__ __forceinline__ void done(const Unit&) const {}
};
struct ProjOrder {
    StaticOrder S; int G, c;
    __device__ void init(int G_, int c_) { S.init(NTOK, PCOLS, G_, c_); G = G_; c = c_; }
    __device__ bool next(int i, Unit& u) const {
        const long L = (long)i * G + c;
        if (L < S.nwg) return S.next(i, u);
        const int j = (int)(L - S.nwg); if (j >= 8) return false;
        u.pm = 64 + (j >> 1); u.pn = 2 + (j & 1); return true;
    }
    __device__ __forceinline__ void a_ready(const Unit&) const {}
    __device__ __forceinline__ void done(const Unit&) const {}
};

__device__ __forceinline__ unsigned cvt_pk_bf16(float lo, float hi) { unsigned r; asm volatile("v_cvt_pk_bf16_f32 %0, %1, %2" : "=v"(r) : "v"(lo), "v"(hi)); return r; }
__device__ __forceinline__ f32x2 gelu_pk(f32x2 v) {
    const f32x2 av = __builtin_elementwise_abs(v), d = av * 0.2316418882f + 1.0f;
    f32x2 t; t.x = __builtin_amdgcn_rcpf(d.x); t.y = __builtin_amdgcn_rcpf(d.y);
    f32x2 q = t * 0.5307027145f + (-0.7265760135f); q = q * t + 0.7107068705f; q = q * t + (-0.142248368f); q = q * t + 0.127414796f; q = q * t;
    const f32x2 s = (v * v) * (-0.72134752044f);
    f32x2 e; e.x = __builtin_amdgcn_exp2f(s.x); e.y = __builtin_amdgcn_exp2f(s.y);
    const f32x2 m = v * (q * e), r = v - m;
    f32x2 o; o.x = v.x < 0.f ? m.x : r.x; o.y = v.y < 0.f ? m.y : r.y; return o;
}
__device__ __forceinline__ float sigm(float x) { return __builtin_amdgcn_rcpf(1.0f + __builtin_amdgcn_exp2f(-1.4426950408889634f * x)); }

struct EpiProj {
    static constexpr bool PERM = true, AFTER_DRAIN = false;
    bf16_t* O; int ldc;
    __device__ __forceinline__ void operator()(const f32x4 (&acc)[2][2][4][2], const Unit& u, int wr, int wc, int fr, int fq) const {
        const int row0 = u.pm * BM + wr * 64 + fr, col0 = u.pn * BM + wc * 32 + 8 * fq;
        const int act = (u.pn < 4) ? 0 : (u.pn < 12 ? 1 : 2);
#pragma unroll
        for (int ai = 0; ai < 2; ++ai)
#pragma unroll
            for (int m = 0; m < 4; ++m) { bf16_t* rowp = O + (size_t)(row0 + ai * HALF + m * 16) * ldc + col0;
#pragma unroll
                for (int bj = 0; bj < 2; ++bj) { f32x4 v0 = acc[ai][bj][m][0], v1 = acc[ai][bj][m][1];
                    if (act == 1) { f32x2 a = gelu_pk((f32x2){v0[0], v0[1]}), b = gelu_pk((f32x2){v0[2], v0[3]}), c = gelu_pk((f32x2){v1[0], v1[1]}), d = gelu_pk((f32x2){v1[2], v1[3]});
                        v0 = (f32x4){a.x, a.y, b.x, b.y}; v1 = (f32x4){c.x, c.y, d.x, d.y}; }
                    else if (act == 2) {
#pragma unroll
                        for (int j = 0; j < 4; ++j) { v0[j] = sigm(v0[j]); v1[j] = sigm(v1[j]); } }
                    u32x4 w; w.x = cvt_pk_bf16(v0[0], v0[1]); w.y = cvt_pk_bf16(v0[2], v0[3]); w.z = cvt_pk_bf16(v1[0], v1[1]); w.w = cvt_pk_bf16(v1[2], v1[3]);
                    *(u32x4*)(rowp + bj * HALF) = w; } }
    }
};
struct EpiBf16 {
    static constexpr bool PERM = true, AFTER_DRAIN = false;
    bf16_t* O; int ldc;
    __device__ __forceinline__ void operator()(const f32x4 (&acc)[2][2][4][2], const Unit& u, int wr, int wc, int fr, int fq) const {
        const int row0 = u.pm * BM + wr * 64 + fr, col0 = u.pn * BM + wc * 32 + 8 * fq;
#pragma unroll
        for (int ai = 0; ai < 2; ++ai)
#pragma unroll
            for (int m = 0; m < 4; ++m) { bf16_t* rowp = O + (size_t)(row0 + ai * HALF + m * 16) * ldc + col0;
#pragma unroll
                for (int bj = 0; bj < 2; ++bj) { const f32x4 v0 = acc[ai][bj][m][0], v1 = acc[ai][bj][m][1];
                    u32x4 w; w.x = cvt_pk_bf16(v0[0], v0[1]); w.y = cvt_pk_bf16(v0[2], v0[3]); w.z = cvt_pk_bf16(v1[0], v1[1]); w.w = cvt_pk_bf16(v1[2], v1[3]);
                    *(u32x4*)(rowp + bj * HALF) = w; } }
    }
};
struct EpiM1 {
    static constexpr bool PERM = false, AFTER_DRAIN = false;
    float* T; const bf16_t* G; int ldg;
    __device__ __forceinline__ void operator()(const f32x4 (&acc)[2][2][4][2], const Unit& u, int wr, int wc, int fr, int fq) const {
        const int row0 = u.pm * BM + wr * 64 + fr, col0 = u.pn * BM + wc * 32 + 4 * fq;
#pragma unroll
        for (int ai = 0; ai < 2; ++ai)
#pragma unroll
            for (int m = 0; m < 4; ++m) { const size_t r = (size_t)(row0 + ai * HALF + m * 16); float* rowp = T + r * DM + col0; const bf16_t* gp = G + r * ldg + col0;
#pragma unroll
                for (int bj = 0; bj < 2; ++bj)
#pragma unroll
                    for (int n = 0; n < 2; ++n) { const u32x2 g = *(const u32x2*)(gp + bj * HALF + n * 16); const f32x4 a = acc[ai][bj][m][n];
                        *(f32x4*)(rowp + bj * HALF + n * 16) = (f32x4){a[0] * bflo(g.x), a[1] * bfhi(g.x), a[2] * bflo(g.y), a[3] * bfhi(g.y)}; } }
    }
};
struct EpiM2 {
    static constexpr bool PERM = true, AFTER_DRAIN = false;
    const float* T; const bf16_t* G; int ldg; bf16_t* O;
    __device__ __forceinline__ void operator()(const f32x4 (&acc)[2][2][4][2], const Unit& u, int wr, int wc, int fr, int fq) const {
        const int row0 = u.pm * BM + wr * 64 + fr, col0 = u.pn * BM + wc * 32 + 8 * fq;
#pragma unroll
        for (int ai = 0; ai < 2; ++ai)
#pragma unroll
            for (int m = 0; m < 4; ++m) { const size_t r = (size_t)(row0 + ai * HALF + m * 16);
#pragma unroll
                for (int bj = 0; bj < 2; ++bj) { const int c = col0 + bj * HALF;
                    const u32x4 g = *(const u32x4*)(G + r * ldg + c); const f32x4 t0 = *(const f32x4*)(T + r * DM + c), t1 = *(const f32x4*)(T + r * DM + c + 4);
                    const f32x4 a0 = acc[ai][bj][m][0], a1 = acc[ai][bj][m][1];
                    u32x4 w; w.x = cvt_pk_bf16(t0[0] + a0[0] * bflo(g.x), t0[1] + a0[1] * bfhi(g.x)); w.y = cvt_pk_bf16(t0[2] + a0[2] * bflo(g.y), t0[3] + a0[3] * bfhi(g.y));
                    w.z = cvt_pk_bf16(t1[0] + a1[0] * bflo(g.z), t1[1] + a1[1] * bfhi(g.z)); w.w = cvt_pk_bf16(t1[2] + a1[2] * bflo(g.w), t1[3] + a1[3] * bfhi(g.w));
                    *(u32x4*)(O + r * DM + c) = w; } }
    }
};
struct EpiRes {
    static constexpr bool PERM = false, AFTER_DRAIN = false;
    const float* base; float* out; const float* gate;
    __device__ __forceinline__ void operator()(const f32x4 (&acc)[2][2][4][2], const Unit& u, int wr, int wc, int fr, int fq) const {
        const int row0 = u.pm * BM + wr * 64 + fr, col0 = u.pn * BM + wc * 32 + 4 * fq;
        const float* gp = gate + (size_t)(u.pm >> 4) * NMOD + col0;
        f32x4 gv[2][2];
#pragma unroll
        for (int bj = 0; bj < 2; ++bj)
#pragma unroll
            for (int n = 0; n < 2; ++n) gv[bj][n] = *(const f32x4*)(gp + bj * HALF + n * 16);
#pragma unroll
        for (int ai = 0; ai < 2; ++ai)
#pragma unroll
            for (int m = 0; m < 4; ++m) { const size_t off = (size_t)(row0 + ai * HALF + m * 16) * DM + col0;
#pragma unroll
                for (int bj = 0; bj < 2; ++bj)
#pragma unroll
                    for (int n = 0; n < 2; ++n) { const f32x4 b = *(const f32x4*)(base + off + bj * HALF + n * 16);
                        *(f32x4*)(out + off + bj * HALF + n * 16) = b + gv[bj][n] * acc[ai][bj][m][n]; } }
    }
};
struct EpiFfnIn {
    static constexpr bool PERM = true, AFTER_DRAIN = false;
    bf16_t* O;
    __device__ __forceinline__ void operator()(const f32x4 (&acc)[2][2][4][2], const Unit& u, int wr, int wc, int fr, int fq) const {
        const int row0 = u.pm * BM + wr * 64 + fr, col0 = u.pn * HALF + wc * 32 + 8 * fq;
#pragma unroll
        for (int ai = 0; ai < 2; ++ai)
#pragma unroll
            for (int m = 0; m < 4; ++m) { bf16_t* rowp = O + (size_t)(row0 + ai * HALF + m * 16) * DFF + col0;
                float o[8];
#pragma unroll
                for (int n = 0; n < 2; ++n)
#pragma unroll
                    for (int j = 0; j < 4; ++j) { const float a = acc[ai][0][m][n][j], b = acc[ai][1][m][n][j]; o[n * 4 + j] = a * sigm(a) * b; }
                u32x4 w; w.x = cvt_pk_bf16(o[0], o[1]); w.y = cvt_pk_bf16(o[2], o[3]); w.z = cvt_pk_bf16(o[4], o[5]); w.w = cvt_pk_bf16(o[6], o[7]);
                *(u32x4*)rowp = w; }
    }
};

template <class Epi, class Sched, bool ALIGN_EPI = true, bool SP2 = true>
__device__ __forceinline__ void gemm_phase(PG8_LAS unsigned char* lds, const Gemm g, const Sched& S, const Epi& E) {
    const int tid = threadIdx.x, wid = __builtin_amdgcn_readfirstlane(tid >> 6), lane = tid & 63, wr = wid >> 2, wc = wid & 3, fr = lane & 15, fq = lane >> 4;
    const int K = g.K, nt = K / BK;
    unsigned voffA[2], voffB[2];
#pragma unroll
    for (int i = 0; i < 2; ++i) { int R, C; stage_rc(tid * 16 + i * 8192, R, C); const int Rb = Epi::PERM ? ((R & ~31) + perm32(R & 31)) : R;
        voffA[i] = (unsigned)(R * g.lda + C) * 2u; voffB[i] = (unsigned)(Rb * g.ldb + C) * 2u; }
    const size_t kstep = (size_t)(BK * 2);
    const size_t hstepA = (size_t)HALF * g.lda * 2, hstepB = (size_t)HALF * g.ldb * 2;
    const size_t tstepA = 2 * hstepA, tstepB = 2 * hstepB;
    const unsigned ldsw = (unsigned)wid * 1024u;
    const int aoff = lds_byte(wr * 64 + fr, fq * 8), boff = lds_byte(wc * 32 + fr, fq * 8);
#define PG8_SA(b, h) (((b) * 2 + (h)) * HTB)
#define PG8_SB(b, h) ((4 + (b) * 2 + (h)) * HTB)
#define PG8_STAGE(bufoff, gbase, voff) do { _Pragma("unroll") for (int _i = 0; _i < 2; ++_i) \
        __builtin_amdgcn_global_load_lds((const unsigned*)((const char*)(gbase) + (voff)[_i]), (PG8_LAS unsigned*)(lds + (bufoff) + ldsw + _i * 8192), 16, 0, 0); } while (0)
#define PG8_LDA(dst, b, h) do { _Pragma("unroll") for (int m = 0; m < 4; ++m) _Pragma("unroll") for (int k = 0; k < 2; ++k) dst[m][k] = *(const PG8_LAS bf16x8*)(lds + PG8_SA(b, h) + aoff + m * 2048 + k * 1024); } while (0)
#define PG8_LDB(dst, b, h) do { _Pragma("unroll") for (int n = 0; n < 2; ++n) _Pragma("unroll") for (int k = 0; k < 2; ++k) dst[n][k] = *(const PG8_LAS bf16x8*)(lds + PG8_SB(b, h) + boff + n * 2048 + k * 1024); } while (0)
#define PG8_MMA(ai, bj, At, Bt) do { __builtin_amdgcn_s_setprio(1); _Pragma("unroll") for (int m = 0; m < 4; ++m) _Pragma("unroll") for (int n = 0; n < 2; ++n) _Pragma("unroll") for (int k = 0; k < 2; ++k) \
        acc[ai][bj][m][n] = __builtin_amdgcn_mfma_f32_16x16x32_bf16(Bt[n][k], At[m][k], acc[ai][bj][m][n], 0, 0, 0); __builtin_amdgcn_s_setprio(0); } while (0)
#define PG8_WAIT_V(n) asm volatile("s_waitcnt vmcnt(" #n ")" ::: "memory")
#define PG8_WAIT_L(n) asm volatile("s_waitcnt lgkmcnt(" #n ")" ::: "memory")
#define PG8_BAR __builtin_amdgcn_s_barrier()
#define PG8_SCHED __builtin_amdgcn_sched_barrier(0)
    Unit cur, nxt; int ui = 0;
    if (!S.next(0, cur)) return;
    f32x4 acc[2][2][4][2];
#pragma unroll
    for (int a = 0; a < 2; ++a)
#pragma unroll
        for (int b = 0; b < 2; ++b)
#pragma unroll
            for (int m = 0; m < 4; ++m)
#pragma unroll
                for (int n = 0; n < 2; ++n) acc[a][b][m][n] = (f32x4){0.f, 0.f, 0.f, 0.f};
    bf16x8 At[4][2], B0[2][2], B1[2][2];
    const char* cA = (const char*)g.A + (size_t)cur.pm * tstepA; const char* cB = (const char*)g.Bt + (size_t)cur.pn * tstepB;
    S.a_ready(cur);
    if constexpr (SP2) {
        PG8_STAGE(PG8_SB(0, 0), cB, voffB); PG8_STAGE(PG8_SB(0, 1), cB + hstepB, voffB); PG8_STAGE(PG8_SA(0, 0), cA, voffA); PG8_STAGE(PG8_SA(0, 1), cA + hstepA, voffA);
        if (wr == 1) PG8_BAR;
        PG8_WAIT_V(2); PG8_BAR;
        PG8_STAGE(PG8_SB(1, 0), cB + kstep, voffB); PG8_STAGE(PG8_SA(1, 0), cA + kstep, voffA); PG8_STAGE(PG8_SB(1, 1), cB + hstepB + kstep, voffB);
        PG8_WAIT_V(6); PG8_BAR;
    } else {
        PG8_STAGE(PG8_SB(0, 0), cB, voffB); PG8_STAGE(PG8_SA(0, 0), cA, voffA); PG8_STAGE(PG8_SB(0, 1), cB + hstepB, voffB); PG8_STAGE(PG8_SA(0, 1), cA + hstepA, voffA);
        if (wr == 1) PG8_BAR;
        PG8_WAIT_V(4); PG8_BAR;
        PG8_STAGE(PG8_SB(1, 0), cB + kstep, voffB); PG8_STAGE(PG8_SA(1, 0), cA + kstep, voffA); PG8_STAGE(PG8_SB(1, 1), cB + hstepB + kstep, voffB);
        PG8_WAIT_V(6); PG8_BAR;
    }
    for (;;) {
        const bool has_next = S.next(ui + 1, nxt);
        const char* nA = has_next ? (const char*)g.A + (size_t)nxt.pm * tstepA : cA; const char* nB = has_next ? (const char*)g.Bt + (size_t)nxt.pn * tstepB : cB;
        for (int t = 0; t < nt; t += 2) {
            const bool last = (t == nt - 2);
            const char* a1 = cA + (size_t)(t + 1) * kstep;
            const char* a2 = last ? nA : cA + (size_t)(t + 2) * kstep; const char* b2 = last ? nB : cB + (size_t)(t + 2) * kstep;
            const char* a3 = a2 + kstep; const char* b3 = b2 + kstep;
            if (last && has_next) S.a_ready(nxt);
            if constexpr (SP2) {
            PG8_LDB(B0, 0, 0); PG8_LDB(B1, 0, 1); PG8_SCHED; PG8_LDA(At, 0, 0); PG8_STAGE(PG8_SA(1, 1), a1 + hstepA, voffA);
            PG8_WAIT_V(8); PG8_WAIT_L(0); PG8_BAR; PG8_MMA(0, 0, At, B0); PG8_MMA(0, 1, At, B1); PG8_BAR; PG8_SCHED;
            PG8_LDA(At, 0, 1); PG8_STAGE(PG8_SB(0, 0), b2, voffB); PG8_STAGE(PG8_SB(0, 1), b2 + hstepB, voffB); PG8_STAGE(PG8_SA(0, 0), a2, voffA);
            PG8_WAIT_V(8); PG8_WAIT_L(0); PG8_BAR; PG8_MMA(1, 0, At, B0); PG8_MMA(1, 1, At, B1); PG8_BAR; PG8_SCHED;
            PG8_LDB(B0, 1, 0); PG8_LDB(B1, 1, 1); PG8_SCHED; PG8_LDA(At, 1, 0); PG8_STAGE(PG8_SA(0, 1), a2 + hstepA, voffA);
            PG8_WAIT_V(8); PG8_WAIT_L(0); PG8_BAR; PG8_MMA(0, 0, At, B0); PG8_MMA(0, 1, At, B1); PG8_BAR; PG8_SCHED;
            PG8_LDA(At, 1, 1); PG8_STAGE(PG8_SB(1, 0), b3, voffB); PG8_STAGE(PG8_SB(1, 1), b3 + hstepB, voffB); PG8_STAGE(PG8_SA(1, 0), a3, voffA);
            PG8_WAIT_V(8); PG8_WAIT_L(0); PG8_BAR; PG8_MMA(1, 0, At, B0); PG8_MMA(1, 1, At, B1); PG8_BAR; PG8_SCHED;
            } else {
            PG8_LDB(B0, 0, 0); PG8_SCHED; PG8_LDA(At, 0, 0); PG8_STAGE(PG8_SA(1, 1), a1 + hstepA, voffA);
            PG8_WAIT_L(8); PG8_BAR; PG8_WAIT_L(0); PG8_MMA(0, 0, At, B0); PG8_BAR; PG8_SCHED;
            PG8_LDB(B1, 0, 1); PG8_STAGE(PG8_SB(0, 0), b2, voffB);
            PG8_BAR; PG8_WAIT_L(0); PG8_MMA(0, 1, At, B1); PG8_BAR;
            PG8_LDA(At, 0, 1); PG8_STAGE(PG8_SA(0, 0), a2, voffA);
            PG8_BAR; PG8_WAIT_L(0); PG8_MMA(1, 0, At, B0); PG8_BAR; PG8_SCHED;
            PG8_STAGE(PG8_SB(0, 1), b2 + hstepB, voffB);
            PG8_WAIT_V(6); PG8_BAR; PG8_MMA(1, 1, At, B1); PG8_BAR;
            PG8_LDB(B0, 1, 0); PG8_SCHED; PG8_LDA(At, 1, 0); PG8_STAGE(PG8_SA(0, 1), a2 + hstepA, voffA);
            PG8_WAIT_L(8); PG8_BAR; PG8_WAIT_L(0); PG8_MMA(0, 0, At, B0); PG8_BAR; PG8_SCHED;
            PG8_LDB(B1, 1, 1); PG8_STAGE(PG8_SB(1, 0), b3, voffB);
            PG8_BAR; PG8_WAIT_L(0); PG8_MMA(0, 1, At, B1); PG8_BAR;
            PG8_LDA(At, 1, 1); PG8_STAGE(PG8_SA(1, 0), a3, voffA);
            PG8_BAR; PG8_WAIT_L(0); PG8_MMA(1, 0, At, B0); PG8_BAR; PG8_SCHED;
            PG8_STAGE(PG8_SB(1, 1), b3 + hstepB, voffB);
            PG8_WAIT_V(6); PG8_BAR; PG8_MMA(1, 1, At, B1); PG8_BAR;
            }
        }
        if constexpr (ALIGN_EPI) { if (wr == 0) PG8_BAR; }
        if constexpr (!Epi::AFTER_DRAIN) { E(acc, cur, wr, wc, fr, fq); S.done(cur); }
        if (!has_next) break;
#pragma unroll
        for (int a = 0; a < 2; ++a)
#pragma unroll
            for (int b = 0; b < 2; ++b)
#pragma unroll
                for (int m = 0; m < 4; ++m)
#pragma unroll
                    for (int n = 0; n < 2; ++n) acc[a][b][m][n] = (f32x4){0.f, 0.f, 0.f, 0.f};
        cur = nxt; cA = nA; cB = nB; ++ui;
        if constexpr (ALIGN_EPI) { if (wr == 1) PG8_BAR; }
    }
    PG8_WAIT_V(0);
    if constexpr (!ALIGN_EPI) { if (wr == 0) PG8_BAR; }
    PG8_BAR;
#undef PG8_SA
#undef PG8_SB
#undef PG8_STAGE
#undef PG8_LDA
#undef PG8_LDB
#undef PG8_MMA
#undef PG8_WAIT_V
#undef PG8_WAIT_L
#undef PG8_BAR
#undef PG8_SCHED
}
}

namespace att {
constexpr int NW = 8, QBLK = 32, KVBLK = 64;
constexpr float SCALE = 0.07216878364870323f;
constexpr float THR = 8.f;
constexpr size_t SHM_V = KVBLK * VD * 2, SHM_K = KVBLK * QKD * 2;
constexpr size_t SHM_ATTN = 2 * SHM_V + 2 * SHM_K + NW * 64 * 4;
#define KSWZ(row, colB) ((row) * 384 + ((colB) ^ (((row) & 7) << 4)))
#define SBAR() __builtin_amdgcn_sched_barrier(0)
__device__ __forceinline__ int crow(int r, int hi) { return (r & 3) + 8 * (r >> 2) + 4 * hi; }
__device__ __forceinline__ unsigned cvtpk(float lo, float hi) { unsigned r; asm volatile("v_cvt_pk_bf16_f32 %0, %1, %2" : "=v"(r) : "v"(lo), "v"(hi)); return r; }

__device__ __forceinline__ void partialSM(f32x16& p0, f32x16& p1, float& m_reg, float& mn, float& alpha) {
  constexpr float C = SCALE * 1.4426950408889634f;
  float pmax = p0[0];
#pragma unroll
  for (int r = 1; r < 16; ++r) pmax = fmaxf(pmax, p0[r]);
#pragma unroll
  for (int r = 0; r < 16; ++r) pmax = fmaxf(pmax, p1[r]);
  { auto rr = __builtin_amdgcn_permlane32_swap(__float_as_uint(pmax), __float_as_uint(pmax), false, false);
    pmax = fmaxf(__uint_as_float(rr[0]), __uint_as_float(rr[1])); }
  if (__builtin_expect(__all(pmax - m_reg <= THR / SCALE), 1)) { mn = m_reg; alpha = 1.f; }
  else { mn = fmaxf(m_reg, pmax); alpha = __builtin_amdgcn_exp2f((m_reg - mn) * C); m_reg = mn; }
  float mnC = -mn * C;
#pragma unroll
  for (int r = 0; r < 16; ++r) p0[r] = fmaf(p0[r], C, mnC);
#pragma unroll
  for (int r = 0; r < 16; ++r) p1[r] = fmaf(p1[r], C, mnC);
#pragma unroll
  for (int r = 0; r < 16; ++r) p0[r] = __builtin_amdgcn_exp2f(p0[r]);
}
__device__ __forceinline__ void finishSM(f32x16& p0, f32x16& p1, float alpha, float& l_reg, bf16x8& pa0, bf16x8& pa1, bf16x8& pa2, bf16x8& pa3) {
#pragma unroll
  for (int r = 0; r < 16; ++r) p1[r] = __builtin_amdgcn_exp2f(p1[r]);
  float ps = 0;
#pragma unroll
  for (int r = 0; r < 16; ++r) ps += p0[r];
#pragma unroll
  for (int r = 0; r < 16; ++r) ps += p1[r];
  { auto rr = __builtin_amdgcn_permlane32_swap(__float_as_uint(ps), __float_as_uint(ps), false, false);
    ps = __uint_as_float(rr[0]) + __uint_as_float(rr[1]); }
  l_reg = l_reg * alpha + ps;
#define PK4(P, BASE, OUT) do { unsigned a0 = cvtpk(P[BASE + 0], P[BASE + 1]), a1 = cvtpk(P[BASE + 2], P[BASE + 3]);   \
    unsigned b0 = cvtpk(P[BASE + 4], P[BASE + 5]), b1 = cvtpk(P[BASE + 6], P[BASE + 7]);                              \
    auto r0 = __builtin_amdgcn_permlane32_swap(a0, b0, false, false); auto r1 = __builtin_amdgcn_permlane32_swap(a1, b1, false, false); \
    u32x4 w = {r0[0], r1[0], r0[1], r1[1]}; OUT = *reinterpret_cast<bf16x8*>(&w); } while (0)
  PK4(p0, 0, pa0); PK4(p0, 8, pa1); PK4(p1, 0, pa2); PK4(p1, 8, pa3);
#undef PK4
}
__device__ __forceinline__ void qkt(f32x16& p0, f32x16& p1, const char* Ks, const bf16x8* qr, int r32, int hi) {
  p0 = f32x16{}; p1 = f32x16{};
#pragma unroll
  for (int d0 = 0; d0 < 12; ++d0) { int cb = (d0 * 16 + hi * 8) * 2;
    bf16x8 b0 = *reinterpret_cast<const bf16x8*>(Ks + KSWZ(r32, cb));
    bf16x8 b1 = *reinterpret_cast<const bf16x8*>(Ks + KSWZ(32 + r32, cb));
    p0 = __builtin_amdgcn_mfma_f32_32x32x16_bf16(b0, qr[d0], p0, 0, 0, 0);
    p1 = __builtin_amdgcn_mfma_f32_32x32x16_bf16(b1, qr[d0], p1, 0, 0, 0); }
}
__device__ __forceinline__ int v_st(int k, int c) { const int kk = (k & ~0xC) | ((k & 4) << 1) | ((k & 8) >> 1); return ((kk >> 3) * 4 + (c >> 5)) * 512 + ((kk & 7) * 32 + (c & 31)) * 2; }
__device__ __forceinline__ int v_rd_base(int lane) { return ((lane & 3) << 3) | (((lane >> 2) & 3) << 6) | (((lane >> 4) & 1) << 5) | (((lane >> 5) & 1) << 8); }
constexpr int v_rd_off(int d0, int ks, int half) { return d0 * 512 + ks * 4096 + half * 2048; }
template <int OFF> __device__ __forceinline__ s16x4 tr_read(int vb) {
  s16x4 r; asm volatile("ds_read_b64_tr_b16 %0, %1 offset:%2" : "=&v"(r) : "v"(vb), "i"(OFF) : "memory"); return r;
}
template <int D0> __device__ __forceinline__ void pv_one(f32x16& od, int vb, bf16x8 pa0, bf16x8 pa1, bf16x8 pa2, bf16x8 pa3) {
  const s16x4 l0 = tr_read<v_rd_off(D0, 0, 0)>(vb), h0 = tr_read<v_rd_off(D0, 0, 1)>(vb), l1 = tr_read<v_rd_off(D0, 1, 0)>(vb), h1 = tr_read<v_rd_off(D0, 1, 1)>(vb);
  const s16x4 l2 = tr_read<v_rd_off(D0, 2, 0)>(vb), h2 = tr_read<v_rd_off(D0, 2, 1)>(vb), l3 = tr_read<v_rd_off(D0, 3, 0)>(vb), h3 = tr_read<v_rd_off(D0, 3, 1)>(vb);
  asm volatile("s_waitcnt lgkmcnt(0)" ::: "memory"); SBAR();
#define PK(L, H) (bf16x8){L[0], L[1], L[2], L[3], H[0], H[1], H[2], H[3]}
  od = __builtin_amdgcn_mfma_f32_32x32x16_bf16(pa0, PK(l0, h0), od, 0, 0, 0);
  od = __builtin_amdgcn_mfma_f32_32x32x16_bf16(pa1, PK(l1, h1), od, 0, 0, 0);
  od = __builtin_amdgcn_mfma_f32_32x32x16_bf16(pa2, PK(l2, h2), od, 0, 0, 0);
  od = __builtin_amdgcn_mfma_f32_32x32x16_bf16(pa3, PK(l3, h3), od, 0, 0, 0);
#undef PK
}
__device__ __forceinline__ void pv_d0(f32x16* o, int vb, bf16x8 pa0, bf16x8 pa1, bf16x8 pa2, bf16x8 pa3) {
  pv_one<0>(o[0], vb, pa0, pa1, pa2, pa3); pv_one<1>(o[1], vb, pa0, pa1, pa2, pa3); pv_one<2>(o[2], vb, pa0, pa1, pa2, pa3); pv_one<3>(o[3], vb, pa0, pa1, pa2, pa3);
}

__device__ __forceinline__ void attn_unit(const bf16_t* __restrict__ Qb, const bf16_t* __restrict__ Kh, const bf16_t* __restrict__ Vh, bf16_t* __restrict__ Ob, char* lds) {
  const int tid = threadIdx.x, wid = tid >> 6, lane = tid & 63, r32 = lane & 31, hi = lane >> 5;
  char* V_lds = lds; char* K_lds = lds + 2 * SHM_V;
  float* wsf = (float*)(lds + 2 * SHM_V + 2 * SHM_K) + wid * 64; float* li_l = wsf; float* al_l = wsf + 32;
  float m_reg = -1e30f, l_reg = 0; f32x16 o[4] = {}; bf16x8 qr[12];
  const bf16_t* Qw = Qb + (long)(wid * QBLK + r32) * QKD + hi * 8;
#pragma unroll
  for (int d0 = 0; d0 < 12; ++d0) qr[d0] = *reinterpret_cast<const bf16x8*>(Qw + d0 * 16);
  const int sr = tid >> 4, sc = (tid & 15) * 8, vst0 = v_st(sr, sc), vst1 = v_st(32 + sr, sc);
  int kst[3];
#pragma unroll
  for (int i = 0; i < 3; ++i) { const int q = tid + i * 512; kst[i] = KSWZ(q / 24, (q % 24) * 16); }
  const int vb0 = (int)(uintptr_t)V_lds + v_rd_base(lane);
  bf16x8 vs0, vs1, ks0, ks1, ks2;
#define SLOAD(k0) do { vs0 = *reinterpret_cast<const bf16x8*>(&Vh[(long)((k0) + sr) * VD + sc]); vs1 = *reinterpret_cast<const bf16x8*>(&Vh[(long)((k0) + 32 + sr) * VD + sc]); \
    const bf16_t* kt_ = Kh + (long)(k0) * QKD + tid * 8; ks0 = *reinterpret_cast<const bf16x8*>(kt_); ks1 = *reinterpret_cast<const bf16x8*>(kt_ + 4096); ks2 = *reinterpret_cast<const bf16x8*>(kt_ + 8192); } while (0)
#define SWRITE(b) do { *(bf16x8*)(V_lds + (b) * SHM_V + vst0) = vs0; *(bf16x8*)(V_lds + (b) * SHM_V + vst1) = vs1; \
    *(bf16x8*)(K_lds + (b) * SHM_K + kst[0]) = ks0; *(bf16x8*)(K_lds + (b) * SHM_K + kst[1]) = ks1; *(bf16x8*)(K_lds + (b) * SHM_K + kst[2]) = ks2; } while (0)
#define SWAIT() asm volatile("s_waitcnt vmcnt(0)" ::: "memory")
#define RESC(a) do { if (__any((a) < 1.f)) { if (hi == 0) al_l[r32] = (a); asm volatile("s_waitcnt lgkmcnt(0)" ::: "memory"); \
    _Pragma("unroll") for (int d = 0; d < 4; ++d) _Pragma("unroll") for (int r = 0; r < 16; ++r) o[d][r] *= al_l[crow(r, hi)]; } } while (0)
  f32x16 p0, p1; float mn, al; bf16x8 pa0, pa1, pa2, pa3; const int NT = SKV / KVBLK;
  SLOAD(0); SWAIT(); SWRITE(0); __syncthreads();
  for (int j = 0; j < NT; ++j) {
    const int cur = j & 1;
    if (j + 1 < NT) SLOAD((j + 1) * KVBLK);
    SBAR(); qkt(p0, p1, K_lds + cur * SHM_K, qr, r32, hi);
    partialSM(p0, p1, m_reg, mn, al);
    RESC(al);
    finishSM(p0, p1, al, l_reg, pa0, pa1, pa2, pa3); SBAR();
    pv_d0(o, vb0 + cur * (int)SHM_V, pa0, pa1, pa2, pa3);
    if (j + 1 < NT) { SWAIT(); SWRITE(cur ^ 1); }
    __syncthreads();
  }
  if (hi == 0) li_l[r32] = l_reg; asm volatile("s_waitcnt lgkmcnt(0)" ::: "memory");
  float rli[16];
#pragma unroll
  for (int r = 0; r < 16; ++r) rli[r] = __builtin_amdgcn_rcpf(li_l[crow(r, hi)]);
  bf16_t* Ow = Ob + (long)(wid * QBLK) * DM;
#pragma unroll
  for (int r = 0; r < 16; ++r) { int orow = crow(r, hi);
#pragma unroll
    for (int d0 = 0; d0 < 4; ++d0) Ow[(long)orow * DM + d0 * 32 + r32] = (bf16_t)f2bf(o[d0][r] * rli[r]); }
  __syncthreads();
#undef SLOAD
#undef SWRITE
#undef SWAIT
#undef RESC
}
}

struct Args { const float* in[24]; float* out; unsigned char* ws; int ph_lo, ph_hi; };

__device__ __forceinline__ void tr_item(const float* __restrict__ W, int ldw, int k0, int c0, bf16_t* __restrict__ WT, int ldt, int r0, const float* __restrict__ gk, LAS float* scr, int lane) {
#pragma unroll 8
    for (int i = 0; i < 32; ++i) { const int kk = 2 * i + (lane >> 5); float v = 0.f;
        if (c0 >= 0) { v = W[(size_t)(k0 + kk) * ldw + c0 + (lane & 31)]; if (gk) v *= gk[k0 + kk]; }
        scr[kk * 33 + (lane & 31)] = v; }
    LDS_WAIT();
    const int c = lane & 7;
#pragma unroll
    for (int j = 0; j < 4; ++j) { const int n = (lane >> 3) + 8 * j; const LAS float* s = scr + (8 * c) * 33 + n;
        u32x4 o; o.x = pk2(s[0 * 33], s[1 * 33]); o.y = pk2(s[2 * 33], s[3 * 33]); o.z = pk2(s[4 * 33], s[5 * 33]); o.w = pk2(s[6 * 33], s[7 * 33]);
        *(u32x4*)(WT + (size_t)(r0 + n) * ldt + k0 + 8 * c) = o; }
    LDS_WAIT();
}

__global__ void __launch_bounds__(512, 2) fwd_kernel(Args args) {
    extern __shared__ __attribute__((aligned(16))) unsigned char lds[];
    const int tid = threadIdx.x, lane = tid & 63, wave = __builtin_amdgcn_readfirstlane(tid >> 6);
    const int G = gridDim.x, bx = blockIdx.x;
    const int vcu = (G % 8 == 0) ? (bx % 8) * (G / 8) + bx / 8 : bx;
    const int gw = vcu * 8 + wave, NGW = G * 8;
    unsigned char* ws = args.ws;
    const float* x = args.in[0]; const float* cvec = args.in[1]; const float* ctx = args.in[2]; const float* c_ctx = args.in[3];
    const float* w_mod = args.in[4]; const float* b_mod = args.in[5]; const float* norm1_g = args.in[6]; const float* w_in = args.in[7];
    const float* q_norm_g = args.in[8]; const float* kv_norm_g = args.in[9]; const float* w_uq = args.in[10]; const float* w_ukv = args.in[11];
    const float* qk_norm_q = args.in[12]; const float* qk_norm_k = args.in[13]; const float* sgu_norm_g = args.in[14]; const float* sgu_norm_b = args.in[15];
    const float* w_spatial = args.in[16]; const float* b_spatial = args.in[17]; const float* w_br_attn = args.in[18]; const float* w_br_sgu = args.in[19];
    const float* w_out = args.in[20]; const float* norm2_g = args.in[21]; const float* w_ffn_in = args.in[22]; const float* w_ffn_out = args.in[23];
    float* out = args.out;
    float* MOD = (float*)(ws + WS_MOD);
    bf16_t* WIN = (bf16_t*)(ws + WS_WIN); bf16_t* WUQ = (bf16_t*)(ws + WS_WUQ); bf16_t* WUKV = (bf16_t*)(ws + WS_WUKV);
    bf16_t* WBRA = (bf16_t*)(ws + WS_WBRA); bf16_t* WBRS = (bf16_t*)(ws + WS_WBRS); bf16_t* WOUT = (bf16_t*)(ws + WS_WOUT);
    bf16_t* WFI = (bf16_t*)(ws + WS_WFI); bf16_t* WFO = (bf16_t*)(ws + WS_WFO); bf16_t* WSP = (bf16_t*)(ws + WS_WSP);
    bf16_t* H = (bf16_t*)(ws + WS_H); bf16_t* KVUP = H; bf16_t* AO = H; bf16_t* H2 = H;
    bf16_t* P = (bf16_t*)(ws + WS_P); bf16_t* ACT = P;
    bf16_t* KF = (bf16_t*)(ws + WS_KF); bf16_t* VF = (bf16_t*)(ws + WS_VF); bf16_t* MERGED = (bf16_t*)(ws + WS_MERGED);
    bf16_t* QUP = (bf16_t*)out; bf16_t* QF = (bf16_t*)((unsigned char*)out + DO_QF); float* TMP = out;
    const int lo = args.ph_lo, hi = args.ph_hi;
#ifndef PH_MASK
#define PH_MASK 0x7ff
#endif
#define IN(k) ((((PH_MASK) >> (k)) & 1) && lo <= (k) && (k) < hi)
#define SEAM(k) do { if (IN(k) && IN((k) + 1)) { cg::this_grid().sync(); } } while (0)

    if (IN(0)) {
        LAS float* sact = (LAS float*)lds;
        LAS float* red = (LAS float*)(lds + 40960);
        for (int i = tid; i < 5 * DM; i += 512) { const float v = (i < 4 * DM) ? cvec[i] : c_ctx[i - 4 * DM]; sact[i] = v / (1.0f + __expf(-v)); }
        __syncthreads();
        for (int cb = bx; cb < NMOD / 48; cb += G) {
            const int n0 = cb * 48, c4 = tid % 12, kg = tid / 12;
            if (kg < 42) {
                f32x4 a[5];
#pragma unroll
                for (int r = 0; r < 5; ++r) a[r] = (f32x4){0.f, 0.f, 0.f, 0.f};
                for (int k = kg; k < DM; k += 42) { const f32x4 w = *(const f32x4*)(w_mod + (size_t)k * NMOD + n0 + c4 * 4);
#pragma unroll
                    for (int r = 0; r < 5; ++r) a[r] += w * sact[r * DM + k]; }
#pragma unroll
                for (int r = 0; r < 5; ++r)
#pragma unroll
                    for (int j = 0; j < 4; ++j) red[(kg * 5 + r) * 48 + c4 * 4 + j] = a[r][j];
            }
            __syncthreads();
            if (tid < 240) { const int r = tid / 48, col = tid % 48; float s = 0.f;
                for (int k2 = 0; k2 < 42; ++k2) s += red[(k2 * 5 + r) * 48 + col];
                MOD[(size_t)r * NMOD + n0 + col] = s + b_mod[n0 + col]; }
            __syncthreads();
        }
        LAS float* scr = (LAS float*)(lds + wave * 16384);
        constexpr int I_IN = 32 * 224, I_UQ = 8 * 48, I_UKV = 4 * 64, I_BR = 16 * 64, I_OUT = 32 * 64, I_FI = 32 * 352, I_FO = 88 * 64;
        constexpr int NITEMS = I_IN + I_UQ + I_UKV + 2 * I_BR + I_OUT + I_FI + I_FO;
        for (int it = gw; it < NITEMS; it += NGW) {
            int r = it;
            if (r < I_IN) { const int kb = r / 224, nb = r % 224, r0 = nb * 32; const int c0 = r0 < 832 ? r0 : (r0 < 1024 ? -1 : r0 - 192);
                tr_item(w_in, IN_COLS, kb * 64, c0, WIN, DM, r0, nullptr, scr, lane); continue; } r -= I_IN;
            if (r < I_UQ) { const int kb = r / 48, nb = r % 48; tr_item(w_uq, NH * QKD, kb * 64, nb * 32, WUQ, QL, nb * 32, q_norm_g, scr, lane); continue; } r -= I_UQ;
            if (r < I_UKV) { const int kb = r / 64, nb = r % 64; tr_item(w_ukv, 2048, kb * 64, nb * 32, WUKV, KVL, nb * 32, kv_norm_g, scr, lane); continue; } r -= I_UKV;
            if (r < I_BR) { const int kb = r / 64, nb = r % 64; tr_item(w_br_attn, DM, kb * 64, nb * 32, WBRA, 1024, nb * 32, nullptr, scr, lane); continue; } r -= I_BR;
            if (r < I_BR) { const int kb = r / 64, nb = r % 64; tr_item(w_br_sgu, DM, kb * 64, nb * 32, WBRS, 1024, nb * 32, nullptr, scr, lane); continue; } r -= I_BR;
            if (r < I_OUT) { const int kb = r / 64, nb = r % 64; tr_item(w_out, DM, kb * 64, nb * 32, WOUT, DM, nb * 32, nullptr, scr, lane); continue; } r -= I_OUT;
            if (r < I_FI) { const int kb = r / 352, nb = r % 352, r0 = nb * 32, pn = r0 >> 8, j = r0 & 255; const int c0 = j < 128 ? pn * 128 + j : DFF + pn * 128 + (j - 128);
                tr_item(w_ffn_in, 2 * DFF, kb * 64, c0, WFI, DM, r0, nullptr, scr, lane); continue; } r -= I_FI;
            { const int kb = r / 64, nb = r % 64; tr_item(w_ffn_out, DM, kb * 64, nb * 32, WFO, DFF, nb * 32, nullptr, scr, lane); }
        }
        for (int i = (bx * 512 + tid); i < 8 * 128 * 128 / 2; i += G * 512) { const f32x2 v = *(const f32x2*)(w_spatial + 2 * (size_t)i); ((unsigned*)WSP)[i] = pk2(v.x, v.y); }
    }
    SEAM(0);

    if (IN(1)) {
        for (int row = gw; row < MROWS; row += NGW) {
            const float* src = row < NTOK ? x + (size_t)row * DM : ctx + (size_t)(row - NTOK) * DM;
            const int b = row < NTOK ? row / SEQ : 4;
            const float* sh = MOD + (size_t)b * NMOD; const float* scp = sh + DM;
            f32x4 v[8]; float ss = 0.f;
#pragma unroll
            for (int j = 0; j < 8; ++j) { v[j] = *(const f32x4*)(src + (lane + 64 * j) * 4); ss += (v[j].x * v[j].x + v[j].y * v[j].y) + (v[j].z * v[j].z + v[j].w * v[j].w); }
            const float r = 1.0f / sqrtf(wave_sum(ss) * (1.0f / DM) + EPS);
#pragma unroll
            for (int j = 0; j < 8; ++j) { const int idx = (lane + 64 * j) * 4; const f32x4 g = *(const f32x4*)(norm1_g + idx), s1 = *(const f32x4*)(scp + idx), s0 = *(const f32x4*)(sh + idx);
                const f32x4 o = (v[j] * r * g) * (s1 + 1.0f) + s0;
                u32x2 w; w.x = pk2(o.x, o.y); w.y = pk2(o.z, o.w); *(u32x2*)(H + (size_t)row * DM + idx) = w; }
        }
    }
    SEAM(1);

    if (IN(2)) {
        pg8::Gemm g{H, WIN, MROWS, PCOLS, DM, DM, DM}; pg8::ProjOrder S; S.init(G, bx);
        pg8::EpiProj E{P, PCOLS};
        pg8::gemm_phase<pg8::EpiProj, pg8::ProjOrder>((LAS unsigned char*)lds, g, S, E);
    }
    SEAM(2);

    if (IN(3)) {
        { pg8::Gemm g{P, WUQ, NTOK, NH * QKD, QL, PCOLS, QL}; pg8::StaticOrder S; S.init(NTOK, NH * QKD, G, bx);
          pg8::EpiBf16 E{QUP, NH * QKD};
          pg8::gemm_phase<pg8::EpiBf16, pg8::StaticOrder>((LAS unsigned char*)lds, g, S, E); }
        { pg8::Gemm g{P + PC_KV, WUKV, MROWS, 2048, KVL, PCOLS, KVL}; pg8::StaticOrder S; S.init(MROWS, 2048, G, bx);
          pg8::EpiBf16 E{KVUP, 2048};
          pg8::gemm_phase<pg8::EpiBf16, pg8::StaticOrder>((LAS unsigned char*)lds, g, S, E); }
    }
    SEAM(3);

    if (IN(4)) {
        for (int t = gw; t < MROWS; t += NGW) {
            const bool lat = t < NTOK;
            const bf16_t* Prow = P + (size_t)t * PCOLS;
            int b, n, m;
            if (lat) { b = t / SEQ; n = t % SEQ; m = n; } else { const int tc = t - NTOK; b = tc / CTXL; n = 0; m = SEQ + tc % CTXL; }
            float r_kv;
            { const u32x2 w = *(const u32x2*)(Prow + PC_KV + lane * 4); const float a0 = bflo(w.x), a1 = bfhi(w.x), a2 = bflo(w.y), a3 = bfhi(w.y);
              r_kv = 1.0f / sqrtf(wave_sum((a0 * a0 + a1 * a1) + (a2 * a2 + a3 * a3)) * (1.0f / KVL) + EPS); }
            const float kr = bf2f(Prow[PC_KR + lane]);
            float cs = 1.f, sn = 0.f;
            if (lat) { const int i = lane & 15; const float pos = (float)((lane < 32) ? (n >> 6) : (n & 63));
                const float freq = exp2f(-(float)i * (13.287712379549449f / 16.0f));
                float rev = pos * freq * 0.15915494309189535f; rev -= floorf(rev);
                cs = __builtin_amdgcn_cosf(rev); sn = __builtin_amdgcn_sinf(rev); }
            const bool first = (lane & 16) == 0;
            const float gk0 = qk_norm_k[lane], gk1 = qk_norm_k[64 + lane], gk2 = qk_norm_k[128 + lane];
            const bf16_t* kvrow = KVUP + (size_t)t * 2048;
#pragma unroll 2
            for (int h = 0; h < NH; ++h) {
                const float e0 = bf2f(kvrow[h * 256 + lane]) * r_kv, e1 = bf2f(kvrow[h * 256 + 64 + lane]) * r_kv;
                const float v0 = bf2f(kvrow[h * 256 + 128 + lane]) * r_kv, v1 = bf2f(kvrow[h * 256 + 192 + lane]) * r_kv;
                const float rn = 1.0f / sqrtf(wave_sum(e0 * e0 + e1 * e1 + kr * kr) * (1.0f / QKD) + EPS);
                const float k0 = e0 * rn * gk0, k1 = e1 * rn * gk1; float k2 = kr * rn * gk2;
                if (lat) { const float pr = __shfl_xor(k2, 16); k2 = first ? k2 * cs - pr * sn : k2 * cs + pr * sn; }
                bf16_t* kd = KF + ((size_t)(b * NH + h) * SKV + m) * QKD;
                kd[lane] = (bf16_t)f2bf(k0); kd[64 + lane] = (bf16_t)f2bf(k1); kd[128 + lane] = (bf16_t)f2bf(k2);
                bf16_t* vd = VF + ((size_t)(b * NH + h) * SKV + m) * VD;
                vd[lane] = (bf16_t)f2bf(v0); vd[64 + lane] = (bf16_t)f2bf(v1);
            }
            if (lat) {
                float r_q;
                { const u32x4 w = *(const u32x4*)(Prow + lane * 8); float s = 0.f;
                  s += bflo(w.x) * bflo(w.x) + bfhi(w.x) * bfhi(w.x); s += bflo(w.y) * bflo(w.y) + bfhi(w.y) * bfhi(w.y);
                  s += bflo(w.z) * bflo(w.z) + bfhi(w.z) * bfhi(w.z); s += bflo(w.w) * bflo(w.w) + bfhi(w.w) * bfhi(w.w);
                  r_q = 1.0f / sqrtf(wave_sum(s) * (1.0f / QL) + EPS); }
                const float gq0 = qk_norm_q[lane], gq1 = qk_norm_q[64 + lane], gq2 = qk_norm_q[128 + lane];
                const bf16_t* qrow = QUP + (size_t)t * (NH * QKD);
#pragma unroll 2
                for (int h = 0; h < NH; ++h) {
                    const float e0 = bf2f(qrow[h * QKD + lane]) * r_q, e1 = bf2f(qrow[h * QKD + 64 + lane]) * r_q, e2 = bf2f(qrow[h * QKD + 128 + lane]) * r_q;
                    const float rn = 1.0f / sqrtf(wave_sum(e0 * e0 + e1 * e1 + e2 * e2) * (1.0f / QKD) + EPS);
                    const float q0 = e0 * rn * gq0, q1 = e1 * rn * gq1; float q2 = e2 * rn * gq2;
                    const float pr = __shfl_xor(q2, 16); q2 = first ? q2 * cs - pr * sn : q2 * cs + pr * sn;
                    bf16_t* qd = QF + ((size_t)(b * NH + h) * SEQ + n) * QKD;
                    qd[lane] = (bf16_t)f2bf(q0); qd[64 + lane] = (bf16_t)f2bf(q1); qd[128 + lane] = (bf16_t)f2bf(q2);
                }
                bf16_t* vp = (bf16_t*)Prow + PC_V;
                float f[16]; float s = 0.f;
#pragma unroll
                for (int j = 0; j < 2; ++j) { const u32x4 w = *(const u32x4*)(vp + j * 512 + lane * 8);
                    f[j * 8 + 0] = bflo(w.x); f[j * 8 + 1] = bfhi(w.x); f[j * 8 + 2] = bflo(w.y); f[j * 8 + 3] = bfhi(w.y);
                    f[j * 8 + 4] = bflo(w.z); f[j * 8 + 5] = bfhi(w.z); f[j * 8 + 6] = bflo(w.w); f[j * 8 + 7] = bfhi(w.w); }
#pragma unroll
                for (int j = 0; j < 16; ++j) s += f[j];
                const float mu = wave_sum(s) * (1.0f / 1024.0f); float q = 0.f;
#pragma unroll
                for (int j = 0; j < 16; ++j) { f[j] -= mu; q += f[j] * f[j]; }
                const float rstd = 1.0f / sqrtf(wave_sum(q) * (1.0f / 1024.0f) + EPS);
#pragma unroll
                for (int j = 0; j < 2; ++j) { const int c0 = j * 512 + lane * 8; float o[8];
#pragma unroll
                    for (int e = 0; e < 8; ++e) o[e] = f[j * 8 + e] * rstd * sgu_norm_g[c0 + e] + sgu_norm_b[c0 + e];
                    u32x4 w; w.x = pk2(o[0], o[1]); w.y = pk2(o[2], o[3]); w.z = pk2(o[4], o[5]); w.w = pk2(o[6], o[7]);
                    *(u32x4*)(vp + c0) = w; }
            }
        }
    }
    SEAM(4);

    if (IN(5)) {
        LAS bf16_t* vt = (LAS bf16_t*)lds;
        for (int un = vcu; un < 1024; un += G) {
            const int ck = un >> 3, g = un & 7; const size_t t0 = (size_t)ck * 128;
#pragma unroll
            for (int i = 0; i < 4; ++i) { const int q = tid + i * 512, j = q >> 4, c0 = (q & 15) * 8;
                const u32x4 w = *(const u32x4*)(P + (t0 + j) * PCOLS + PC_V + g * 128 + c0);
                vt[(c0 + 0) * 136 + j] = (bf16_t)(w.x & 0xffff); vt[(c0 + 1) * 136 + j] = (bf16_t)(w.x >> 16);
                vt[(c0 + 2) * 136 + j] = (bf16_t)(w.y & 0xffff); vt[(c0 + 3) * 136 + j] = (bf16_t)(w.y >> 16);
                vt[(c0 + 4) * 136 + j] = (bf16_t)(w.z & 0xffff); vt[(c0 + 5) * 136 + j] = (bf16_t)(w.z >> 16);
                vt[(c0 + 6) * 136 + j] = (bf16_t)(w.w & 0xffff); vt[(c0 + 7) * 136 + j] = (bf16_t)(w.w >> 16); }
            __syncthreads();
            const int fr = lane & 15, fq = lane >> 4;
            bf16x8 af[4];
#pragma unroll
            for (int kk = 0; kk < 4; ++kk) af[kk] = *(const bf16x8*)(WSP + ((size_t)g * 128 + wave * 16 + fr) * 128 + kk * 32 + fq * 8);
            float bs[4];
#pragma unroll
            for (int j = 0; j < 4; ++j) bs[j] = b_spatial[g * 128 + wave * 16 + fq * 4 + j];
#pragma unroll
            for (int nb = 0; nb < 8; ++nb) {
                f32x4 acc = (f32x4){0.f, 0.f, 0.f, 0.f};
#pragma unroll
                for (int kk = 0; kk < 4; ++kk) { const bf16x8 bfr = *(const LAS bf16x8*)(vt + (nb * 16 + fr) * 136 + kk * 32 + fq * 8);
                    acc = __builtin_amdgcn_mfma_f32_16x16x32_bf16(af[kk], bfr, acc, 0, 0, 0); }
#pragma unroll
                for (int j = 0; j < 4; ++j) { const size_t t = t0 + wave * 16 + fq * 4 + j; const int c = g * 128 + nb * 16 + fr;
                    const float u = bf2f(P[t * PCOLS + PC_U + c]);
                    AO[t * DM + 1024 + c] = (bf16_t)f2bf(u * (acc[j] + bs[j])); }
            }
            __syncthreads();
        }
        for (int un = vcu; un < NB * NH * (SEQ / 256); un += G) {
            const int bh = un >> 4, qb = un & 15, b = bh >> 3, h = bh & 7;
            att::attn_unit(QF + ((size_t)bh * SEQ + qb * 256) * QKD, KF + (size_t)bh * SKV * QKD, VF + (size_t)bh * SKV * VD,
                           AO + ((size_t)b * SEQ + qb * 256) * DM + h * VD, (char*)lds);
        }
    }
    SEAM(5);

    if (IN(6)) {
        { pg8::Gemm g{AO, WBRA, NTOK, DM, 1024, DM, 1024}; pg8::StaticOrder S; S.init(NTOK, DM, G, bx);
          pg8::EpiM1 E{TMP, P + PC_GA, PCOLS};
          pg8::gemm_phase<pg8::EpiM1, pg8::StaticOrder>((LAS unsigned char*)lds, g, S, E); }
        { pg8::Gemm g{AO + 1024, WBRS, NTOK, DM, 1024, DM, 1024}; pg8::StaticOrder S; S.init(NTOK, DM, G, bx);
          pg8::EpiM2 E{TMP, P + PC_GS, PCOLS, MERGED};
          pg8::gemm_phase<pg8::EpiM2, pg8::StaticOrder>((LAS unsigned char*)lds, g, S, E); }
    }
    SEAM(6);

    if (IN(7)) {
        pg8::Gemm g{MERGED, WOUT, NTOK, DM, DM, DM, DM}; pg8::StaticOrder S; S.init(NTOK, DM, G, bx);
        pg8::EpiRes E{x, out, MOD + 2 * DM};
        pg8::gemm_phase<pg8::EpiRes, pg8::StaticOrder>((LAS unsigned char*)lds, g, S, E);
    }
    SEAM(7);

    if (IN(8)) {
        for (int row = gw; row < NTOK; row += NGW) {
            const float* src = out + (size_t)row * DM; const int b = row / SEQ;
            const float* sh = MOD + (size_t)b * NMOD + 3 * DM; const float* scp = sh + DM;
            f32x4 v[8]; float ss = 0.f;
#pragma unroll
            for (int j = 0; j < 8; ++j) { v[j] = *(const f32x4*)(src + (lane + 64 * j) * 4); ss += (v[j].x * v[j].x + v[j].y * v[j].y) + (v[j].z * v[j].z + v[j].w * v[j].w); }
            const float r = 1.0f / sqrtf(wave_sum(ss) * (1.0f / DM) + EPS);
#pragma unroll
            for (int j = 0; j < 8; ++j) { const int idx = (lane + 64 * j) * 4; const f32x4 g = *(const f32x4*)(norm2_g + idx), s1 = *(const f32x4*)(scp + idx), s0 = *(const f32x4*)(sh + idx);
                const f32x4 o = (v[j] * r * g) * (s1 + 1.0f) + s0;
                u32x2 w; w.x = pk2(o.x, o.y); w.y = pk2(o.z, o.w); *(u32x2*)(H2 + (size_t)row * DM + idx) = w; }
        }
    }
    SEAM(8);

    if (IN(9)) {
        pg8::Gemm g{H2, WFI, NTOK, 2 * DFF, DM, DM, DM}; pg8::StaticOrder S; S.init(NTOK, 2 * DFF, G, bx);
        pg8::EpiFfnIn E{ACT};
        pg8::gemm_phase<pg8::EpiFfnIn, pg8::StaticOrder>((LAS unsigned char*)lds, g, S, E);
    }
    SEAM(9);

    if (IN(10)) {
        pg8::Gemm g{ACT, WFO, NTOK, DM, DFF, DFF, DFF}; pg8::StaticOrder S; S.init(NTOK, DM, G, bx);
        pg8::EpiRes E{out, out, MOD + 5 * DM};
        pg8::gemm_phase<pg8::EpiRes, pg8::StaticOrder>((LAS unsigned char*)lds, g, S, E);
    }
#undef IN
#undef SEAM
}

constexpr int N_PHASES = 11;

extern "C" void kernel_launch(void* const* d_in, const int* in_sizes, int n_in, void* d_out, int out_size, void* d_ws, size_t ws_size, hipStream_t stream) {
    static int grid = 0;
    if (grid == 0) {
        if (n_in != 24 || out_size != NTOK * DM || ws_size < WS_END) { fprintf(stderr, "kernel_launch: unexpected shapes n_in %d out %d ws %zu\n", n_in, out_size, ws_size); grid = -1; return; }
        int dev = 0, cus = 0, per_cu = 0;
        (void)hipGetDevice(&dev); (void)hipDeviceGetAttribute(&cus, hipDeviceAttributeMultiprocessorCount, dev);
        if (hipFuncSetAttribute((const void*)fwd_kernel, hipFuncAttributeMaxDynamicSharedMemorySize, LDS_BYTES) != hipSuccess) { fprintf(stderr, "kernel_launch: hipFuncSetAttribute failed\n"); grid = -1; return; }
        if (hipOccupancyMaxActiveBlocksPerMultiprocessor(&per_cu, (const void*)fwd_kernel, 512, LDS_BYTES) != hipSuccess || per_cu < 1) { fprintf(stderr, "kernel_launch: occupancy query says %d\n", per_cu); per_cu = 1; }
        (void)hipGetLastError();
        grid = cus * per_cu;
    }
    if (grid < 0) return;
    Args a{};
    for (int i = 0; i < 24; ++i) a.in[i] = (const float*)d_in[i];
    a.out = (float*)d_out; a.ws = (unsigned char*)d_ws;
#if MK_LAUNCH_PER_PHASE
    for (int p = 0; p < N_PHASES; ++p) { a.ph_lo = p; a.ph_hi = p + 1;
        hipLaunchKernelGGL(fwd_kernel, dim3(grid), dim3(512), LDS_BYTES, stream, a); }
#else
    a.ph_lo = 0; a.ph_hi = N_PHASES;
    void* kargs[] = {&a};
    hipError_t e = hipLaunchCooperativeKernel((const void*)fwd_kernel, dim3(grid), dim3(512), kargs, LDS_BYTES, stream);
    if (e != hipSuccess) fprintf(stderr, "cooperative launch failed: %s (grid %d)\n", hipGetErrorString(e), grid);
#endif
}
```

```cpp
#include <hip/hip_runtime.h>
#include <hip/hip_cooperative_groups.h>
#include <cstdio>
#include <cstdint>
namespace cg = cooperative_groups;

#ifndef MK_LAUNCH_PER_PHASE
#define MK_LAUNCH_PER_PHASE 0
#endif

#define LAS __attribute__((address_space(3)))
typedef unsigned short bf16_t;
typedef short bf16x8 __attribute__((ext_vector_type(8)));
typedef short s16x4 __attribute__((ext_vector_type(4)));
typedef float f32x2 __attribute__((ext_vector_type(2)));
typedef float f32x4 __attribute__((ext_vector_type(4)));
typedef float f32x16 __attribute__((ext_vector_type(16)));
typedef unsigned u32x2 __attribute__((ext_vector_type(2)));
typedef unsigned u32x4 __attribute__((ext_vector_type(4)));

constexpr int DM = 2048, NB = 4, SEQ = 4096, NTOK = NB * SEQ, CTXL = 256, NCTX = NB * CTXL, MROWS = NTOK + NCTX;
constexpr int NH = 8, QL = 512, KVL = 256, QKD = 192, VD = 128;
constexpr int DFF = 5632, NMOD = 6 * DM;
constexpr int SKV = SEQ + CTXL;
constexpr int PCOLS = 7168;
constexpr int PC_KV = 512, PC_KR = 768, PC_U = 1024, PC_V = 2048, PC_GA = 3072, PC_GS = 5120;
constexpr int IN_COLS = 6976;
constexpr float EPS = 1e-6f;

constexpr size_t MiB = 1u << 20;
constexpr size_t WS_MOD = 0;
constexpr size_t WS_WIN = 1 * MiB;
constexpr size_t WS_WUQ = 29 * MiB;
constexpr size_t WS_WUKV = 31 * MiB;
constexpr size_t WS_WBRA = 32 * MiB;
constexpr size_t WS_WBRS = 36 * MiB;
constexpr size_t WS_WOUT = 40 * MiB;
constexpr size_t WS_WFI = 48 * MiB;
constexpr size_t WS_WFO = 92 * MiB;
constexpr size_t WS_WSP = 114 * MiB;
constexpr size_t WS_H = 116 * MiB;
constexpr size_t WS_P = 184 * MiB;
constexpr size_t WS_KF = 422 * MiB;
constexpr size_t WS_VF = 473 * MiB;
constexpr size_t WS_MERGED = 422 * MiB;
constexpr size_t WS_END = 512 * MiB;
constexpr size_t DO_QF = 48 * MiB;

constexpr int LDS_BYTES = 139264;

__device__ __forceinline__ unsigned f2bf(float f) { unsigned u = __builtin_bit_cast(unsigned, f); return (u + 0x7fffu + ((u >> 16) & 1u)) >> 16; }
__device__ __forceinline__ unsigned pk2(float lo, float hi) { return f2bf(lo) | (f2bf(hi) << 16); }
__device__ __forceinline__ float bf2f(unsigned short b) { return __builtin_bit_cast(float, ((unsigned)b) << 16); }
__device__ __forceinline__ float bflo(unsigned w) { return __builtin_bit_cast(float, w << 16); }
__device__ __forceinline__ float bfhi(unsigned w) { return __builtin_bit_cast(float, w & 0xffff0000u); }
__device__ __forceinline__ float wave_sum(float v) {
#pragma unroll
    for (int o = 1; o < 64; o <<= 1) v += __shfl_xor(v, o);
    return v;
}
#define LDS_WAIT() asm volatile("s_waitcnt lgkmcnt(0)" ::: "memory")

namespace pg8 {
#define PG8_LAS __attribute__((address_space(3)))
constexpr int BM = 256, BK = 64, HALF = 128, HTB = HALF * BK * 2, STAGE_BYTES = 8 * HTB, NXCD = 8, WGM = 8;
__host__ __device__ __forceinline__ int lds_byte(int r, int c) { const int st = (r >> 4) * 2 + (c >> 5), rr = r & 15, cc = c & 31, ob = rr * 64 + cc * 2; return st * 1024 + (ob ^ (((ob >> 9) & 1) << 5)); }
__host__ __device__ __forceinline__ void stage_rc(int b, int& R, int& C) { const int st = b / 1024, sb = b % 1024, swz = sb ^ (((sb >> 9) & 1) << 5); R = (st >> 1) * 16 + swz / 64; C = (st & 1) * 32 + (swz % 64) / 2; }
__host__ __device__ __forceinline__ int perm32(int rho) { const int n = rho >> 4, i = rho & 15; return 8 * (i >> 2) + 4 * n + (i & 3); }

struct Unit { int pm, pn; };
struct Gemm { const bf16_t* A; const bf16_t* Bt; int M, N, K, lda, ldb; };

struct StaticOrder {
    int nM, nN, nwg, G, c;
    __device__ void init(int M, int N, int G_, int c_) { nM = M / BM; nN = N / BM; nwg = nM * nN; G = G_; c = c_; }
    __device__ bool next(int i, Unit& u) const {
        const long L = (long)i * G + c; if (L >= nwg) return false;
        int wgid = (int)L; { const int q = nwg / NXCD, r = nwg % NXCD, xcd = wgid % NXCD, off = wgid / NXCD; wgid = (xcd < r ? xcd * (q + 1) : r * (q + 1) + (xcd - r) * q) + off; }
        const int nig = WGM * nN, gid = wgid / nig, fm = gid * WGM, gsz = (nM - fm) < WGM ? (nM - fm) : WGM;
        u.pm = fm + ((wgid % nig) % gsz); u.pn = (wgid % nig) / gsz; return true;
    }
    __device__ __forceinline__ void a_ready(const Unit&) const {}
    __device__ __forceinline__ void done(const Unit&) const {}
};
struct ProjOrder {
    StaticOrder S; int G, c;
    __device__ void init(int G_, int c_) { S.init(NTOK, PCOLS, G_, c_); G = G_; c = c_; }
    __device__ bool next(int i, Unit& u) const {
        const long L = (long)i * G + c;
        if (L < S.nwg) return S.next(i, u);
        const int j = (int)(L - S.nwg); if (j >= 8) return false;
        u.pm = 64 + (j >> 1); u.pn = 2 + (j & 1); return true;
    }
    __device__ __forceinline__ void a_ready(const Unit&) const {}
    __device__ __forceinline__ void done(const Unit&) const {}
};

__device__ __forceinline__ unsigned cvt_pk_bf16(float lo, float hi) { unsigned r; asm volatile("v_cvt_pk_bf16_f32 %0, %1, %2" : "=v"(r) : "v"(lo), "v"(hi)); return r; }
__device__ __forceinline__ f32x2 gelu_pk(f32x2 v) {
    const f32x2 av = __builtin_elementwise_abs(v), d = av * 0.2316418882f + 1.0f;
    f32x2 t; t.x = __builtin_amdgcn_rcpf(d.x); t.y = __builtin_amdgcn_rcpf(d.y);
    f32x2 q = t * 0.5307027145f + (-0.7265760135f); q = q * t + 0.7107068705f; q = q * t + (-0.142248368f); q = q * t + 0.127414796f; q = q * t;
    const f32x2 s = (v * v) * (-0.72134752044f);
    f32x2 e; e.x = __builtin_amdgcn_exp2f(s.x); e.y = __builtin_amdgcn_exp2f(s.y);
    const f32x2 m = v * (q * e), r = v - m;
    f32x2 o; o.x = v.x < 0.f ? m.x : r.x; o.y = v.y < 0.f ? m.y : r.y; return o;
}
__device__ __forceinline__ float sigm(float x) { return __builtin_amdgcn_rcpf(1.0f + __builtin_amdgcn_exp2f(-1.4426950408889634f * x)); }

struct EpiProj {
    static constexpr bool PERM = true, AFTER_DRAIN = false, MID = false;
    bf16_t* O; int ldc;
    __device__ __forceinline__ void operator()(const f32x4 (&acc)[2][2][4][2], const Unit& u, int wr, int wc, int fr, int fq) const {
        const int row0 = u.pm * BM + wr * 64 + fr, col0 = u.pn * BM + wc * 32 + 8 * fq;
        const int act = (u.pn < 4) ? 0 : (u.pn < 12 ? 1 : 2);
#pragma unroll
        for (int ai = 0; ai < 2; ++ai)
#pragma unroll
            for (int m = 0; m < 4; ++m) { bf16_t* rowp = O + (size_t)(row0 + ai * HALF + m * 16) * ldc + col0;
#pragma unroll
                for (int bj = 0; bj < 2; ++bj) { f32x4 v0 = acc[ai][bj][m][0], v1 = acc[ai][bj][m][1];
                    if (act == 1) { f32x2 a = gelu_pk((f32x2){v0[0], v0[1]}), b = gelu_pk((f32x2){v0[2], v0[3]}), c = gelu_pk((f32x2){v1[0], v1[1]}), d = gelu_pk((f32x2){v1[2], v1[3]});
                        v0 = (f32x4){a.x, a.y, b.x, b.y}; v1 = (f32x4){c.x, c.y, d.x, d.y}; }
                    else if (act == 2) {
#pragma unroll
                        for (int j = 0; j < 4; ++j) { v0[j] = sigm(v0[j]); v1[j] = sigm(v1[j]); } }
                    u32x4 w; w.x = cvt_pk_bf16(v0[0], v0[1]); w.y = cvt_pk_bf16(v0[2], v0[3]); w.z = cvt_pk_bf16(v1[0], v1[1]); w.w = cvt_pk_bf16(v1[2], v1[3]);
                    *(u32x4*)(rowp + bj * HALF) = w; } }
    }
};
struct EpiBf16 {
    static constexpr bool PERM = true, AFTER_DRAIN = false, MID = false;
    bf16_t* O; int ldc;
    __device__ __forceinline__ void operator()(const f32x4 (&acc)[2][2][4][2], const Unit& u, int wr, int wc, int fr, int fq) const {
        const int row0 = u.pm * BM + wr * 64 + fr, col0 = u.pn * BM + wc * 32 + 8 * fq;
#pragma unroll
        for (int ai = 0; ai < 2; ++ai)
#pragma unroll
            for (int m = 0; m < 4; ++m) { bf16_t* rowp = O + (size_t)(row0 + ai * HALF + m * 16) * ldc + col0;
#pragma unroll
                for (int bj = 0; bj < 2; ++bj) { const f32x4 v0 = acc[ai][bj][m][0], v1 = acc[ai][bj][m][1];
                    u32x4 w; w.x = cvt_pk_bf16(v0[0], v0[1]); w.y = cvt_pk_bf16(v0[2], v0[3]); w.z = cvt_pk_bf16(v1[0], v1[1]); w.w = cvt_pk_bf16(v1[2], v1[3]);
                    *(u32x4*)(rowp + bj * HALF) = w; } }
    }
};
struct EpiMerge {
    static constexpr bool PERM = true, AFTER_DRAIN = false, MID = true;
    const bf16_t* GA; const bf16_t* GS; int ldg; bf16_t* O;
    __device__ __forceinline__ void mid(f32x4 (&acc)[2][2][4][2], const Unit& u, int wr, int wc, int fr, int fq) const {
        int row0 = u.pm * BM + wr * 64 + fr, col0 = u.pn * BM + wc * 32 + 8 * fq;
        asm volatile("" : "+v"(row0), "+v"(col0));
#pragma unroll
        for (int ai = 0; ai < 2; ++ai)
#pragma unroll
            for (int m = 0; m < 4; ++m) { const size_t r = (size_t)(row0 + ai * HALF + m * 16);
#pragma unroll
                for (int bj = 0; bj < 2; ++bj) { const int c = col0 + bj * HALF;
                    const u32x4 ga = *(const u32x4*)(GA + r * ldg + c), gs = *(const u32x4*)(GS + r * ldg + c);
                    f32x4 r0, r1;
                    r0[0] = bflo(ga.x) * __builtin_amdgcn_rcpf(fmaxf(bflo(gs.x), 1e-30f)); r0[1] = bfhi(ga.x) * __builtin_amdgcn_rcpf(fmaxf(bfhi(gs.x), 1e-30f));
                    r0[2] = bflo(ga.y) * __builtin_amdgcn_rcpf(fmaxf(bflo(gs.y), 1e-30f)); r0[3] = bfhi(ga.y) * __builtin_amdgcn_rcpf(fmaxf(bfhi(gs.y), 1e-30f));
                    r1[0] = bflo(ga.z) * __builtin_amdgcn_rcpf(fmaxf(bflo(gs.z), 1e-30f)); r1[1] = bfhi(ga.z) * __builtin_amdgcn_rcpf(fmaxf(bfhi(gs.z), 1e-30f));
                    r1[2] = bflo(ga.w) * __builtin_amdgcn_rcpf(fmaxf(bflo(gs.w), 1e-30f)); r1[3] = bfhi(ga.w) * __builtin_amdgcn_rcpf(fmaxf(bfhi(gs.w), 1e-30f));
                    acc[ai][bj][m][0] = acc[ai][bj][m][0] * r0; acc[ai][bj][m][1] = acc[ai][bj][m][1] * r1; }
                asm volatile("" ::: "memory"); }
    }
    __device__ __forceinline__ void operator()(const f32x4 (&acc)[2][2][4][2], const Unit& u, int wr, int wc, int fr, int fq) const {
        int row0 = u.pm * BM + wr * 64 + fr, col0 = u.pn * BM + wc * 32 + 8 * fq;
        asm volatile("" : "+v"(row0), "+v"(col0));
#pragma unroll
        for (int ai = 0; ai < 2; ++ai)
#pragma unroll
            for (int m = 0; m < 4; ++m) { const size_t r = (size_t)(row0 + ai * HALF + m * 16);
#pragma unroll
                for (int bj = 0; bj < 2; ++bj) { const int c = col0 + bj * HALF;
                    const u32x4 g = *(const u32x4*)(GS + r * ldg + c);
                    const f32x4 a0 = acc[ai][bj][m][0], a1 = acc[ai][bj][m][1];
                    u32x4 w; w.x = cvt_pk_bf16(a0[0] * bflo(g.x), a0[1] * bfhi(g.x)); w.y = cvt_pk_bf16(a0[2] * bflo(g.y), a0[3] * bfhi(g.y));
                    w.z = cvt_pk_bf16(a1[0] * bflo(g.z), a1[1] * bfhi(g.z)); w.w = cvt_pk_bf16(a1[2] * bflo(g.w), a1[3] * bfhi(g.w));
                    *(u32x4*)(O + r * DM + c) = w; } }
    }
};
struct EpiRes {
    static constexpr bool PERM = false, AFTER_DRAIN = false, MID = false;
    const float* base; float* out; const float* gate;
    __device__ __forceinline__ void operator()(const f32x4 (&acc)[2][2][4][2], const Unit& u, int wr, int wc, int fr, int fq) const {
        const int row0 = u.pm * BM + wr * 64 + fr, col0 = u.pn * BM + wc * 32 + 4 * fq;
        const float* gp = gate + (size_t)(u.pm >> 4) * NMOD + col0;
        f32x4 gv[2][2];
#pragma unroll
        for (int bj = 0; bj < 2; ++bj)
#pragma unroll
            for (int n = 0; n < 2; ++n) gv[bj][n] = *(const f32x4*)(gp + bj * HALF + n * 16);
#pragma unroll
        for (int ai = 0; ai < 2; ++ai)
#pragma unroll
            for (int m = 0; m < 4; ++m) { const size_t off = (size_t)(row0 + ai * HALF + m * 16) * DM + col0;
#pragma unroll
                for (int bj = 0; bj < 2; ++bj)
#pragma unroll
                    for (int n = 0; n < 2; ++n) { const f32x4 b = *(const f32x4*)(base + off + bj * HALF + n * 16);
                        *(f32x4*)(out + off + bj * HALF + n * 16) = b + gv[bj][n] * acc[ai][bj][m][n]; } }
    }
};
struct EpiFfnIn {
    static constexpr bool PERM = true, AFTER_DRAIN = false, MID = false;
    bf16_t* O;
    __device__ __forceinline__ void operator()(const f32x4 (&acc)[2][2][4][2], const Unit& u, int wr, int wc, int fr, int fq) const {
        const int row0 = u.pm * BM + wr * 64 + fr, col0 = u.pn * HALF + wc * 32 + 8 * fq;
#pragma unroll
        for (int ai = 0; ai < 2; ++ai)
#pragma unroll
            for (int m = 0; m < 4; ++m) { bf16_t* rowp = O + (size_t)(row0 + ai * HALF + m * 16) * DFF + col0;
                float o[8];
#pragma unroll
                for (int n = 0; n < 2; ++n)
#pragma unroll
                    for (int j = 0; j < 4; ++j) { const float a = acc[ai][0][m][n][j], b = acc[ai][1][m][n][j]; o[n * 4 + j] = a * sigm(a) * b; }
                u32x4 w; w.x = cvt_pk_bf16(o[0], o[1]); w.y = cvt_pk_bf16(o[2], o[3]); w.z = cvt_pk_bf16(o[4], o[5]); w.w = cvt_pk_bf16(o[6], o[7]);
                *(u32x4*)rowp = w; }
    }
};

template <class Epi, class Sched, bool ALIGN_EPI = true, bool SP2 = true>
__device__ __forceinline__ void gemm_phase(PG8_LAS unsigned char* lds, const Gemm g, const Sched& S, const Epi& E) {
    const int tid = threadIdx.x, wid = __builtin_amdgcn_readfirstlane(tid >> 6), lane = tid & 63, wr = wid >> 2, wc = wid & 3, fr = lane & 15, fq = lane >> 4;
    const int K = g.K, nt = K / BK;
    unsigned voffA[2], voffB[2];
#pragma unroll
    for (int i = 0; i < 2; ++i) { int R, C; stage_rc(tid * 16 + i * 8192, R, C); const int Rb = Epi::PERM ? ((R & ~31) + perm32(R & 31)) : R;
        voffA[i] = (unsigned)(R * g.lda + C) * 2u; voffB[i] = (unsigned)(Rb * g.ldb + C) * 2u; }
    const size_t kstep = (size_t)(BK * 2);
    const size_t hstepA = (size_t)HALF * g.lda * 2, hstepB = (size_t)HALF * g.ldb * 2;
    const size_t tstepA = 2 * hstepA, tstepB = 2 * hstepB;
    const unsigned ldsw = (unsigned)wid * 1024u;
    const int aoff = lds_byte(wr * 64 + fr, fq * 8), boff = lds_byte(wc * 32 + fr, fq * 8);
#define PG8_SA(b, h) (((b) * 2 + (h)) * HTB)
#define PG8_SB(b, h) ((4 + (b) * 2 + (h)) * HTB)
#define PG8_STAGE(bufoff, gbase, voff) do { _Pragma("unroll") for (int _i = 0; _i < 2; ++_i) \
        __builtin_amdgcn_global_load_lds((const unsigned*)((const char*)(gbase) + (voff)[_i]), (PG8_LAS unsigned*)(lds + (bufoff) + ldsw + _i * 8192), 16, 0, 0); } while (0)
#define PG8_LDA(dst, b, h) do { _Pragma("unroll") for (int m = 0; m < 4; ++m) _Pragma("unroll") for (int k = 0; k < 2; ++k) dst[m][k] = *(const PG8_LAS bf16x8*)(lds + PG8_SA(b, h) + aoff + m * 2048 + k * 1024); } while (0)
#define PG8_LDB(dst, b, h) do { _Pragma("unroll") for (int n = 0; n < 2; ++n) _Pragma("unroll") for (int k = 0; k < 2; ++k) dst[n][k] = *(const PG8_LAS bf16x8*)(lds + PG8_SB(b, h) + boff + n * 2048 + k * 1024); } while (0)
#define PG8_MMA(ai, bj, At, Bt) do { __builtin_amdgcn_s_setprio(1); _Pragma("unroll") for (int m = 0; m < 4; ++m) _Pragma("unroll") for (int n = 0; n < 2; ++n) _Pragma("unroll") for (int k = 0; k < 2; ++k) \
        acc[ai][bj][m][n] = __builtin_amdgcn_mfma_f32_16x16x32_bf16(Bt[n][k], At[m][k], acc[ai][bj][m][n], 0, 0, 0); __builtin_amdgcn_s_setprio(0); } while (0)
#define PG8_WAIT_V(n) asm volatile("s_waitcnt vmcnt(" #n ")" ::: "memory")
#define PG8_WAIT_L(n) asm volatile("s_waitcnt lgkmcnt(" #n ")" ::: "memory")
#define PG8_BAR __builtin_amdgcn_s_barrier()
#define PG8_SCHED __builtin_amdgcn_sched_barrier(0)
    Unit cur, nxt; int ui = 0;
    if (!S.next(0, cur)) return;
    f32x4 acc[2][2][4][2];
#pragma unroll
    for (int a = 0; a < 2; ++a)
#pragma unroll
        for (int b = 0; b < 2; ++b)
#pragma unroll
            for (int m = 0; m < 4; ++m)
#pragma unroll
                for (int n = 0; n < 2; ++n) acc[a][b][m][n] = (f32x4){0.f, 0.f, 0.f, 0.f};
    bf16x8 At[4][2], B0[2][2], B1[2][2];
    const char* cA = (const char*)g.A + (size_t)cur.pm * tstepA; const char* cB = (const char*)g.Bt + (size_t)cur.pn * tstepB;
    S.a_ready(cur);
    if constexpr (SP2) {
        PG8_STAGE(PG8_SB(0, 0), cB, voffB); PG8_STAGE(PG8_SB(0, 1), cB + hstepB, voffB); PG8_STAGE(PG8_SA(0, 0), cA, voffA); PG8_STAGE(PG8_SA(0, 1), cA + hstepA, voffA);
        if (wr == 1) PG8_BAR;
        PG8_WAIT_V(2); PG8_BAR;
        PG8_STAGE(PG8_SB(1, 0), cB + kstep, voffB); PG8_STAGE(PG8_SA(1, 0), cA + kstep, voffA); PG8_STAGE(PG8_SB(1, 1), cB + hstepB + kstep, voffB);
        PG8_WAIT_V(6); PG8_BAR;
    } else {
        PG8_STAGE(PG8_SB(0, 0), cB, voffB); PG8_STAGE(PG8_SA(0, 0), cA, voffA); PG8_STAGE(PG8_SB(0, 1), cB + hstepB, voffB); PG8_STAGE(PG8_SA(0, 1), cA + hstepA, voffA);
        if (wr == 1) PG8_BAR;
        PG8_WAIT_V(4); PG8_BAR;
        PG8_STAGE(PG8_SB(1, 0), cB + kstep, voffB); PG8_STAGE(PG8_SA(1, 0), cA + kstep, voffA); PG8_STAGE(PG8_SB(1, 1), cB + hstepB + kstep, voffB);
        PG8_WAIT_V(6); PG8_BAR;
    }
    for (;;) {
        const bool has_next = S.next(ui + 1, nxt);
        const char* nA = has_next ? (const char*)g.A + (size_t)nxt.pm * tstepA : cA; const char* nB = has_next ? (const char*)g.Bt + (size_t)nxt.pn * tstepB : cB;
        for (int t = 0; t < nt; t += 2) {
            const bool last = (t == nt - 2);
            const char* a1 = cA + (size_t)(t + 1) * kstep;
            const char* a2 = last ? nA : cA + (size_t)(t + 2) * kstep; const char* b2 = last ? nB : cB + (size_t)(t + 2) * kstep;
            const char* a3 = a2 + kstep; const char* b3 = b2 + kstep;
            if constexpr (Epi::MID) { if (t == nt / 2) { PG8_SCHED; E.mid(acc, cur, wr, wc, fr, fq); PG8_SCHED; } }
            if (last && has_next) S.a_ready(nxt);
            if constexpr (SP2) {
            PG8_LDB(B0, 0, 0); PG8_LDB(B1, 0, 1); PG8_SCHED; PG8_LDA(At, 0, 0); PG8_STAGE(PG8_SA(1, 1), a1 + hstepA, voffA);
            PG8_WAIT_V(8); PG8_WAIT_L(0); PG8_BAR; PG8_MMA(0, 0, At, B0); PG8_MMA(0, 1, At, B1); PG8_BAR; PG8_SCHED;
            PG8_LDA(At, 0, 1); PG8_STAGE(PG8_SB(0, 0), b2, voffB); PG8_STAGE(PG8_SB(0, 1), b2 + hstepB, voffB); PG8_STAGE(PG8_SA(0, 0), a2, voffA);
            PG8_WAIT_V(8); PG8_WAIT_L(0); PG8_BAR; PG8_MMA(1, 0, At, B0); PG8_MMA(1, 1, At, B1); PG8_BAR; PG8_SCHED;
            PG8_LDB(B0, 1, 0); PG8_LDB(B1, 1, 1); PG8_SCHED; PG8_LDA(At, 1, 0); PG8_STAGE(PG8_SA(0, 1), a2 + hstepA, voffA);
            PG8_WAIT_V(8); PG8_WAIT_L(0); PG8_BAR; PG8_MMA(0, 0, At, B0); PG8_MMA(0, 1, At, B1); PG8_BAR; PG8_SCHED;
            PG8_LDA(At, 1, 1); PG8_STAGE(PG8_SB(1, 0), b3, voffB); PG8_STAGE(PG8_SB(1, 1), b3 + hstepB, voffB); PG8_STAGE(PG8_SA(1, 0), a3, voffA);
            PG8_WAIT_V(8); PG8_WAIT_L(0); PG8_BAR; PG8_MMA(1, 0, At, B0); PG8_MMA(1, 1, At, B1); PG8_BAR; PG8_SCHED;
            } else {
            PG8_LDB(B0, 0, 0); PG8_SCHED; PG8_LDA(At, 0, 0); PG8_STAGE(PG8_SA(1, 1), a1 + hstepA, voffA);
            PG8_WAIT_L(8); PG8_BAR; PG8_WAIT_L(0); PG8_MMA(0, 0, At, B0); PG8_BAR; PG8_SCHED;
            PG8_LDB(B1, 0, 1); PG8_STAGE(PG8_SB(0, 0), b2, voffB);
            PG8_BAR; PG8_WAIT_L(0); PG8_MMA(0, 1, At, B1); PG8_BAR;
            PG8_LDA(At, 0, 1); PG8_STAGE(PG8_SA(0, 0), a2, voffA);
            PG8_BAR; PG8_WAIT_L(0); PG8_MMA(1, 0, At, B0); PG8_BAR; PG8_SCHED;
            PG8_STAGE(PG8_SB(0, 1), b2 + hstepB, voffB);
            PG8_WAIT_V(6); PG8_BAR; PG8_MMA(1, 1, At, B1); PG8_BAR;
            PG8_LDB(B0, 1, 0); PG8_SCHED; PG8_LDA(At, 1, 0); PG8_STAGE(PG8_SA(0, 1), a2 + hstepA, voffA);
            PG8_WAIT_L(8); PG8_BAR; PG8_WAIT_L(0); PG8_MMA(0, 0, At, B0); PG8_BAR; PG8_SCHED;
            PG8_LDB(B1, 1, 1); PG8_STAGE(PG8_SB(1, 0), b3, voffB);
            PG8_BAR; PG8_WAIT_L(0); PG8_MMA(0, 1, At, B1); PG8_BAR;
            PG8_LDA(At, 1, 1); PG8_STAGE(PG8_SA(1, 0), a3, voffA);
            PG8_BAR; PG8_WAIT_L(0); PG8_MMA(1, 0, At, B0); PG8_BAR; PG8_SCHED;
            PG8_STAGE(PG8_SB(1, 1), b3 + hstepB, voffB);
            PG8_WAIT_V(6); PG8_BAR; PG8_MMA(1, 1, At, B1); PG8_BAR;
            }
        }
        if constexpr (ALIGN_EPI) { if (wr == 0) PG8_BAR; }
        if constexpr (!Epi::AFTER_DRAIN) { E(acc, cur, wr, wc, fr, fq); S.done(cur); }
        if (!has_next) break;
#pragma unroll
        for (int a = 0; a < 2; ++a)
#pragma unroll
            for (int b = 0; b < 2; ++b)
#pragma unroll
                for (int m = 0; m < 4; ++m)
#pragma unroll
                    for (int n = 0; n < 2; ++n) acc[a][b][m][n] = (f32x4){0.f, 0.f, 0.f, 0.f};
        cur = nxt; cA = nA; cB = nB; ++ui;
        if constexpr (ALIGN_EPI) { if (wr == 1) PG8_BAR; }
    }
    PG8_WAIT_V(0);
    if constexpr (!ALIGN_EPI) { if (wr == 0) PG8_BAR; }
    PG8_BAR;
#undef PG8_SA
#undef PG8_SB
#undef PG8_STAGE
#undef PG8_LDA
#undef PG8_LDB
#undef PG8_MMA
#undef PG8_WAIT_V
#undef PG8_WAIT_L
#undef PG8_BAR
#undef PG8_SCHED
}
}

namespace att {
constexpr int NW = 8, QBLK = 32, KVBLK = 64;
constexpr float SCALE = 0.07216878364870323f;
constexpr float THR = 8.f;
constexpr size_t SHM_V = KVBLK * VD * 2, SHM_K = KVBLK * QKD * 2;
constexpr size_t SHM_ATTN = 2 * SHM_V + 2 * SHM_K + NW * 64 * 4;
#define KSWZ(row, colB) ((row) * 384 + ((colB) ^ (((row) & 7) << 4)))
#define SBAR() __builtin_amdgcn_sched_barrier(0)
__device__ __forceinline__ int crow(int r, int hi) { return (r & 3) + 8 * (r >> 2) + 4 * hi; }
__device__ __forceinline__ unsigned cvtpk(float lo, float hi) { unsigned r; asm volatile("v_cvt_pk_bf16_f32 %0, %1, %2" : "=v"(r) : "v"(lo), "v"(hi)); return r; }

__device__ __forceinline__ void partialSM(f32x16& p0, f32x16& p1, float& m_reg, float& mn, float& alpha) {
  constexpr float C = SCALE * 1.4426950408889634f;
  float pmax = p0[0];
#pragma unroll
  for (int r = 1; r < 16; ++r) pmax = fmaxf(pmax, p0[r]);
#pragma unroll
  for (int r = 0; r < 16; ++r) pmax = fmaxf(pmax, p1[r]);
  { auto rr = __builtin_amdgcn_permlane32_swap(__float_as_uint(pmax), __float_as_uint(pmax), false, false);
    pmax = fmaxf(__uint_as_float(rr[0]), __uint_as_float(rr[1])); }
  if (__builtin_expect(__all(pmax - m_reg <= THR / SCALE), 1)) { mn = m_reg; alpha = 1.f; }
  else { mn = fmaxf(m_reg, pmax); alpha = __builtin_amdgcn_exp2f((m_reg - mn) * C); m_reg = mn; }
  float mnC = -mn * C;
#pragma unroll
  for (int r = 0; r < 16; ++r) p0[r] = fmaf(p0[r], C, mnC);
#pragma unroll
  for (int r = 0; r < 16; ++r) p1[r] = fmaf(p1[r], C, mnC);
#pragma unroll
  for (int r = 0; r < 16; ++r) p0[r] = __builtin_amdgcn_exp2f(p0[r]);
}
__device__ __forceinline__ void finishSM(f32x16& p0, f32x16& p1, float alpha, float& l_reg, bf16x8& pa0, bf16x8& pa1, bf16x8& pa2, bf16x8& pa3) {
#pragma unroll
  for (int r = 0; r < 16; ++r) p1[r] = __builtin_amdgcn_exp2f(p1[r]);
  float ps = 0;
#pragma unroll
  for (int r = 0; r < 16; ++r) ps += p0[r];
#pragma unroll
  for (int r = 0; r < 16; ++r) ps += p1[r];
  { auto rr = __builtin_amdgcn_permlane32_swap(__float_as_uint(ps), __float_as_uint(ps), false, false);
    ps = __uint_as_float(rr[0]) + __uint_as_float(rr[1]); }
  l_reg = l_reg * alpha + ps;
#define PK4(P, BASE, OUT) do { unsigned a0 = cvtpk(P[BASE + 0], P[BASE + 1]), a1 = cvtpk(P[BASE + 2], P[BASE + 3]);   \
    unsigned b0 = cvtpk(P[BASE + 4], P[BASE + 5]), b1 = cvtpk(P[BASE + 6], P[BASE + 7]);                              \
    auto r0 = __builtin_amdgcn_permlane32_swap(a0, b0, false, false); auto r1 = __builtin_amdgcn_permlane32_swap(a1, b1, false, false); \
    u32x4 w = {r0[0], r1[0], r0[1], r1[1]}; OUT = *reinterpret_cast<bf16x8*>(&w); } while (0)
  PK4(p0, 0, pa0); PK4(p0, 8, pa1); PK4(p1, 0, pa2); PK4(p1, 8, pa3);
#undef PK4
}
__device__ __forceinline__ void qkt(f32x16& p0, f32x16& p1, const char* Ks, const bf16x8* qr, int r32, int hi) {
  p0 = f32x16{}; p1 = f32x16{};
#pragma unroll
  for (int d0 = 0; d0 < 12; ++d0) { int cb = (d0 * 16 + hi * 8) * 2;
    bf16x8 b0 = *reinterpret_cast<const bf16x8*>(Ks + KSWZ(r32, cb));
    bf16x8 b1 = *reinterpret_cast<const bf16x8*>(Ks + KSWZ(32 + r32, cb));
    p0 = __builtin_amdgcn_mfma_f32_32x32x16_bf16(b0, qr[d0], p0, 0, 0, 0);
    p1 = __builtin_amdgcn_mfma_f32_32x32x16_bf16(b1, qr[d0], p1, 0, 0, 0); }
}
__device__ __forceinline__ int v_st(int k, int c) { const int kk = (k & ~0xC) | ((k & 4) << 1) | ((k & 8) >> 1); return ((kk >> 3) * 4 + (c >> 5)) * 512 + ((kk & 7) * 32 + (c & 31)) * 2; }
__device__ __forceinline__ int v_rd_base(int lane) { return ((lane & 3) << 3) | (((lane >> 2) & 3) << 6) | (((lane >> 4) & 1) << 5) | (((lane >> 5) & 1) << 8); }
constexpr int v_rd_off(int d0, int ks, int half) { return d0 * 512 + ks * 4096 + half * 2048; }
template <int OFF> __device__ __forceinline__ s16x4 tr_read(int vb) {
  s16x4 r; asm volatile("ds_read_b64_tr_b16 %0, %1 offset:%2" : "=&v"(r) : "v"(vb), "i"(OFF) : "memory"); return r;
}
template <int D0> __device__ __forceinline__ void pv_one(f32x16& od, int vb, bf16x8 pa0, bf16x8 pa1, bf16x8 pa2, bf16x8 pa3) {
  const s16x4 l0 = tr_read<v_rd_off(D0, 0, 0)>(vb), h0 = tr_read<v_rd_off(D0, 0, 1)>(vb), l1 = tr_read<v_rd_off(D0, 1, 0)>(vb), h1 = tr_read<v_rd_off(D0, 1, 1)>(vb);
  const s16x4 l2 = tr_read<v_rd_off(D0, 2, 0)>(vb), h2 = tr_read<v_rd_off(D0, 2, 1)>(vb), l3 = tr_read<v_rd_off(D0, 3, 0)>(vb), h3 = tr_read<v_rd_off(D0, 3, 1)>(vb);
  asm volatile("s_waitcnt lgkmcnt(0)" ::: "memory"); SBAR();
#define PK(L, H) (bf16x8){L[0], L[1], L[2], L[3], H[0], H[1], H[2], H[3]}
  od = __builtin_amdgcn_mfma_f32_32x32x16_bf16(pa0, PK(l0, h0), od, 0, 0, 0);
  od = __builtin_amdgcn_mfma_f32_32x32x16_bf16(pa1, PK(l1, h1), od, 0, 0, 0);
  od = __builtin_amdgcn_mfma_f32_32x32x16_bf16(pa2, PK(l2, h2), od, 0, 0, 0);
  od = __builtin_amdgcn_mfma_f32_32x32x16_bf16(pa3, PK(l3, h3), od, 0, 0, 0);
#undef PK
}
__device__ __forceinline__ void pv_d0(f32x16* o, int vb, bf16x8 pa0, bf16x8 pa1, bf16x8 pa2, bf16x8 pa3) {
  pv_one<0>(o[0], vb, pa0, pa1, pa2, pa3); pv_one<1>(o[1], vb, pa0, pa1, pa2, pa3); pv_one<2>(o[2], vb, pa0, pa1, pa2, pa3); pv_one<3>(o[3], vb, pa0, pa1, pa2, pa3);
}

__device__ __forceinline__ void attn_unit(const bf16_t* __restrict__ Qb, const bf16_t* __restrict__ Kh, const bf16_t* __restrict__ Vh, bf16_t* __restrict__ Ob, char* lds) {
  const int tid = threadIdx.x, wid = tid >> 6, lane = tid & 63, r32 = lane & 31, hi = lane >> 5;
  char* V_lds = lds; char* K_lds = lds + 2 * SHM_V;
  float* wsf = (float*)(lds + 2 * SHM_V + 2 * SHM_K) + wid * 64; float* li_l = wsf; float* al_l = wsf + 32;
  float m_reg = -1e30f, l_reg = 0; f32x16 o[4] = {}; bf16x8 qr[12];
  const bf16_t* Qw = Qb + (long)(wid * QBLK + r32) * QKD + hi * 8;
#pragma unroll
  for (int d0 = 0; d0 < 12; ++d0) qr[d0] = *reinterpret_cast<const bf16x8*>(Qw + d0 * 16);
  const int sr = tid >> 4, sc = (tid & 15) * 8, vst0 = v_st(sr, sc), vst1 = v_st(32 + sr, sc);
  int kst[3];
#pragma unroll
  for (int i = 0; i < 3; ++i) { const int q = tid + i * 512; kst[i] = KSWZ(q / 24, (q % 24) * 16); }
  const int vb0 = (int)(uintptr_t)V_lds + v_rd_base(lane);
  bf16x8 vs0, vs1, ks0, ks1, ks2;
#define SLOAD(k0) do { vs0 = *reinterpret_cast<const bf16x8*>(&Vh[(long)((k0) + sr) * VD + sc]); vs1 = *reinterpret_cast<const bf16x8*>(&Vh[(long)((k0) + 32 + sr) * VD + sc]); \
    const bf16_t* kt_ = Kh + (long)(k0) * QKD + tid * 8; ks0 = *reinterpret_cast<const bf16x8*>(kt_); ks1 = *reinterpret_cast<const bf16x8*>(kt_ + 4096); ks2 = *reinterpret_cast<const bf16x8*>(kt_ + 8192); } while (0)
#define SWRITE(b) do { *(bf16x8*)(V_lds + (b) * SHM_V + vst0) = vs0; *(bf16x8*)(V_lds + (b) * SHM_V + vst1) = vs1; \
    *(bf16x8*)(K_lds + (b) * SHM_K + kst[0]) = ks0; *(bf16x8*)(K_lds + (b) * SHM_K + kst[1]) = ks1; *(bf16x8*)(K_lds + (b) * SHM_K + kst[2]) = ks2; } while (0)
#define SWAIT() asm volatile("s_waitcnt vmcnt(0)" ::: "memory")
#define RESC(a) do { if (__any((a) < 1.f)) { if (hi == 0) al_l[r32] = (a); asm volatile("s_waitcnt lgkmcnt(0)" ::: "memory"); \
    _Pragma("unroll") for (int d = 0; d < 4; ++d) _Pragma("unroll") for (int r = 0; r < 16; ++r) o[d][r] *= al_l[crow(r, hi)]; } } while (0)
  f32x16 p0, p1; float mn, al; bf16x8 pa0, pa1, pa2, pa3; const int NT = SKV / KVBLK;
  SLOAD(0); SWAIT(); SWRITE(0); __syncthreads();
  for (int j = 0; j < NT; ++j) {
    const int cur = j & 1;
    if (j + 1 < NT) SLOAD((j + 1) * KVBLK);
    SBAR(); qkt(p0, p1, K_lds + cur * SHM_K, qr, r32, hi);
    partialSM(p0, p1, m_reg, mn, al);
    RESC(al);
    finishSM(p0, p1, al, l_reg, pa0, pa1, pa2, pa3); SBAR();
    pv_d0(o, vb0 + cur * (int)SHM_V, pa0, pa1, pa2, pa3);
    if (j + 1 < NT) { SWAIT(); SWRITE(cur ^ 1); }
    __syncthreads();
  }
  if (hi == 0) li_l[r32] = l_reg; asm volatile("s_waitcnt lgkmcnt(0)" ::: "memory");
  float rli[16];
#pragma unroll
  for (int r = 0; r < 16; ++r) rli[r] = __builtin_amdgcn_rcpf(li_l[crow(r, hi)]);
  bf16_t* Ow = Ob + (long)(wid * QBLK) * DM;
#pragma unroll
  for (int r = 0; r < 16; ++r) { int orow = crow(r, hi);
#pragma unroll
    for (int d0 = 0; d0 < 4; ++d0) Ow[(long)orow * DM + d0 * 32 + r32] = (bf16_t)f2bf(o[d0][r] * rli[r]); }
  __syncthreads();
#undef SLOAD
#undef SWRITE
#undef SWAIT
#undef RESC
}
}

struct Args { const float* in[24]; float* out; unsigned char* ws; int ph_lo, ph_hi; };

template <int MODE> __device__ __forceinline__ int src_col(int n) {
    if (MODE == 1) return n < 832 ? n : (n < 1024 ? -1 : n - 192);
    if (MODE == 2) { const int pn = n >> 8, j = n & 255; return j < 128 ? pn * 128 + j : DFF + pn * 128 + (j - 128); }
    return n;
}
template <int MODE> __device__ __forceinline__ void tr_item(const float* __restrict__ W, int ldw, int k0, int n0, bf16_t* __restrict__ WT, int ldt, const float* __restrict__ gk, LAS float* scr, int lane) {
    const int sc = src_col<MODE>(n0 + (lane & 31) * 4);
#pragma unroll 4
    for (int i = 0; i < 16; ++i) { const int kk = 2 * i + (lane >> 5); f32x4 v = (f32x4){0.f, 0.f, 0.f, 0.f};
        if (sc >= 0) { v = *(const f32x4*)(W + (size_t)(k0 + kk) * ldw + sc); if (gk) v = v * gk[k0 + kk]; }
        LAS float* d = scr + kk * 129 + (lane & 31) * 4; d[0] = v.x; d[1] = v.y; d[2] = v.z; d[3] = v.w; }
    LDS_WAIT();
    const int c = lane & 3;
#pragma unroll
    for (int j = 0; j < 8; ++j) { const int n = (lane >> 2) + 16 * j; const LAS float* sp = scr + (8 * c) * 129 + n;
        u32x4 o; o.x = pk2(sp[0 * 129], sp[1 * 129]); o.y = pk2(sp[2 * 129], sp[3 * 129]); o.z = pk2(sp[4 * 129], sp[5 * 129]); o.w = pk2(sp[6 * 129], sp[7 * 129]);
        *(u32x4*)(WT + (size_t)(n0 + n) * ldt + k0 + 8 * c) = o; }
    LDS_WAIT();
}

__global__ void __launch_bounds__(512, 2) fwd_kernel(Args args) {
    extern __shared__ __attribute__((aligned(16))) unsigned char lds[];
    const int tid = threadIdx.x, lane = tid & 63, wave = __builtin_amdgcn_readfirstlane(tid >> 6);
    const int G = gridDim.x, bx = blockIdx.x;
    const int vcu = (G % 8 == 0) ? (bx % 8) * (G / 8) + bx / 8 : bx;
    const int gw = vcu * 8 + wave, NGW = G * 8;
    unsigned char* ws = args.ws;
    const float* x = args.in[0]; const float* cvec = args.in[1]; const float* ctx = args.in[2]; const float* c_ctx = args.in[3];
    const float* w_mod = args.in[4]; const float* b_mod = args.in[5]; const float* norm1_g = args.in[6]; const float* w_in = args.in[7];
    const float* q_norm_g = args.in[8]; const float* kv_norm_g = args.in[9]; const float* w_uq = args.in[10]; const float* w_ukv = args.in[11];
    const float* qk_norm_q = args.in[12]; const float* qk_norm_k = args.in[13]; const float* sgu_norm_g = args.in[14]; const float* sgu_norm_b = args.in[15];
    const float* w_spatial = args.in[16]; const float* b_spatial = args.in[17]; const float* w_br_attn = args.in[18]; const float* w_br_sgu = args.in[19];
    const float* w_out = args.in[20]; const float* norm2_g = args.in[21]; const float* w_ffn_in = args.in[22]; const float* w_ffn_out = args.in[23];
    float* out = args.out;
    float* MOD = (float*)(ws + WS_MOD);
    bf16_t* WIN = (bf16_t*)(ws + WS_WIN); bf16_t* WUQ = (bf16_t*)(ws + WS_WUQ); bf16_t* WUKV = (bf16_t*)(ws + WS_WUKV);
    bf16_t* WBR = (bf16_t*)(ws + WS_WBRA); bf16_t* WOUT = (bf16_t*)(ws + WS_WOUT);
    bf16_t* WFI = (bf16_t*)(ws + WS_WFI); bf16_t* WFO = (bf16_t*)(ws + WS_WFO); bf16_t* WSP = (bf16_t*)(ws + WS_WSP);
    bf16_t* H = (bf16_t*)(ws + WS_H); bf16_t* KVUP = H; bf16_t* AO = H; bf16_t* H2 = H;
    bf16_t* P = (bf16_t*)(ws + WS_P); bf16_t* ACT = P;
    bf16_t* KF = (bf16_t*)(ws + WS_KF); bf16_t* VF = (bf16_t*)(ws + WS_VF); bf16_t* MERGED = (bf16_t*)(ws + WS_MERGED);
    bf16_t* QUP = (bf16_t*)out; bf16_t* QF = (bf16_t*)((unsigned char*)out + DO_QF);
    const int lo = args.ph_lo, hi = args.ph_hi;
#ifndef PH_MASK
#define PH_MASK 0x7ff
#endif
#define IN(k) ((((PH_MASK) >> (k)) & 1) && lo <= (k) && (k) < hi)
#ifndef PROBE_DUP
#define PROBE_DUP 0
#endif
#define REPS(k) ((((PROBE_DUP) >> (k)) & 1) ? 2 : 1)
#define SEAM(k) do { if (IN(k) && IN((k) + 1)) { cg::this_grid().sync(); } } while (0)

    if (IN(0)) for (int rep_ = 0; rep_ < REPS(0); ++rep_) { if (rep_) cg::this_grid().sync();
        LAS float* sact = (LAS float*)lds;
        LAS float* red = (LAS float*)(lds + 40960);
        for (int i = tid; i < 5 * DM; i += 512) { const float v = (i < 4 * DM) ? cvec[i] : c_ctx[i - 4 * DM]; sact[i] = v / (1.0f + __expf(-v)); }
        __syncthreads();
        for (int cb = bx; cb < NMOD / 48; cb += G) {
            const int n0 = cb * 48, c4 = tid % 12, kg = tid / 12;
            if (kg < 42) {
                f32x4 a[5];
#pragma unroll
                for (int r = 0; r < 5; ++r) a[r] = (f32x4){0.f, 0.f, 0.f, 0.f};
                for (int k = kg; k < DM; k += 42) { const f32x4 w = *(const f32x4*)(w_mod + (size_t)k * NMOD + n0 + c4 * 4);
#pragma unroll
                    for (int r = 0; r < 5; ++r) a[r] += w * sact[r * DM + k]; }
#pragma unroll
                for (int r = 0; r < 5; ++r)
#pragma unroll
                    for (int j = 0; j < 4; ++j) red[(kg * 5 + r) * 48 + c4 * 4 + j] = a[r][j];
            }
            __syncthreads();
            if (tid < 240) { const int r = tid / 48, col = tid % 48; float s = 0.f;
                for (int k2 = 0; k2 < 42; ++k2) s += red[(k2 * 5 + r) * 48 + col];
                MOD[(size_t)r * NMOD + n0 + col] = s + b_mod[n0 + col]; }
            __syncthreads();
        }
        LAS float* scr = (LAS float*)(lds + wave * 16512);
        constexpr int I_IN = 64 * 56, I_UQ = 16 * 12, I_UKV = 8 * 16, I_BR = 32 * 16, I_OUT = 64 * 16, I_FI = 64 * 88, I_FO = 176 * 16;
        constexpr int NITEMS = I_IN + I_UQ + I_UKV + 2 * I_BR + I_OUT + I_FI + I_FO;
        for (int it = gw; it < NITEMS; it += NGW) {
            int r = it;
            if (r < I_IN) { tr_item<1>(w_in, IN_COLS, (r / 56) * 32, (r % 56) * 128, WIN, DM, nullptr, scr, lane); continue; } r -= I_IN;
            if (r < I_UQ) { tr_item<0>(w_uq, NH * QKD, (r / 12) * 32, (r % 12) * 128, WUQ, QL, q_norm_g, scr, lane); continue; } r -= I_UQ;
            if (r < I_UKV) { tr_item<0>(w_ukv, 2048, (r / 16) * 32, (r % 16) * 128, WUKV, KVL, kv_norm_g, scr, lane); continue; } r -= I_UKV;
            if (r < I_BR) { tr_item<0>(w_br_attn, DM, (r / 16) * 32, (r % 16) * 128, WBR, DM, nullptr, scr, lane); continue; } r -= I_BR;
            if (r < I_BR) { tr_item<0>(w_br_sgu, DM, (r / 16) * 32, (r % 16) * 128, WBR + 1024, DM, nullptr, scr, lane); continue; } r -= I_BR;
            if (r < I_OUT) { tr_item<0>(w_out, DM, (r / 16) * 32, (r % 16) * 128, WOUT, DM, nullptr, scr, lane); continue; } r -= I_OUT;
            if (r < I_FI) { tr_item<2>(w_ffn_in, 2 * DFF, (r / 88) * 32, (r % 88) * 128, WFI, DM, nullptr, scr, lane); continue; } r -= I_FI;
            tr_item<0>(w_ffn_out, DM, (r / 16) * 32, (r % 16) * 128, WFO, DFF, nullptr, scr, lane);
        }
        for (int i = (bx * 512 + tid); i < 8 * 128 * 128 / 2; i += G * 512) { const f32x2 v = *(const f32x2*)(w_spatial + 2 * (size_t)i); ((unsigned*)WSP)[i] = pk2(v.x, v.y); }
    }
    SEAM(0);

    if (IN(1)) for (int rep_ = 0; rep_ < REPS(1); ++rep_) { if (rep_) cg::this_grid().sync();
        for (int row = gw; row < MROWS; row += NGW) {
            const float* src = row < NTOK ? x + (size_t)row * DM : ctx + (size_t)(row - NTOK) * DM;
            const int b = row < NTOK ? row / SEQ : 4;
            const float* sh = MOD + (size_t)b * NMOD; const float* scp = sh + DM;
            f32x4 v[8]; float ss = 0.f;
#pragma unroll
            for (int j = 0; j < 8; ++j) { v[j] = *(const f32x4*)(src + (lane + 64 * j) * 4); ss += (v[j].x * v[j].x + v[j].y * v[j].y) + (v[j].z * v[j].z + v[j].w * v[j].w); }
            const float r = 1.0f / sqrtf(wave_sum(ss) * (1.0f / DM) + EPS);
#pragma unroll
            for (int j = 0; j < 8; ++j) { const int idx = (lane + 64 * j) * 4; const f32x4 g = *(const f32x4*)(norm1_g + idx), s1 = *(const f32x4*)(scp + idx), s0 = *(const f32x4*)(sh + idx);
                const f32x4 o = (v[j] * r * g) * (s1 + 1.0f) + s0;
                u32x2 w; w.x = pk2(o.x, o.y); w.y = pk2(o.z, o.w); *(u32x2*)(H + (size_t)row * DM + idx) = w; }
        }
    }
    SEAM(1);

    if (IN(2)) for (int rep_ = 0; rep_ < REPS(2); ++rep_) { if (rep_) cg::this_grid().sync();
        pg8::Gemm g{H, WIN, MROWS, PCOLS, DM, DM, DM}; pg8::ProjOrder S; S.init(G, bx);
        pg8::EpiProj E{P, PCOLS};
        pg8::gemm_phase<pg8::EpiProj, pg8::ProjOrder>((LAS unsigned char*)lds, g, S, E);
    }
    SEAM(2);

    if (IN(3)) for (int rep_ = 0; rep_ < REPS(3); ++rep_) { if (rep_) cg::this_grid().sync();
        { pg8::Gemm g{P, WUQ, NTOK, NH * QKD, QL, PCOLS, QL}; pg8::StaticOrder S; S.init(NTOK, NH * QKD, G, bx);
          pg8::EpiBf16 E{QUP, NH * QKD};
          pg8::gemm_phase<pg8::EpiBf16, pg8::StaticOrder>((LAS unsigned char*)lds, g, S, E); }
        { pg8::Gemm g{P + PC_KV, WUKV, MROWS, 2048, KVL, PCOLS, KVL}; pg8::StaticOrder S; S.init(MROWS, 2048, G, bx);
          pg8::EpiBf16 E{KVUP, 2048};
          pg8::gemm_phase<pg8::EpiBf16, pg8::StaticOrder>((LAS unsigned char*)lds, g, S, E); }
    }
    SEAM(3);

    if (IN(4)) for (int rep_ = 0; rep_ < REPS(4); ++rep_) { if (rep_) cg::this_grid().sync();
        for (int t = gw; t < MROWS; t += NGW) {
            const bool lat = t < NTOK;
            const bf16_t* Prow = P + (size_t)t * PCOLS;
            int b, n, m;
            if (lat) { b = t / SEQ; n = t % SEQ; m = n; } else { const int tc = t - NTOK; b = tc / CTXL; n = 0; m = SEQ + tc % CTXL; }
            float r_kv;
            { const u32x2 w = *(const u32x2*)(Prow + PC_KV + lane * 4); const float a0 = bflo(w.x), a1 = bfhi(w.x), a2 = bflo(w.y), a3 = bfhi(w.y);
              r_kv = 1.0f / sqrtf(wave_sum((a0 * a0 + a1 * a1) + (a2 * a2 + a3 * a3)) * (1.0f / KVL) + EPS); }
            const float kr = bf2f(Prow[PC_KR + lane]);
            float cs = 1.f, sn = 0.f;
            if (lat) { const int i = lane & 15; const float pos = (float)((lane < 32) ? (n >> 6) : (n & 63));
                const float freq = exp2f(-(float)i * (13.287712379549449f / 16.0f));
                float rev = pos * freq * 0.15915494309189535f; rev -= floorf(rev);
                cs = __builtin_amdgcn_cosf(rev); sn = __builtin_amdgcn_sinf(rev); }
            const bool first = (lane & 16) == 0;
            const float gk0 = qk_norm_k[lane], gk1 = qk_norm_k[64 + lane], gk2 = qk_norm_k[128 + lane];
            const bf16_t* kvrow = KVUP + (size_t)t * 2048;
#pragma unroll 2
            for (int h = 0; h < NH; ++h) {
                const float e0 = bf2f(kvrow[h * 256 + lane]) * r_kv, e1 = bf2f(kvrow[h * 256 + 64 + lane]) * r_kv;
                const float v0 = bf2f(kvrow[h * 256 + 128 + lane]) * r_kv, v1 = bf2f(kvrow[h * 256 + 192 + lane]) * r_kv;
                const float rn = 1.0f / sqrtf(wave_sum(e0 * e0 + e1 * e1 + kr * kr) * (1.0f / QKD) + EPS);
                const float k0 = e0 * rn * gk0, k1 = e1 * rn * gk1; float k2 = kr * rn * gk2;
                if (lat) { const float pr = __shfl_xor(k2, 16); k2 = first ? k2 * cs - pr * sn : k2 * cs + pr * sn; }
                bf16_t* kd = KF + ((size_t)(b * NH + h) * SKV + m) * QKD;
                kd[lane] = (bf16_t)f2bf(k0); kd[64 + lane] = (bf16_t)f2bf(k1); kd[128 + lane] = (bf16_t)f2bf(k2);
                bf16_t* vd = VF + ((size_t)(b * NH + h) * SKV + m) * VD;
                vd[lane] = (bf16_t)f2bf(v0); vd[64 + lane] = (bf16_t)f2bf(v1);
            }
            if (lat) {
                float r_q;
                { const u32x4 w = *(const u32x4*)(Prow + lane * 8); float s = 0.f;
                  s += bflo(w.x) * bflo(w.x) + bfhi(w.x) * bfhi(w.x); s += bflo(w.y) * bflo(w.y) + bfhi(w.y) * bfhi(w.y);
                  s += bflo(w.z) * bflo(w.z) + bfhi(w.z) * bfhi(w.z); s += bflo(w.w) * bflo(w.w) + bfhi(w.w) * bfhi(w.w);
                  r_q = 1.0f / sqrtf(wave_sum(s) * (1.0f / QL) + EPS); }
                const float gq0 = qk_norm_q[lane], gq1 = qk_norm_q[64 + lane], gq2 = qk_norm_q[128 + lane];
                const bf16_t* qrow = QUP + (size_t)t * (NH * QKD);
#pragma unroll 2
                for (int h = 0; h < NH; ++h) {
                    const float e0 = bf2f(qrow[h * QKD + lane]) * r_q, e1 = bf2f(qrow[h * QKD + 64 + lane]) * r_q, e2 = bf2f(qrow[h * QKD + 128 + lane]) * r_q;
                    const float rn = 1.0f / sqrtf(wave_sum(e0 * e0 + e1 * e1 + e2 * e2) * (1.0f / QKD) + EPS);
                    const float q0 = e0 * rn * gq0, q1 = e1 * rn * gq1; float q2 = e2 * rn * gq2;
                    const float pr = __shfl_xor(q2, 16); q2 = first ? q2 * cs - pr * sn : q2 * cs + pr * sn;
                    bf16_t* qd = QF + ((size_t)(b * NH + h) * SEQ + n) * QKD;
                    qd[lane] = (bf16_t)f2bf(q0); qd[64 + lane] = (bf16_t)f2bf(q1); qd[128 + lane] = (bf16_t)f2bf(q2);
                }
                bf16_t* vp = (bf16_t*)Prow + PC_V;
                float f[16]; float s = 0.f;
#pragma unroll
                for (int j = 0; j < 2; ++j) { const u32x4 w = *(const u32x4*)(vp + j * 512 + lane * 8);
                    f[j * 8 + 0] = bflo(w.x); f[j * 8 + 1] = bfhi(w.x); f[j * 8 + 2] = bflo(w.y); f[j * 8 + 3] = bfhi(w.y);
                    f[j * 8 + 4] = bflo(w.z); f[j * 8 + 5] = bfhi(w.z); f[j * 8 + 6] = bflo(w.w); f[j * 8 + 7] = bfhi(w.w); }
#pragma unroll
                for (int j = 0; j < 16; ++j) s += f[j];
                const float mu = wave_sum(s) * (1.0f / 1024.0f); float q = 0.f;
#pragma unroll
                for (int j = 0; j < 16; ++j) { f[j] -= mu; q += f[j] * f[j]; }
                const float rstd = 1.0f / sqrtf(wave_sum(q) * (1.0f / 1024.0f) + EPS);
#pragma unroll
                for (int j = 0; j < 2; ++j) { const int c0 = j * 512 + lane * 8; float o[8];
#pragma unroll
                    for (int e = 0; e < 8; ++e) o[e] = f[j * 8 + e] * rstd * sgu_norm_g[c0 + e] + sgu_norm_b[c0 + e];
                    u32x4 w; w.x = pk2(o[0], o[1]); w.y = pk2(o[2], o[3]); w.z = pk2(o[4], o[5]); w.w = pk2(o[6], o[7]);
                    *(u32x4*)(vp + c0) = w; }
            }
        }
    }
    SEAM(4);

    if (IN(5)) for (int rep_ = 0; rep_ < REPS(5); ++rep_) { if (rep_) cg::this_grid().sync();
        LAS bf16_t* vt = (LAS bf16_t*)lds;
        for (int un = vcu; un < 1024; un += G) {
            const int ck = un >> 3, g = un & 7; const size_t t0 = (size_t)ck * 128;
#pragma unroll
            for (int i = 0; i < 4; ++i) { const int q = tid + i * 512, j = q >> 4, c0 = (q & 15) * 8;
                const u32x4 w = *(const u32x4*)(P + (t0 + j) * PCOLS + PC_V + g * 128 + c0);
                vt[(c0 + 0) * 136 + j] = (bf16_t)(w.x & 0xffff); vt[(c0 + 1) * 136 + j] = (bf16_t)(w.x >> 16);
                vt[(c0 + 2) * 136 + j] = (bf16_t)(w.y & 0xffff); vt[(c0 + 3) * 136 + j] = (bf16_t)(w.y >> 16);
                vt[(c0 + 4) * 136 + j] = (bf16_t)(w.z & 0xffff); vt[(c0 + 5) * 136 + j] = (bf16_t)(w.z >> 16);
                vt[(c0 + 6) * 136 + j] = (bf16_t)(w.w & 0xffff); vt[(c0 + 7) * 136 + j] = (bf16_t)(w.w >> 16); }
            __syncthreads();
            const int fr = lane & 15, fq = lane >> 4;
            bf16x8 af[4];
#pragma unroll
            for (int kk = 0; kk < 4; ++kk) af[kk] = *(const bf16x8*)(WSP + ((size_t)g * 128 + wave * 16 + fr) * 128 + kk * 32 + fq * 8);
            float bs[4];
#pragma unroll
            for (int j = 0; j < 4; ++j) bs[j] = b_spatial[g * 128 + wave * 16 + fq * 4 + j];
#pragma unroll
            for (int nb = 0; nb < 8; ++nb) {
                f32x4 acc = (f32x4){0.f, 0.f, 0.f, 0.f};
#pragma unroll
                for (int kk = 0; kk < 4; ++kk) { const bf16x8 bfr = *(const LAS bf16x8*)(vt + (nb * 16 + fr) * 136 + kk * 32 + fq * 8);
                    acc = __builtin_amdgcn_mfma_f32_16x16x32_bf16(af[kk], bfr, acc, 0, 0, 0); }
#pragma unroll
                for (int j = 0; j < 4; ++j) { const size_t t = t0 + wave * 16 + fq * 4 + j; const int c = g * 128 + nb * 16 + fr;
                    const float u = bf2f(P[t * PCOLS + PC_U + c]);
                    AO[t * DM + 1024 + c] = (bf16_t)f2bf(u * (acc[j] + bs[j])); }
            }
            __syncthreads();
        }
        for (int un = vcu; un < NB * NH * (SEQ / 256); un += G) {
            const int bh = un >> 4, qb = un & 15, b = bh >> 3, h = bh & 7;
            att::attn_unit(QF + ((size_t)bh * SEQ + qb * 256) * QKD, KF + (size_t)bh * SKV * QKD, VF + (size_t)bh * SKV * VD,
                           AO + ((size_t)b * SEQ + qb * 256) * DM + h * VD, (char*)lds);
        }
    }
    SEAM(5);

    if (IN(6)) for (int rep_ = 0; rep_ < REPS(6); ++rep_) { if (rep_) cg::this_grid().sync();
        pg8::Gemm g{AO, WBR, NTOK, DM, DM, DM, DM}; pg8::StaticOrder S; S.init(NTOK, DM, G, bx);
        pg8::EpiMerge E{P + PC_GA, P + PC_GS, PCOLS, MERGED};
        pg8::gemm_phase<pg8::EpiMerge, pg8::StaticOrder>((LAS unsigned char*)lds, g, S, E);
    }
    SEAM(6);

    if (IN(7)) for (int rep_ = 0; rep_ < REPS(7); ++rep_) { if (rep_) cg::this_grid().sync();
        pg8::Gemm g{MERGED, WOUT, NTOK, DM, DM, DM, DM}; pg8::StaticOrder S; S.init(NTOK, DM, G, bx);
        pg8::EpiRes E{x, out, MOD + 2 * DM};
        pg8::gemm_phase<pg8::EpiRes, pg8::StaticOrder>((LAS unsigned char*)lds, g, S, E);
    }
    SEAM(7);

    if (IN(8)) for (int rep_ = 0; rep_ < REPS(8); ++rep_) { if (rep_) cg::this_grid().sync();
        for (int row = gw; row < NTOK; row += NGW) {
            const float* src = out + (size_t)row * DM; const int b = row / SEQ;
            const float* sh = MOD + (size_t)b * NMOD + 3 * DM; const float* scp = sh + DM;
            f32x4 v[8]; float ss = 0.f;
#pragma unroll
            for (int j = 0; j < 8; ++j) { v[j] = *(const f32x4*)(src + (lane + 64 * j) * 4); ss += (v[j].x * v[j].x + v[j].y * v[j].y) + (v[j].z * v[j].z + v[j].w * v[j].w); }
            const float r = 1.0f / sqrtf(wave_sum(ss) * (1.0f / DM) + EPS);
#pragma unroll
            for (int j = 0; j < 8; ++j) { const int idx = (lane + 64 * j) * 4; const f32x4 g = *(const f32x4*)(norm2_g + idx), s1 = *(const f32x4*)(scp + idx), s0 = *(const f32x4*)(sh + idx);
                const f32x4 o = (v[j] * r * g) * (s1 + 1.0f) + s0;
                u32x2 w; w.x = pk2(o.x, o.y); w.y = pk2(o.z, o.w); *(u32x2*)(H2 + (size_t)row * DM + idx) = w; }
        }
    }
    SEAM(8);

    if (IN(9)) for (int rep_ = 0; rep_ < REPS(9); ++rep_) { if (rep_) cg::this_grid().sync();
        pg8::Gemm g{H2, WFI, NTOK, 2 * DFF, DM, DM, DM}; pg8::StaticOrder S; S.init(NTOK, 2 * DFF, G, bx);
        pg8::EpiFfnIn E{ACT};
        pg8::gemm_phase<pg8::EpiFfnIn, pg8::StaticOrder>((LAS unsigned char*)lds, g, S, E);
    }
    SEAM(9);

    if (IN(10)) for (int rep_ = 0; rep_ < REPS(10); ++rep_) { if (rep_) cg::this_grid().sync();
        pg8::Gemm g{ACT, WFO, NTOK, DM, DFF, DFF, DFF}; pg8::StaticOrder S; S.init(NTOK, DM, G, bx);
        pg8::EpiRes E{out, out, MOD + 5 * DM};
        pg8::gemm_phase<pg8::EpiRes, pg8::StaticOrder>((LAS unsigned char*)lds, g, S, E);
    }
#undef IN
#undef SEAM
}

constexpr int N_PHASES = 11;

extern "C" void kernel_launch(void* const* d_in, const int* in_sizes, int n_in, void* d_out, int out_size, void* d_ws, size_t ws_size, hipStream_t stream) {
    static int grid = 0;
    if (grid == 0) {
        if (n_in != 24 || out_size != NTOK * DM || ws_size < WS_END) { fprintf(stderr, "kernel_launch: unexpected shapes n_in %d out %d ws %zu\n", n_in, out_size, ws_size); grid = -1; return; }
        int dev = 0, cus = 0, per_cu = 0;
        (void)hipGetDevice(&dev); (void)hipDeviceGetAttribute(&cus, hipDeviceAttributeMultiprocessorCount, dev);
        if (hipFuncSetAttribute((const void*)fwd_kernel, hipFuncAttributeMaxDynamicSharedMemorySize, LDS_BYTES) != hipSuccess) { fprintf(stderr, "kernel_launch: hipFuncSetAttribute failed\n"); grid = -1; return; }
        if (hipOccupancyMaxActiveBlocksPerMultiprocessor(&per_cu, (const void*)fwd_kernel, 512, LDS_BYTES) != hipSuccess || per_cu < 1) { fprintf(stderr, "kernel_launch: occupancy query says %d\n", per_cu); per_cu = 1; }
        (void)hipGetLastError();
        grid = cus * per_cu;
    }
    if (grid < 0) return;
    Args a{};
    for (int i = 0; i < 24; ++i) a.in[i] = (const float*)d_in[i];
    a.out = (float*)d_out; a.ws = (unsigned char*)d_ws;
#if MK_LAUNCH_PER_PHASE
    for (int p = 0; p < N_PHASES; ++p) { a.ph_lo = p; a.ph_hi = p + 1;
        hipLaunchKernelGGL(fwd_kernel, dim3(grid), dim3(512), LDS_BYTES, stream, a); }
#else
#ifndef PROBE_SPLIT
    a.ph_lo = 0; a.ph_hi = N_PHASES;
    void* kargs[] = {&a};
    hipError_t e = hipLaunchCooperativeKernel((const void*)fwd_kernel, dim3(grid), dim3(512), kargs, LDS_BYTES, stream);
    if (e != hipSuccess) fprintf(stderr, "cooperative launch failed: %s (grid %d)\n", hipGetErrorString(e), grid);
#else
    void* kargs[] = {&a};
    a.ph_lo = 0; a.ph_hi = PROBE_SPLIT + 1;
    (void)hipLaunchCooperativeKernel((const void*)fwd_kernel, dim3(grid), dim3(512), kargs, LDS_BYTES, stream);
    a.ph_lo = PROBE_SPLIT; a.ph_hi = N_PHASES;
    (void)hipLaunchCooperativeKernel((const void*)fwd_kernel, dim3(grid), dim3(512), kargs, LDS_BYTES, stream);
#endif
#endif
}
```

```cpp
#include <hip/hip_runtime.h>
#include <hip/hip_cooperative_groups.h>
#include <cstdio>
#include <cstdint>
namespace cg = cooperative_groups;

#ifndef MK_LAUNCH_PER_PHASE
#define MK_LAUNCH_PER_PHASE 0
#endif

#define LAS __attribute__((address_space(3)))
typedef unsigned short bf16_t;
typedef short bf16x8 __attribute__((ext_vector_type(8)));
typedef short s16x4 __attribute__((ext_vector_type(4)));
typedef float f32x2 __attribute__((ext_vector_type(2)));
typedef float f32x4 __attribute__((ext_vector_type(4)));
typedef float f32x16 __attribute__((ext_vector_type(16)));
typedef unsigned u32x2 __attribute__((ext_vector_type(2)));
typedef unsigned u32x4 __attribute__((ext_vector_type(4)));

constexpr int DM = 2048, NB = 4, SEQ = 4096, NTOK = NB * SEQ, CTXL = 256, NCTX = NB * CTXL, MROWS = NTOK + NCTX;
constexpr int NH = 8, QL = 512, KVL = 256, QKD = 192, VD = 128;
constexpr int DFF = 5632, NMOD = 6 * DM;
constexpr int SKV = SEQ + CTXL;
constexpr int PCOLS = 7168;
constexpr int PC_KV = 512, PC_KR = 768, PC_U = 1024, PC_V = 2048, PC_GA = 3072, PC_GS = 5120;
constexpr int IN_COLS = 6976;
constexpr float EPS = 1e-6f;

constexpr size_t MiB = 1u << 20;
constexpr size_t WS_MOD = 0;
constexpr size_t WS_ROPE = 512 * 1024;
constexpr size_t WS_BAR = 768 * 1024;
constexpr size_t WS_WIN = 1 * MiB;
constexpr size_t WS_WUQ = 29 * MiB;
constexpr size_t WS_WUKV = 31 * MiB;
constexpr size_t WS_WBRA = 32 * MiB;
constexpr size_t WS_WBRS = 36 * MiB;
constexpr size_t WS_WOUT = 40 * MiB;
constexpr size_t WS_WFI = 48 * MiB;
constexpr size_t WS_WFO = 92 * MiB;
constexpr size_t WS_WSP = 114 * MiB;
constexpr size_t WS_H = 116 * MiB;
constexpr size_t WS_P = 184 * MiB;
constexpr size_t WS_KF = 422 * MiB;
constexpr size_t WS_VF = 473 * MiB;
constexpr size_t WS_MERGED = 422 * MiB;
constexpr size_t WS_END = 512 * MiB;
constexpr size_t DO_QF = 48 * MiB;

constexpr int LDS_BYTES = 139264, LDS_BARST = 139200;

__device__ __forceinline__ unsigned f2bf(float f) { unsigned u = __builtin_bit_cast(unsigned, f); return (u + 0x7fffu + ((u >> 16) & 1u)) >> 16; }
__device__ __forceinline__ unsigned pk2(float lo, float hi) { unsigned r; asm("v_cvt_pk_bf16_f32 %0, %1, %2" : "=v"(r) : "v"(lo), "v"(hi)); return r; }
__device__ __forceinline__ float bf2f(unsigned short b) { return __builtin_bit_cast(float, ((unsigned)b) << 16); }
__device__ __forceinline__ float bflo(unsigned w) { return __builtin_bit_cast(float, w << 16); }
__device__ __forceinline__ float bfhi(unsigned w) { return __builtin_bit_cast(float, w & 0xffff0000u); }
template <int CTRL> __device__ __forceinline__ float dppf(float v) { return __builtin_bit_cast(float, __builtin_amdgcn_update_dpp(0, __builtin_bit_cast(int, v), CTRL, 0xf, 0xf, true)); }
#define DPP_XOR1 0xB1
#define DPP_XOR2 0x4E
#define DPP_HMIR 0x141
#define DPP_MIR  0x140
__device__ __forceinline__ float sum4(float v) { v += dppf<DPP_XOR1>(v); v += dppf<DPP_XOR2>(v); return v; }
__device__ __forceinline__ float sum8(float v) { v = sum4(v); v += dppf<DPP_HMIR>(v); return v; }
__device__ __forceinline__ float sum16(float v) { v = sum8(v); v += dppf<DPP_MIR>(v); return v; }
__device__ __forceinline__ float wave_sum(float v) {
    v = sum16(v);
    const float a = __builtin_bit_cast(float, __builtin_amdgcn_readlane(__builtin_bit_cast(int, v), 0)), b = __builtin_bit_cast(float, __builtin_amdgcn_readlane(__builtin_bit_cast(int, v), 16));
    const float c = __builtin_bit_cast(float, __builtin_amdgcn_readlane(__builtin_bit_cast(int, v), 32)), d = __builtin_bit_cast(float, __builtin_amdgcn_readlane(__builtin_bit_cast(int, v), 48));
    return (a + b) + (c + d);
}
#define LDS_WAIT() asm volatile("s_waitcnt lgkmcnt(0)" ::: "memory")

namespace pg8 {
#define PG8_LAS __attribute__((address_space(3)))
constexpr int BM = 256, BK = 64, HALF = 128, HTB = HALF * BK * 2, STAGE_BYTES = 8 * HTB, NXCD = 8, WGM = 7;
__host__ __device__ __forceinline__ int lds_byte(int r, int c) { const int st = (r >> 4) * 2 + (c >> 5), rr = r & 15, cc = c & 31, ob = rr * 64 + cc * 2; return st * 1024 + (ob ^ (((ob >> 9) & 1) << 5)); }
__host__ __device__ __forceinline__ void stage_rc(int b, int& R, int& C) { const int st = b / 1024, sb = b % 1024, swz = sb ^ (((sb >> 9) & 1) << 5); R = (st >> 1) * 16 + swz / 64; C = (st & 1) * 32 + (swz % 64) / 2; }
__host__ __device__ __forceinline__ int perm32(int rho) { const int n = rho >> 4, i = rho & 15; return 8 * (i >> 2) + 4 * n + (i & 3); }

struct Unit { int pm, pn; };
struct Gemm { const bf16_t* A; const bf16_t* Bt; int M, N, K, lda, ldb; };

struct StaticOrder {
    int nM, nN, nwg, G, c;
    __device__ void init(int M, int N, int G_, int c_) { nM = M / BM; nN = N / BM; nwg = nM * nN; G = G_; c = c_; }
    __device__ bool next(int i, Unit& u) const {
        const long L = (long)i * G + c; if (L >= nwg) return false;
        int wgid = (int)L; { const int q = nwg / NXCD, r = nwg % NXCD, xcd = wgid % NXCD, off = wgid / NXCD; wgid = (xcd < r ? xcd * (q + 1) : r * (q + 1) + (xcd - r) * q) + off; }
        const int nig = WGM * nN, gid = wgid / nig, fm = gid * WGM, gsz = (nM - fm) < WGM ? (nM - fm) : WGM;
        u.pm = fm + ((wgid % nig) % gsz); u.pn = (wgid % nig) / gsz; return true;
    }
    __device__ __forceinline__ void a_ready(const Unit&) const {}
    __device__ __forceinline__ void done(const Unit&) const {}
};
struct ProjOrder {
    StaticOrder S; int G, c;
    __device__ void init(int G_, int c_) { S.init(NTOK, PCOLS, G_, c_); G = G_; c = c_; }
    __device__ bool next(int i, Unit& u) const {
        const long L = (long)i * G + c;
        if (L < S.nwg) return S.next(i, u);
        const int j = (int)(L - S.nwg); if (j >= 8) return false;
        u.pm = 64 + (j >> 1); u.pn = 2 + (j & 1); return true;
    }
    __device__ __forceinline__ void a_ready(const Unit&) const {}
    __device__ __forceinline__ void done(const Unit&) const {}
};

__device__ __forceinline__ unsigned cvt_pk_bf16(float lo, float hi) { unsigned r; asm volatile("v_cvt_pk_bf16_f32 %0, %1, %2" : "=v"(r) : "v"(lo), "v"(hi)); return r; }
__device__ __forceinline__ f32x2 gelu_pk(f32x2 v) {
    const f32x2 av = __builtin_elementwise_abs(v), d = av * 0.2316418882f + 1.0f;
    f32x2 t; t.x = __builtin_amdgcn_rcpf(d.x); t.y = __builtin_amdgcn_rcpf(d.y);
    f32x2 q = t * 0.5307027145f + (-0.7265760135f); q = q * t + 0.7107068705f; q = q * t + (-0.142248368f); q = q * t + 0.127414796f; q = q * t;
    const f32x2 s = (v * v) * (-0.72134752044f);
    f32x2 e; e.x = __builtin_amdgcn_exp2f(s.x); e.y = __builtin_amdgcn_exp2f(s.y);
    const f32x2 m = v * (q * e), r = v - m;
    f32x2 o; o.x = v.x < 0.f ? m.x : r.x; o.y = v.y < 0.f ? m.y : r.y; return o;
}
__device__ __forceinline__ float sigm(float x) { return __builtin_amdgcn_rcpf(1.0f + __builtin_amdgcn_exp2f(-1.4426950408889634f * x)); }

struct EpiProj {
    static constexpr bool PERM = true, AFTER_DRAIN = false, MID = false;
    bf16_t* O; int ldc;
    __device__ __forceinline__ void operator()(const f32x4 (&acc)[2][2][4][2], const Unit& u, int wr, int wc, int fr, int fq) const {
        const int row0 = u.pm * BM + wr * 64 + fr, col0 = u.pn * BM + wc * 32 + 8 * fq;
        const int act = (u.pn < 4) ? 0 : (u.pn < 12 ? 1 : 2);
#pragma unroll
        for (int ai = 0; ai < 2; ++ai)
#pragma unroll
            for (int m = 0; m < 4; ++m) { bf16_t* rowp = O + (size_t)(row0 + ai * HALF + m * 16) * ldc + col0;
#pragma unroll
                for (int bj = 0; bj < 2; ++bj) { f32x4 v0 = acc[ai][bj][m][0], v1 = acc[ai][bj][m][1];
                    if (act == 1) { f32x2 a = gelu_pk((f32x2){v0[0], v0[1]}), b = gelu_pk((f32x2){v0[2], v0[3]}), c = gelu_pk((f32x2){v1[0], v1[1]}), d = gelu_pk((f32x2){v1[2], v1[3]});
                        v0 = (f32x4){a.x, a.y, b.x, b.y}; v1 = (f32x4){c.x, c.y, d.x, d.y}; }
                    else if (act == 2) {
#pragma unroll
                        for (int j = 0; j < 4; ++j) { v0[j] = sigm(v0[j]); v1[j] = sigm(v1[j]); } }
                    u32x4 w; w.x = cvt_pk_bf16(v0[0], v0[1]); w.y = cvt_pk_bf16(v0[2], v0[3]); w.z = cvt_pk_bf16(v1[0], v1[1]); w.w = cvt_pk_bf16(v1[2], v1[3]);
                    *(u32x4*)(rowp + bj * HALF) = w; } }
    }
};
struct EpiBf16 {
    static constexpr bool PERM = true, AFTER_DRAIN = false, MID = false;
    bf16_t* O; int ldc;
    __device__ __forceinline__ void operator()(const f32x4 (&acc)[2][2][4][2], const Unit& u, int wr, int wc, int fr, int fq) const {
        const int row0 = u.pm * BM + wr * 64 + fr, col0 = u.pn * BM + wc * 32 + 8 * fq;
#pragma unroll
        for (int ai = 0; ai < 2; ++ai)
#pragma unroll
            for (int m = 0; m < 4; ++m) { bf16_t* rowp = O + (size_t)(row0 + ai * HALF + m * 16) * ldc + col0;
#pragma unroll
                for (int bj = 0; bj < 2; ++bj) { const f32x4 v0 = acc[ai][bj][m][0], v1 = acc[ai][bj][m][1];
                    u32x4 w; w.x = cvt_pk_bf16(v0[0], v0[1]); w.y = cvt_pk_bf16(v0[2], v0[3]); w.z = cvt_pk_bf16(v1[0], v1[1]); w.w = cvt_pk_bf16(v1[2], v1[3]);
                    *(u32x4*)(rowp + bj * HALF) = w; } }
    }
};
struct EpiMerge {
    static constexpr bool PERM = true, AFTER_DRAIN = false, MID = true;
    const bf16_t* GA; const bf16_t* GS; int ldg; bf16_t* O;
    __device__ __forceinline__ void mid(f32x4 (&acc)[2][2][4][2], const Unit& u, int wr, int wc, int fr, int fq) const {
        int row0 = u.pm * BM + wr * 64 + fr, col0 = u.pn * BM + wc * 32 + 8 * fq;
        asm volatile("" : "+v"(row0), "+v"(col0));
#pragma unroll
        for (int ai = 0; ai < 2; ++ai)
#pragma unroll
            for (int m = 0; m < 4; ++m) { const size_t r = (size_t)(row0 + ai * HALF + m * 16);
#pragma unroll
                for (int bj = 0; bj < 2; ++bj) { const int c = col0 + bj * HALF;
                    const u32x4 ga = *(const u32x4*)(GA + r * ldg + c), gs = *(const u32x4*)(GS + r * ldg + c);
                    f32x4 r0, r1;
                    r0[0] = bflo(ga.x) * __builtin_amdgcn_rcpf(fmaxf(bflo(gs.x), 1e-30f)); r0[1] = bfhi(ga.x) * __builtin_amdgcn_rcpf(fmaxf(bfhi(gs.x), 1e-30f));
                    r0[2] = bflo(ga.y) * __builtin_amdgcn_rcpf(fmaxf(bflo(gs.y), 1e-30f)); r0[3] = bfhi(ga.y) * __builtin_amdgcn_rcpf(fmaxf(bfhi(gs.y), 1e-30f));
                    r1[0] = bflo(ga.z) * __builtin_amdgcn_rcpf(fmaxf(bflo(gs.z), 1e-30f)); r1[1] = bfhi(ga.z) * __builtin_amdgcn_rcpf(fmaxf(bfhi(gs.z), 1e-30f));
                    r1[2] = bflo(ga.w) * __builtin_amdgcn_rcpf(fmaxf(bflo(gs.w), 1e-30f)); r1[3] = bfhi(ga.w) * __builtin_amdgcn_rcpf(fmaxf(bfhi(gs.w), 1e-30f));
                    acc[ai][bj][m][0] = acc[ai][bj][m][0] * r0; acc[ai][bj][m][1] = acc[ai][bj][m][1] * r1; }
                asm volatile("" ::: "memory"); }
    }
    __device__ __forceinline__ void operator()(const f32x4 (&acc)[2][2][4][2], const Unit& u, int wr, int wc, int fr, int fq) const {
        int row0 = u.pm * BM + wr * 64 + fr, col0 = u.pn * BM + wc * 32 + 8 * fq;
        asm volatile("" : "+v"(row0), "+v"(col0));
#pragma unroll
        for (int ai = 0; ai < 2; ++ai)
#pragma unroll
            for (int m = 0; m < 4; ++m) { const size_t r = (size_t)(row0 + ai * HALF + m * 16);
#pragma unroll
                for (int bj = 0; bj < 2; ++bj) { const int c = col0 + bj * HALF;
                    const u32x4 g = *(const u32x4*)(GS + r * ldg + c);
                    const f32x4 a0 = acc[ai][bj][m][0], a1 = acc[ai][bj][m][1];
                    u32x4 w; w.x = cvt_pk_bf16(a0[0] * bflo(g.x), a0[1] * bfhi(g.x)); w.y = cvt_pk_bf16(a0[2] * bflo(g.y), a0[3] * bfhi(g.y));
                    w.z = cvt_pk_bf16(a1[0] * bflo(g.z), a1[1] * bfhi(g.z)); w.w = cvt_pk_bf16(a1[2] * bflo(g.w), a1[3] * bfhi(g.w));
                    *(u32x4*)(O + r * DM + c) = w; } }
    }
};
struct EpiRes {
    static constexpr bool PERM = false, AFTER_DRAIN = false, MID = false;
    const float* base; float* out; const float* gate;
    __device__ __forceinline__ void operator()(const f32x4 (&acc)[2][2][4][2], const Unit& u, int wr, int wc, int fr, int fq) const {
        const int row0 = u.pm * BM + wr * 64 + fr, col0 = u.pn * BM + wc * 32 + 4 * fq;
        const float* gp = gate + (size_t)(u.pm >> 4) * NMOD + col0;
        f32x4 gv[2][2];
#pragma unroll
        for (int bj = 0; bj < 2; ++bj)
#pragma unroll
            for (int n = 0; n < 2; ++n) gv[bj][n] = *(const f32x4*)(gp + bj * HALF + n * 16);
#pragma unroll
        for (int ai = 0; ai < 2; ++ai)
#pragma unroll
            for (int m = 0; m < 4; ++m) { const size_t off = (size_t)(row0 + ai * HALF + m * 16) * DM + col0;
#pragma unroll
                for (int bj = 0; bj < 2; ++bj)
#pragma unroll
                    for (int n = 0; n < 2; ++n) { const f32x4 b = *(const f32x4*)(base + off + bj * HALF + n * 16);
                        *(f32x4*)(out + off + bj * HALF + n * 16) = b + gv[bj][n] * acc[ai][bj][m][n]; } }
    }
};
struct EpiFfnIn {
    static constexpr bool PERM = true, AFTER_DRAIN = false, MID = false;
    bf16_t* O;
    __device__ __forceinline__ void operator()(const f32x4 (&acc)[2][2][4][2], const Unit& u, int wr, int wc, int fr, int fq) const {
        const int row0 = u.pm * BM + wr * 64 + fr, col0 = u.pn * HALF + wc * 32 + 8 * fq;
#pragma unroll
        for (int ai = 0; ai < 2; ++ai)
#pragma unroll
            for (int m = 0; m < 4; ++m) { bf16_t* rowp = O + (size_t)(row0 + ai * HALF + m * 16) * DFF + col0;
                float o[8];
#pragma unroll
                for (int n = 0; n < 2; ++n)
#pragma unroll
                    for (int j = 0; j < 4; ++j) { const float a = acc[ai][0][m][n][j], b = acc[ai][1][m][n][j]; o[n * 4 + j] = a * sigm(a) * b; }
                u32x4 w; w.x = cvt_pk_bf16(o[0], o[1]); w.y = cvt_pk_bf16(o[2], o[3]); w.z = cvt_pk_bf16(o[4], o[5]); w.w = cvt_pk_bf16(o[6], o[7]);
                *(u32x4*)rowp = w; }
    }
};

template <class Epi, class Sched, bool ALIGN_EPI = true, bool SP2 = true>
__device__ __forceinline__ void gemm_phase(PG8_LAS unsigned char* lds, const Gemm g, const Sched& S, const Epi& E) {
    const int tid = threadIdx.x, wid = __builtin_amdgcn_readfirstlane(tid >> 6), lane = tid & 63, wr = wid >> 2, wc = wid & 3, fr = lane & 15, fq = lane >> 4;
    const int K = g.K, nt = K / BK;
    unsigned voffA[2], voffB[2];
#pragma unroll
    for (int i = 0; i < 2; ++i) { int R, C; stage_rc(tid * 16 + i * 8192, R, C); const int Rb = Epi::PERM ? ((R & ~31) + perm32(R & 31)) : R;
        voffA[i] = (unsigned)(R * g.lda + C) * 2u; voffB[i] = (unsigned)(Rb * g.ldb + C) * 2u; }
    const size_t kstep = (size_t)(BK * 2);
    const size_t hstepA = (size_t)HALF * g.lda * 2, hstepB = (size_t)HALF * g.ldb * 2;
    const size_t tstepA = 2 * hstepA, tstepB = 2 * hstepB;
    const unsigned ldsw = (unsigned)wid * 1024u;
    const int aoff = lds_byte(wr * 64 + fr, fq * 8), boff = lds_byte(wc * 32 + fr, fq * 8);
#define PG8_SA(b, h) (((b) * 2 + (h)) * HTB)
#define PG8_SB(b, h) ((4 + (b) * 2 + (h)) * HTB)
#define PG8_STAGE(bufoff, gbase, voff) do { _Pragma("unroll") for (int _i = 0; _i < 2; ++_i) \
        __builtin_amdgcn_global_load_lds((const unsigned*)((const char*)(gbase) + (voff)[_i]), (PG8_LAS unsigned*)(lds + (bufoff) + ldsw + _i * 8192), 16, 0, 0); } while (0)
#define PG8_LDA(dst, b, h) do { _Pragma("unroll") for (int m = 0; m < 4; ++m) _Pragma("unroll") for (int k = 0; k < 2; ++k) dst[m][k] = *(const PG8_LAS bf16x8*)(lds + PG8_SA(b, h) + aoff + m * 2048 + k * 1024); } while (0)
#define PG8_LDB(dst, b, h) do { _Pragma("unroll") for (int n = 0; n < 2; ++n) _Pragma("unroll") for (int k = 0; k < 2; ++k) dst[n][k] = *(const PG8_LAS bf16x8*)(lds + PG8_SB(b, h) + boff + n * 2048 + k * 1024); } while (0)
#define PG8_MMA(ai, bj, At, Bt) do { __builtin_amdgcn_s_setprio(1); _Pragma("unroll") for (int m = 0; m < 4; ++m) _Pragma("unroll") for (int n = 0; n < 2; ++n) _Pragma("unroll") for (int k = 0; k < 2; ++k) \
        acc[ai][bj][m][n] = __builtin_amdgcn_mfma_f32_16x16x32_bf16(Bt[n][k], At[m][k], acc[ai][bj][m][n], 0, 0, 0); __builtin_amdgcn_s_setprio(0); } while (0)
#define PG8_WAIT_V(n) asm volatile("s_waitcnt vmcnt(" #n ")" ::: "memory")
#define PG8_WAIT_L(n) asm volatile("s_waitcnt lgkmcnt(" #n ")" ::: "memory")
#define PG8_BAR __builtin_amdgcn_s_barrier()
#define PG8_SCHED __builtin_amdgcn_sched_barrier(0)
    Unit cur, nxt; int ui = 0;
    if (!S.next(0, cur)) return;
    f32x4 acc[2][2][4][2];
#pragma unroll
    for (int a = 0; a < 2; ++a)
#pragma unroll
        for (int b = 0; b < 2; ++b)
#pragma unroll
            for (int m = 0; m < 4; ++m)
#pragma unroll
                for (int n = 0; n < 2; ++n) acc[a][b][m][n] = (f32x4){0.f, 0.f, 0.f, 0.f};
    bf16x8 At[4][2], B0[2][2], B1[2][2];
    const char* cA = (const char*)g.A + (size_t)cur.pm * tstepA; const char* cB = (const char*)g.Bt + (size_t)cur.pn * tstepB;
    S.a_ready(cur);
    if constexpr (SP2) {
        PG8_STAGE(PG8_SB(0, 0), cB, voffB); PG8_STAGE(PG8_SB(0, 1), cB + hstepB, voffB); PG8_STAGE(PG8_SA(0, 0), cA, voffA); PG8_STAGE(PG8_SA(0, 1), cA + hstepA, voffA);
        if (wr == 1) PG8_BAR;
        PG8_WAIT_V(2); PG8_BAR;
        PG8_STAGE(PG8_SB(1, 0), cB + kstep, voffB); PG8_STAGE(PG8_SA(1, 0), cA + kstep, voffA); PG8_STAGE(PG8_SB(1, 1), cB + hstepB + kstep, voffB);
        PG8_WAIT_V(6); PG8_BAR;
    } else {
        PG8_STAGE(PG8_SB(0, 0), cB, voffB); PG8_STAGE(PG8_SA(0, 0), cA, voffA); PG8_STAGE(PG8_SB(0, 1), cB + hstepB, voffB); PG8_STAGE(PG8_SA(0, 1), cA + hstepA, voffA);
        if (wr == 1) PG8_BAR;
        PG8_WAIT_V(4); PG8_BAR;
        PG8_STAGE(PG8_SB(1, 0), cB + kstep, voffB); PG8_STAGE(PG8_SA(1, 0), cA + kstep, voffA); PG8_STAGE(PG8_SB(1, 1), cB + hstepB + kstep, voffB);
        PG8_WAIT_V(6); PG8_BAR;
    }
    for (;;) {
        const bool has_next = S.next(ui + 1, nxt);
        const char* nA = has_next ? (const char*)g.A + (size_t)nxt.pm * tstepA : cA; const char* nB = has_next ? (const char*)g.Bt + (size_t)nxt.pn * tstepB : cB;
        for (int t = 0; t < nt; t += 2) {
            const bool last = (t == nt - 2);
            const char* a1 = cA + (size_t)(t + 1) * kstep;
            const char* a2 = last ? nA : cA + (size_t)(t + 2) * kstep; const char* b2 = last ? nB : cB + (size_t)(t + 2) * kstep;
            const char* a3 = a2 + kstep; const char* b3 = b2 + kstep;
            if constexpr (Epi::MID) { if (t == nt / 2) { PG8_SCHED; E.mid(acc, cur, wr, wc, fr, fq); PG8_SCHED; } }
            if (last && has_next) S.a_ready(nxt);
            if constexpr (SP2) {
            PG8_LDB(B0, 0, 0); PG8_LDB(B1, 0, 1); PG8_SCHED; PG8_LDA(At, 0, 0); PG8_STAGE(PG8_SA(1, 1), a1 + hstepA, voffA);
            PG8_WAIT_V(8); PG8_WAIT_L(0); PG8_BAR; PG8_MMA(0, 0, At, B0); PG8_MMA(0, 1, At, B1); PG8_BAR; PG8_SCHED;
            PG8_LDA(At, 0, 1); PG8_STAGE(PG8_SB(0, 0), b2, voffB); PG8_STAGE(PG8_SB(0, 1), b2 + hstepB, voffB); PG8_STAGE(PG8_SA(0, 0), a2, voffA);
            PG8_WAIT_V(8); PG8_WAIT_L(0); PG8_BAR; PG8_MMA(1, 0, At, B0); PG8_MMA(1, 1, At, B1); PG8_BAR; PG8_SCHED;
            PG8_LDB(B0, 1, 0); PG8_LDB(B1, 1, 1); PG8_SCHED; PG8_LDA(At, 1, 0); PG8_STAGE(PG8_SA(0, 1), a2 + hstepA, voffA);
            PG8_WAIT_V(8); PG8_WAIT_L(0); PG8_BAR; PG8_MMA(0, 0, At, B0); PG8_MMA(0, 1, At, B1); PG8_BAR; PG8_SCHED;
            PG8_LDA(At, 1, 1); PG8_STAGE(PG8_SB(1, 0), b3, voffB); PG8_STAGE(PG8_SB(1, 1), b3 + hstepB, voffB); PG8_STAGE(PG8_SA(1, 0), a3, voffA);
            PG8_WAIT_V(8); PG8_WAIT_L(0); PG8_BAR; PG8_MMA(1, 0, At, B0); PG8_MMA(1, 1, At, B1); PG8_BAR; PG8_SCHED;
            } else {
            PG8_LDB(B0, 0, 0); PG8_SCHED; PG8_LDA(At, 0, 0); PG8_STAGE(PG8_SA(1, 1), a1 + hstepA, voffA);
            PG8_WAIT_L(8); PG8_BAR; PG8_WAIT_L(0); PG8_MMA(0, 0, At, B0); PG8_BAR; PG8_SCHED;
            PG8_LDB(B1, 0, 1); PG8_STAGE(PG8_SB(0, 0), b2, voffB);
            PG8_BAR; PG8_WAIT_L(0); PG8_MMA(0, 1, At, B1); PG8_BAR;
            PG8_LDA(At, 0, 1); PG8_STAGE(PG8_SA(0, 0), a2, voffA);
            PG8_BAR; PG8_WAIT_L(0); PG8_MMA(1, 0, At, B0); PG8_BAR; PG8_SCHED;
            PG8_STAGE(PG8_SB(0, 1), b2 + hstepB, voffB);
            PG8_WAIT_V(6); PG8_BAR; PG8_MMA(1, 1, At, B1); PG8_BAR;
            PG8_LDB(B0, 1, 0); PG8_SCHED; PG8_LDA(At, 1, 0); PG8_STAGE(PG8_SA(0, 1), a2 + hstepA, voffA);
            PG8_WAIT_L(8); PG8_BAR; PG8_WAIT_L(0); PG8_MMA(0, 0, At, B0); PG8_BAR; PG8_SCHED;
            PG8_LDB(B1, 1, 1); PG8_STAGE(PG8_SB(1, 0), b3, voffB);
            PG8_BAR; PG8_WAIT_L(0); PG8_MMA(0, 1, At, B1); PG8_BAR;
            PG8_LDA(At, 1, 1); PG8_STAGE(PG8_SA(1, 0), a3, voffA);
            PG8_BAR; PG8_WAIT_L(0); PG8_MMA(1, 0, At, B0); PG8_BAR; PG8_SCHED;
            PG8_STAGE(PG8_SB(1, 1), b3 + hstepB, voffB);
            PG8_WAIT_V(6); PG8_BAR; PG8_MMA(1, 1, At, B1); PG8_BAR;
            }
        }
        if constexpr (ALIGN_EPI) { if (wr == 0) PG8_BAR; }
        if constexpr (!Epi::AFTER_DRAIN) { E(acc, cur, wr, wc, fr, fq); S.done(cur); }
        if (!has_next) break;
#pragma unroll
        for (int a = 0; a < 2; ++a)
#pragma unroll
            for (int b = 0; b < 2; ++b)
#pragma unroll
                for (int m = 0; m < 4; ++m)
#pragma unroll
                    for (int n = 0; n < 2; ++n) acc[a][b][m][n] = (f32x4){0.f, 0.f, 0.f, 0.f};
        cur = nxt; cA = nA; cB = nB; ++ui;
        if constexpr (ALIGN_EPI) { if (wr == 1) PG8_BAR; }
    }
    PG8_WAIT_V(0);
    if constexpr (!ALIGN_EPI) { if (wr == 0) PG8_BAR; }
    PG8_BAR;
#undef PG8_SA
#undef PG8_SB
#undef PG8_STAGE
#undef PG8_LDA
#undef PG8_LDB
#undef PG8_MMA
#undef PG8_WAIT_V
#undef PG8_WAIT_L
#undef PG8_BAR
#undef PG8_SCHED
}
}

namespace att {
constexpr int NW = 8, QBLK = 32, KVBLK = 64;
constexpr float SCALE = 0.07216878364870323f;
constexpr float THR = 8.f;
constexpr size_t SHM_V = KVBLK * VD * 2, SHM_K = KVBLK * QKD * 2;
constexpr size_t SHM_ATTN = 2 * SHM_V + 2 * SHM_K + NW * 64 * 4;
#define KSWZ(row, colB) ((row) * 384 + ((colB) ^ (((row) & 7) << 4)))
#define SBAR() __builtin_amdgcn_sched_barrier(0)
__device__ __forceinline__ int crow(int r, int hi) { return (r & 3) + 8 * (r >> 2) + 4 * hi; }
__device__ __forceinline__ unsigned cvtpk(float lo, float hi) { unsigned r; asm volatile("v_cvt_pk_bf16_f32 %0, %1, %2" : "=v"(r) : "v"(lo), "v"(hi)); return r; }

__device__ __forceinline__ void partialSM(f32x16& p0, f32x16& p1, float& m_reg, float& mn, float& alpha) {
  constexpr float C = SCALE * 1.4426950408889634f;
  float pmax = p0[0];
#pragma unroll
  for (int r = 1; r < 16; ++r) pmax = fmaxf(pmax, p0[r]);
#pragma unroll
  for (int r = 0; r < 16; ++r) pmax = fmaxf(pmax, p1[r]);
  { auto rr = __builtin_amdgcn_permlane32_swap(__float_as_uint(pmax), __float_as_uint(pmax), false, false);
    pmax = fmaxf(__uint_as_float(rr[0]), __uint_as_float(rr[1])); }
  if (__builtin_expect(__all(pmax - m_reg <= THR / SCALE), 1)) { mn = m_reg; alpha = 1.f; }
  else { mn = fmaxf(m_reg, pmax); alpha = __builtin_amdgcn_exp2f((m_reg - mn) * C); m_reg = mn; }
  float mnC = -mn * C;
#pragma unroll
  for (int r = 0; r < 16; ++r) p0[r] = fmaf(p0[r], C, mnC);
#pragma unroll
  for (int r = 0; r < 16; ++r) p1[r] = fmaf(p1[r], C, mnC);
#pragma unroll
  for (int r = 0; r < 16; ++r) p0[r] = __builtin_amdgcn_exp2f(p0[r]);
}
__device__ __forceinline__ void finishSM(f32x16& p0, f32x16& p1, float alpha, float& l_reg, bf16x8& pa0, bf16x8& pa1, bf16x8& pa2, bf16x8& pa3) {
#pragma unroll
  for (int r = 0; r < 16; ++r) p1[r] = __builtin_amdgcn_exp2f(p1[r]);
  float ps = 0;
#pragma unroll
  for (int r = 0; r < 16; ++r) ps += p0[r];
#pragma unroll
  for (int r = 0; r < 16; ++r) ps += p1[r];
  { auto rr = __builtin_amdgcn_permlane32_swap(__float_as_uint(ps), __float_as_uint(ps), false, false);
    ps = __uint_as_float(rr[0]) + __uint_as_float(rr[1]); }
  l_reg = l_reg * alpha + ps;
#define PK4(P, BASE, OUT) do { unsigned a0 = cvtpk(P[BASE + 0], P[BASE + 1]), a1 = cvtpk(P[BASE + 2], P[BASE + 3]);   \
    unsigned b0 = cvtpk(P[BASE + 4], P[BASE + 5]), b1 = cvtpk(P[BASE + 6], P[BASE + 7]);                              \
    auto r0 = __builtin_amdgcn_permlane32_swap(a0, b0, false, false); auto r1 = __builtin_amdgcn_permlane32_swap(a1, b1, false, false); \
    u32x4 w = {r0[0], r1[0], r0[1], r1[1]}; OUT = *reinterpret_cast<bf16x8*>(&w); } while (0)
  PK4(p0, 0, pa0); PK4(p0, 8, pa1); PK4(p1, 0, pa2); PK4(p1, 8, pa3);
#undef PK4
}
__device__ __forceinline__ void qkt(f32x16& p0, f32x16& p1, const char* Ks, const bf16x8* qr, int r32, int hi) {
  p0 = f32x16{}; p1 = f32x16{};
  int rsw = ((r32 >> 1) & 7) << 4; asm volatile("" : "+v"(rsw));
  const char* Kr = Ks + r32 * 384;
#pragma unroll
  for (int d0 = 0; d0 < 12; ++d0) { int cb = (d0 * 16 + hi * 8) * 2;
    bf16x8 b0 = *reinterpret_cast<const bf16x8*>(Kr + (cb ^ rsw));
    bf16x8 b1 = *reinterpret_cast<const bf16x8*>(Kr + 32 * 384 + (cb ^ rsw));
    p0 = __builtin_amdgcn_mfma_f32_32x32x16_bf16(b0, qr[d0], p0, 0, 0, 0);
    p1 = __builtin_amdgcn_mfma_f32_32x32x16_bf16(b1, qr[d0], p1, 0, 0, 0); }
}
#define QKF_PK4(P, BASE, OUT) do { unsigned a0_ = cvtpk(P[BASE + 0], P[BASE + 1]), a1_ = cvtpk(P[BASE + 2], P[BASE + 3]);   \
    unsigned b0_ = cvtpk(P[BASE + 4], P[BASE + 5]), b1_ = cvtpk(P[BASE + 6], P[BASE + 7]);                              \
    auto r0_ = __builtin_amdgcn_permlane32_swap(a0_, b0_, false, false); auto r1_ = __builtin_amdgcn_permlane32_swap(a1_, b1_, false, false); \
    u32x4 w_ = {r0_[0], r1_[0], r0_[1], r1_[1]}; OUT = *reinterpret_cast<bf16x8*>(&w_); } while (0)
__device__ __forceinline__ void qk_fsm(f32x16& x0, f32x16& x1, const char* Ks, const bf16x8* qr, int r32, int hi,
                                       f32x16& y0, f32x16& y1, float alpha, float& l_reg, bf16x8& pa0, bf16x8& pa1, bf16x8& pa2, bf16x8& pa3) {
  x0 = f32x16{}; x1 = f32x16{};
  int rsw = ((r32 >> 1) & 7) << 4; asm volatile("" : "+v"(rsw));
  const char* Kr = Ks + r32 * 384;
#define QKF_RD(D0, B0, B1) do { const int cb_ = ((D0) * 16 + hi * 8) * 2; B0 = *reinterpret_cast<const bf16x8*>(Kr + (cb_ ^ rsw)); B1 = *reinterpret_cast<const bf16x8*>(Kr + 32 * 384 + (cb_ ^ rsw)); } while (0)
#define QKF_MM(D0, B0, B1) do { x0 = __builtin_amdgcn_mfma_f32_32x32x16_bf16(B0, qr[D0], x0, 0, 0, 0); x1 = __builtin_amdgcn_mfma_f32_32x32x16_bf16(B1, qr[D0], x1, 0, 0, 0); } while (0)
#define QKF_EXP(K) do { y1[2 * (K)] = __builtin_amdgcn_exp2f(y1[2 * (K)]); y1[2 * (K) + 1] = __builtin_amdgcn_exp2f(y1[2 * (K) + 1]); ps += y0[2 * (K)] + y0[2 * (K) + 1]; \
    if ((K) >= 1) ps += y1[2 * (K) - 2] + y1[2 * (K) - 1]; } while (0)
  bf16x8 a0, a1, b0, b1; float ps = 0.f;
  QKF_RD(0, a0, a1);
  QKF_RD(1, b0, b1);  QKF_MM(0, a0, a1);  QKF_EXP(0); SBAR();
  QKF_RD(2, a0, a1);  QKF_MM(1, b0, b1);  QKF_EXP(1); SBAR();
  QKF_RD(3, b0, b1);  QKF_MM(2, a0, a1);  QKF_EXP(2); SBAR();
  QKF_RD(4, a0, a1);  QKF_MM(3, b0, b1);  QKF_EXP(3); SBAR();
  QKF_RD(5, b0, b1);  QKF_MM(4, a0, a1);  QKF_EXP(4); SBAR();
  QKF_RD(6, a0, a1);  QKF_MM(5, b0, b1);  QKF_EXP(5); SBAR();
  QKF_RD(7, b0, b1);  QKF_MM(6, a0, a1);  QKF_EXP(6); SBAR();
  QKF_RD(8, a0, a1);  QKF_MM(7, b0, b1);  QKF_EXP(7); SBAR();
  QKF_RD(9, b0, b1);  QKF_MM(8, a0, a1);
  ps += y1[14] + y1[15];
  { auto rr = __builtin_amdgcn_permlane32_swap(__float_as_uint(ps), __float_as_uint(ps), false, false); ps = __uint_as_float(rr[0]) + __uint_as_float(rr[1]); }
  l_reg = l_reg * alpha + ps; QKF_PK4(y0, 0, pa0); SBAR();
  QKF_RD(10, a0, a1); QKF_MM(9, b0, b1);  QKF_PK4(y0, 8, pa1); SBAR();
  QKF_RD(11, b0, b1); QKF_MM(10, a0, a1); QKF_PK4(y1, 0, pa2); SBAR();
  QKF_MM(11, b0, b1); QKF_PK4(y1, 8, pa3);
#undef QKF_RD
#undef QKF_MM
#undef QKF_EXP
}
#undef QKF_PK4
__device__ __forceinline__ int v_st(int k, int c) { const int kk = (k & ~0xC) | ((k & 4) << 1) | ((k & 8) >> 1); return ((kk >> 3) * 4 + (c >> 5)) * 512 + ((kk & 7) * 32 + (c & 31)) * 2; }
__device__ __forceinline__ int v_rd_base(int lane) { return ((lane & 3) << 3) | (((lane >> 2) & 3) << 6) | (((lane >> 4) & 1) << 5) | (((lane >> 5) & 1) << 8); }
constexpr int v_rd_off(int d0, int ks, int half) { return d0 * 512 + ks * 4096 + half * 2048; }
template <int OFF> __device__ __forceinline__ s16x4 tr_read(int vb) {
  s16x4 r; asm volatile("ds_read_b64_tr_b16 %0, %1 offset:%2" : "=&v"(r) : "v"(vb), "i"(OFF) : "memory"); return r;
}
template <int KS> __device__ __forceinline__ void pv_step(f32x16* o, int vb, bf16x8 pa) {
  const s16x4 l0 = tr_read<v_rd_off(0, KS, 0)>(vb), h0 = tr_read<v_rd_off(0, KS, 1)>(vb), l1 = tr_read<v_rd_off(1, KS, 0)>(vb), h1 = tr_read<v_rd_off(1, KS, 1)>(vb);
  const s16x4 l2 = tr_read<v_rd_off(2, KS, 0)>(vb), h2 = tr_read<v_rd_off(2, KS, 1)>(vb), l3 = tr_read<v_rd_off(3, KS, 0)>(vb), h3 = tr_read<v_rd_off(3, KS, 1)>(vb);
  asm volatile("s_waitcnt lgkmcnt(0)" ::: "memory"); SBAR();
#define PK(L, H) (bf16x8){L[0], L[1], L[2], L[3], H[0], H[1], H[2], H[3]}
  o[0] = __builtin_amdgcn_mfma_f32_32x32x16_bf16(pa, PK(l0, h0), o[0], 0, 0, 0);
  o[1] = __builtin_amdgcn_mfma_f32_32x32x16_bf16(pa, PK(l1, h1), o[1], 0, 0, 0);
  o[2] = __builtin_amdgcn_mfma_f32_32x32x16_bf16(pa, PK(l2, h2), o[2], 0, 0, 0);
  o[3] = __builtin_amdgcn_mfma_f32_32x32x16_bf16(pa, PK(l3, h3), o[3], 0, 0, 0);
#undef PK
}
__device__ __forceinline__ void pv_d0(f32x16* o, int vb, bf16x8 pa0, bf16x8 pa1, bf16x8 pa2, bf16x8 pa3) {
  pv_step<0>(o, vb, pa0); pv_step<1>(o, vb, pa1); pv_step<2>(o, vb, pa2); pv_step<3>(o, vb, pa3);
}
#define PVS_READS(KS) const s16x4 l0_##KS = tr_read<v_rd_off(0, KS, 0)>(vb), h0_##KS = tr_read<v_rd_off(0, KS, 1)>(vb), l1_##KS = tr_read<v_rd_off(1, KS, 0)>(vb), h1_##KS = tr_read<v_rd_off(1, KS, 1)>(vb), \
    l2_##KS = tr_read<v_rd_off(2, KS, 0)>(vb), h2_##KS = tr_read<v_rd_off(2, KS, 1)>(vb), l3_##KS = tr_read<v_rd_off(3, KS, 0)>(vb), h3_##KS = tr_read<v_rd_off(3, KS, 1)>(vb)
#define PVS_PK(L, H) (bf16x8){L[0], L[1], L[2], L[3], H[0], H[1], H[2], H[3]}
#define PVS_MMA(KS, PA) do { asm volatile("s_waitcnt lgkmcnt(0)" ::: "memory"); SBAR(); \
    o[0] = __builtin_amdgcn_mfma_f32_32x32x16_bf16(PA, PVS_PK(l0_##KS, h0_##KS), o[0], 0, 0, 0); o[1] = __builtin_amdgcn_mfma_f32_32x32x16_bf16(PA, PVS_PK(l1_##KS, h1_##KS), o[1], 0, 0, 0); \
    o[2] = __builtin_amdgcn_mfma_f32_32x32x16_bf16(PA, PVS_PK(l2_##KS, h2_##KS), o[2], 0, 0, 0); o[3] = __builtin_amdgcn_mfma_f32_32x32x16_bf16(PA, PVS_PK(l3_##KS, h3_##KS), o[3], 0, 0, 0); SBAR(); } while (0)
__device__ __forceinline__ void pv_psm(f32x16* o, int vb, bf16x8 pa0, bf16x8 pa1, bf16x8 pa2, bf16x8 pa3, f32x16& p0, f32x16& p1, float& m_reg, float& mn, float& alpha) {
  constexpr float C = SCALE * 1.4426950408889634f;
  PVS_READS(0);
  PVS_MMA(0, pa0);
  PVS_READS(1);
  float pmax = p0[0];
#pragma unroll
  for (int r = 1; r < 16; ++r) pmax = fmaxf(pmax, p0[r]);
#pragma unroll
  for (int r = 0; r < 16; ++r) pmax = fmaxf(pmax, p1[r]);
  PVS_MMA(1, pa1);
  PVS_READS(2);
  { auto rr = __builtin_amdgcn_permlane32_swap(__float_as_uint(pmax), __float_as_uint(pmax), false, false);
    pmax = fmaxf(__uint_as_float(rr[0]), __uint_as_float(rr[1])); }
  if (__builtin_expect(__all(pmax - m_reg <= THR / SCALE), 1)) { mn = m_reg; alpha = 1.f; }
  else { mn = fmaxf(m_reg, pmax); alpha = __builtin_amdgcn_exp2f((m_reg - mn) * C); m_reg = mn; }
  const float mnC = -mn * C;
  PVS_MMA(2, pa2);
  PVS_READS(3);
#pragma unroll
  for (int r = 0; r < 16; ++r) p0[r] = fmaf(p0[r], C, mnC);
#pragma unroll
  for (int r = 0; r < 16; ++r) p1[r] = fmaf(p1[r], C, mnC);
  PVS_MMA(3, pa3);
#pragma unroll
  for (int r = 0; r < 16; ++r) p0[r] = __builtin_amdgcn_exp2f(p0[r]);
}
#undef PVS_READS
#undef PVS_PK
#undef PVS_MMA

constexpr size_t OFFTAB = 3 * SHM_V + 3 * SHM_K + NW * 64 * 4;
__device__ __forceinline__ void attn_offsets_init(char* lds) {
  const int tid = threadIdx.x; u32x4 r;
  { const int p = tid, row = p / 24, ch = p - row * 24; r.x = (unsigned)(row * 384 + ((ch ^ ((row >> 1) & 7)) << 4)); }
  { const int p = 512 + tid, row = p / 24, ch = p - row * 24; r.y = (unsigned)(row * 384 + ((ch ^ ((row >> 1) & 7)) << 4)); }
  { const int p = 1024 + tid, row = p / 24, ch = p - row * 24; r.z = (unsigned)(row * 384 + ((ch ^ ((row >> 1) & 7)) << 4)); }
  { const int p = tid, st = p >> 5, wi = p & 31, kk = (st >> 2) * 8 + (wi >> 2), c = (st & 3) * 32 + (wi & 3) * 8;
    const int k = (kk & ~0xC) | ((kk & 4) << 1) | ((kk & 8) >> 1); r.w = (unsigned)(k * 256 + c * 2); }
  *(reinterpret_cast<u32x4*>(lds + OFFTAB) + tid) = r;
  __syncthreads();
}
constexpr size_t RING_V = 0, RING_K = 3 * SHM_V, RING_END = 3 * SHM_V + 3 * SHM_K;
__device__ __forceinline__ void attn_unit(const bf16_t* __restrict__ Qb, const bf16_t* __restrict__ Kh, const bf16_t* __restrict__ Vh, bf16_t* __restrict__ Ob, char* lds, LAS unsigned char* ldsl) {
  const int tid = threadIdx.x, wid = tid >> 6, lane = tid & 63, r32 = lane & 31, hi = lane >> 5;
  char* V_lds = lds + RING_V; char* K_lds = lds + RING_K;
  float* wsf = (float*)(lds + RING_END) + wid * 64; float* li_l = wsf; float* al_l = wsf + 32;
  float m_reg = -1e30f, l_reg = 0; f32x16 o[4] = {}; bf16x8 qr[12];
  const bf16_t* Qw = Qb + (long)(wid * QBLK + r32) * QKD + hi * 8;
#pragma unroll
  for (int d0 = 0; d0 < 12; ++d0) qr[d0] = *reinterpret_cast<const bf16x8*>(Qw + d0 * 16);
  const int widu = __builtin_amdgcn_readfirstlane(wid);
  const int vb0 = (int)(uintptr_t)V_lds + v_rd_base(lane);
  const u32x4* offrec = reinterpret_cast<const u32x4*>(lds + OFFTAB) + tid;
#define DMA_K(tile, buf) do { const char* kg_ = (const char*)Kh + (size_t)(tile) * (KVBLK * QKD * 2); const u32x4 vo_ = *offrec; \
    __builtin_amdgcn_global_load_lds((const unsigned*)(kg_ + vo_.x), (LAS unsigned*)(ldsl + RING_K + (buf) * SHM_K + 0 * 8192 + widu * 1024), 16, 0, 0); \
    __builtin_amdgcn_global_load_lds((const unsigned*)(kg_ + vo_.y), (LAS unsigned*)(ldsl + RING_K + (buf) * SHM_K + 1 * 8192 + widu * 1024), 16, 0, 0); \
    __builtin_amdgcn_global_load_lds((const unsigned*)(kg_ + vo_.z), (LAS unsigned*)(ldsl + RING_K + (buf) * SHM_K + 2 * 8192 + widu * 1024), 16, 0, 0); } while (0)
#define DMA_V(tile, buf) do { const char* vg_ = (const char*)Vh + (size_t)(tile) * (KVBLK * VD * 2); const unsigned vo_ = (*offrec).w; \
    __builtin_amdgcn_global_load_lds((const unsigned*)(vg_ + vo_), (LAS unsigned*)(ldsl + RING_V + (buf) * SHM_V + 0 * 8192 + widu * 1024), 16, 0, 0); \
    __builtin_amdgcn_global_load_lds((const unsigned*)(vg_ + vo_ + 8192u), (LAS unsigned*)(ldsl + RING_V + (buf) * SHM_V + 1 * 8192 + widu * 1024), 16, 0, 0); } while (0)
#define RESC(a) do { if (__any((a) < 1.f)) { if (hi == 0) al_l[r32] = (a); asm volatile("s_waitcnt lgkmcnt(0)" ::: "memory"); \
    _Pragma("unroll") for (int d = 0; d < 4; ++d) _Pragma("unroll") for (int r = 0; r < 16; ++r) o[d][r] *= al_l[crow(r, hi)]; } } while (0)
#define TILE_BAR() do { asm volatile("s_waitcnt vmcnt(0)" ::: "memory"); __syncthreads(); } while (0)
  f32x16 pA0, pA1, pB0, pB1; float mnA, mnB, alA, alB; bf16x8 pa0, pa1, pa2, pa3; constexpr int NT = SKV / KVBLK;
  DMA_K(0, 0); DMA_K(1, 1); DMA_V(0, 0);
  TILE_BAR();
  DMA_K(2, 2); DMA_V(1, 1);
  qkt(pA0, pA1, K_lds, qr, r32, hi); partialSM(pA0, pA1, m_reg, mnA, alA);
  int b1 = 1, b0 = 0;
  for (int j = 1; j + 1 < NT; j += 2) {
    TILE_BAR();
    { const int b2 = (b1 == 2) ? 0 : b1 + 1;
      if (j + 2 < NT) DMA_K(j + 2, b0);
      DMA_V(j + 1, b2);
      SBAR(); qk_fsm(pB0, pB1, K_lds + b1 * SHM_K, qr, r32, hi, pA0, pA1, alA, l_reg, pa0, pa1, pa2, pa3); SBAR();
      pv_psm(o, vb0 + b0 * (int)SHM_V, pa0, pa1, pa2, pa3, pB0, pB1, m_reg, mnB, alB);
      RESC(alB);
      b0 = b1; b1 = b2; }
    TILE_BAR();
    { const int b2 = (b1 == 2) ? 0 : b1 + 1;
      if (j + 3 < NT) DMA_K(j + 3, b0);
      if (j + 2 < NT) DMA_V(j + 2, b2);
      SBAR(); qk_fsm(pA0, pA1, K_lds + b1 * SHM_K, qr, r32, hi, pB0, pB1, alB, l_reg, pa0, pa1, pa2, pa3); SBAR();
      pv_psm(o, vb0 + b0 * (int)SHM_V, pa0, pa1, pa2, pa3, pA0, pA1, m_reg, mnA, alA);
      RESC(alA);
      b0 = b1; b1 = b2; }
  }
  TILE_BAR();
  SBAR(); qk_fsm(pB0, pB1, K_lds + b1 * SHM_K, qr, r32, hi, pA0, pA1, alA, l_reg, pa0, pa1, pa2, pa3); SBAR();
  pv_psm(o, vb0 + b0 * (int)SHM_V, pa0, pa1, pa2, pa3, pB0, pB1, m_reg, mnB, alB);
  RESC(alB);
  finishSM(pB0, pB1, alB, l_reg, pa0, pa1, pa2, pa3); SBAR();
  pv_d0(o, vb0 + b1 * (int)SHM_V, pa0, pa1, pa2, pa3);
  if (hi == 0) li_l[r32] = l_reg; asm volatile("s_waitcnt lgkmcnt(0)" ::: "memory");
  float rli[16];
#pragma unroll
  for (int r = 0; r < 16; ++r) rli[r] = __builtin_amdgcn_rcpf(li_l[crow(r, hi)]);
  bf16_t* Ow = Ob + (long)(wid * QBLK) * DM;
#pragma unroll
  for (int r = 0; r < 16; ++r) { int orow = crow(r, hi);
#pragma unroll
    for (int d0 = 0; d0 < 4; ++d0) Ow[(long)orow * DM + d0 * 32 + r32] = (bf16_t)f2bf(o[d0][r] * rli[r]); }
  __syncthreads();
#undef DMA_K
#undef DMA_V
#undef RESC
#undef TILE_BAR
}
}


#define XB_TMO      128
#define XB_XCNT(j)  (256  + 64 * (j))
#define XB_XSUB(j)  (1280 + 64 * (j))
#define XB_XGEN(j)  (2304 + 64 * (j))
#define XB_TOP      3328
#define XB_TOPGEN   3392
#define XCD_BAR_WORDS 3456
#define XB_SPIN_CAP (1u << 18)
__device__ __forceinline__ unsigned xb_ld(unsigned* p)              { return __hip_atomic_load(p, __ATOMIC_RELAXED, __HIP_MEMORY_SCOPE_AGENT); }
__device__ __forceinline__ unsigned xb_add(unsigned* p, unsigned v) { return __hip_atomic_fetch_add(p, v, __ATOMIC_RELAXED, __HIP_MEMORY_SCOPE_AGENT); }
__device__ __forceinline__ unsigned xb_xcc_id() { return (unsigned)__builtin_amdgcn_s_getreg((3 << 11) | 20) & 0xFu; }
#define XB_SPIN(cond, bar) do { unsigned _sp = 0; while (cond) { __builtin_amdgcn_s_sleep(1); \
    if ((++_sp & 255u) == 0u) { if (xb_ld(&(bar)[XB_TMO])) break; if (_sp > XB_SPIN_CAP) { atomicAdd(&(bar)[XB_TMO], 1u); break; } } } } while (0)
struct XcdBarrier { unsigned* bar; unsigned x; volatile LAS unsigned* st; };
__device__ __forceinline__ XcdBarrier xcd_barrier_post(unsigned* bar, volatile LAS unsigned* st) {
    XcdBarrier b; b.bar = bar; b.x = xb_xcc_id(); b.st = st;
    if (threadIdx.x == 0) (void)xb_add(&bar[XB_XCNT(b.x)], 1u);
    return b;
}
__device__ __forceinline__ void xcd_barrier_complete(unsigned* bar, unsigned x, unsigned& nloc, unsigned& nx) {
    const unsigned G = gridDim.x * gridDim.y * gridDim.z;
    unsigned sum, cnt, mine, sp = 0u;
    for (;;) {
        sum = 0u; cnt = 0u; mine = 0u;
#pragma unroll
        for (unsigned j = 0; j < 16; ++j) { const unsigned c = xb_ld(&bar[XB_XCNT(j)]); sum += c; cnt += (c > 0u) ? 1u : 0u; mine = (j == x) ? c : mine; }
        if (sum == G) break;
        __builtin_amdgcn_s_sleep(1);
        if ((++sp & 255u) == 0u) { if (xb_ld(&bar[XB_TMO])) break; if (sp > XB_SPIN_CAP) { atomicAdd(&bar[XB_TMO], 1u); break; } }
    }
    nloc = mine > 0u ? mine : 1u; nx = cnt > 0u ? cnt : 1u;
}
__device__ __forceinline__ void xcd_barrier(const XcdBarrier& b) {
    asm volatile("s_waitcnt vmcnt(0)" ::: "memory");
    __syncthreads();
    if (threadIdx.x == 0) {
        unsigned* bar = b.bar;
        __builtin_amdgcn_s_waitcnt(0);
        unsigned nloc = b.st[0], nx = b.st[1];
        if (nloc == 0u) { xcd_barrier_complete(bar, b.x, nloc, nx); b.st[0] = nloc; b.st[1] = nx; }
        const unsigned old = xb_add(&bar[XB_XSUB(b.x)], 1u);
        const unsigned gen = old / nloc;
        if (old + 1u == (gen + 1u) * nloc) {
            __builtin_amdgcn_fence(__ATOMIC_RELEASE, "agent");
            asm volatile("s_waitcnt vmcnt(0)" ::: "memory");
            const unsigned og = xb_add(&bar[XB_TOP], 1u);
            const unsigned tg = og / nx;
            if (og + 1u == (tg + 1u) * nx) xb_add(&bar[XB_TOPGEN], 1u);
            else XB_SPIN(xb_ld(&bar[XB_TOPGEN]) == tg, bar);
            __builtin_amdgcn_fence(__ATOMIC_ACQUIRE, "agent");
            xb_add(&bar[XB_XGEN(b.x)], 1u);
            asm volatile("s_waitcnt vmcnt(0)" ::: "memory");
        } else {
            XB_SPIN(xb_ld(&bar[XB_XGEN(b.x)]) == gen, bar);
            __builtin_amdgcn_fence(__ATOMIC_ACQUIRE, "agent");
            asm volatile("s_waitcnt vmcnt(0)" ::: "memory");
        }
    }
    __syncthreads();
}

struct Args { const float* in[24]; float* out; unsigned char* ws; int ph_lo, ph_hi; };

template <int MODE> __device__ __forceinline__ int src_col(int n) {
    if (MODE == 1) return n < 832 ? n : (n < 1024 ? -1 : n - 192);
    if (MODE == 2) { const int pn = n >> 8, j = n & 255; return j < 128 ? pn * 128 + j : DFF + pn * 128 + (j - 128); }
    if (MODE == 3) return n < 1024 ? (n >> 7) * 192 + (n & 127) : ((n - 1024) >> 6) * 192 + 128 + ((n - 1024) & 63);
    return n;
}
template <int MODE> __device__ __forceinline__ void tr_item(const float* __restrict__ W, int ldw, int k0, int n0, bf16_t* __restrict__ WT, int ldt, const float* __restrict__ gk, LAS float* scr, int lane) {
    const int sc = src_col<MODE>(n0 + (lane & 31) * 4);
    f32x4 vv[16];
#pragma unroll
    for (int i = 0; i < 16; ++i) { const int kk = 2 * i + (lane >> 5); vv[i] = (f32x4){0.f, 0.f, 0.f, 0.f};
        if (sc >= 0) { vv[i] = *(const f32x4*)(W + (size_t)(k0 + kk) * ldw + sc); } }
#pragma unroll
    for (int i = 0; i < 16; ++i) { const int kk = 2 * i + (lane >> 5); f32x4 v = vv[i]; if (gk) v = v * gk[k0 + kk];
        LAS float* d = scr + kk * 129 + (lane & 31) * 4; d[0] = v.x; d[1] = v.y; d[2] = v.z; d[3] = v.w; }
    LDS_WAIT();
    const int c = lane & 3;
#pragma unroll
    for (int j = 0; j < 8; ++j) { const int n = (lane >> 2) + 16 * j; const LAS float* sp = scr + (8 * c) * 129 + n;
        u32x4 o; o.x = pk2(sp[0 * 129], sp[1 * 129]); o.y = pk2(sp[2 * 129], sp[3 * 129]); o.z = pk2(sp[4 * 129], sp[5 * 129]); o.w = pk2(sp[6 * 129], sp[7 * 129]);
        *(u32x4*)(WT + (size_t)(n0 + n) * ldt + k0 + 8 * c) = o; }
    LDS_WAIT();
}

__global__ void __launch_bounds__(512, 2) fwd_kernel(Args args) {
    extern __shared__ __attribute__((aligned(16))) unsigned char lds[];
    const int tid = threadIdx.x, lane = tid & 63, wave = __builtin_amdgcn_readfirstlane(tid >> 6);
    const int G = gridDim.x, bx = blockIdx.x;
    const int vcu = (G % 8 == 0) ? (bx % 8) * (G / 8) + bx / 8 : bx;
    const int gw = vcu * 8 + wave, NGW = G * 8;
    unsigned char* ws = args.ws;
    const float* x = args.in[0]; const float* cvec = args.in[1]; const float* ctx = args.in[2]; const float* c_ctx = args.in[3];
    const float* w_mod = args.in[4]; const float* b_mod = args.in[5]; const float* norm1_g = args.in[6]; const float* w_in = args.in[7];
    const float* q_norm_g = args.in[8]; const float* kv_norm_g = args.in[9]; const float* w_uq = args.in[10]; const float* w_ukv = args.in[11];
    const float* qk_norm_q = args.in[12]; const float* qk_norm_k = args.in[13]; const float* sgu_norm_g = args.in[14]; const float* sgu_norm_b = args.in[15];
    const float* w_spatial = args.in[16]; const float* b_spatial = args.in[17]; const float* w_br_attn = args.in[18]; const float* w_br_sgu = args.in[19];
    const float* w_out = args.in[20]; const float* norm2_g = args.in[21]; const float* w_ffn_in = args.in[22]; const float* w_ffn_out = args.in[23];
    float* out = args.out;
    float* MOD = (float*)(ws + WS_MOD);
    bf16_t* WIN = (bf16_t*)(ws + WS_WIN); bf16_t* WUQ = (bf16_t*)(ws + WS_WUQ); bf16_t* WUKV = (bf16_t*)(ws + WS_WUKV);
    bf16_t* WBR = (bf16_t*)(ws + WS_WBRA); bf16_t* WOUT = (bf16_t*)(ws + WS_WOUT);
    bf16_t* WFI = (bf16_t*)(ws + WS_WFI); bf16_t* WFO = (bf16_t*)(ws + WS_WFO); bf16_t* WSP = (bf16_t*)(ws + WS_WSP);
    bf16_t* H = (bf16_t*)(ws + WS_H); bf16_t* KVUP = H; bf16_t* AO = H; bf16_t* H2 = H;
    bf16_t* P = (bf16_t*)(ws + WS_P); bf16_t* ACT = P;
    bf16_t* KF = (bf16_t*)(ws + WS_KF); bf16_t* VF = (bf16_t*)(ws + WS_VF); bf16_t* MERGED = (bf16_t*)(ws + WS_MERGED);
    bf16_t* QUP = (bf16_t*)out; bf16_t* QF = (bf16_t*)((unsigned char*)out + DO_QF);
    const int lo = args.ph_lo, hi = args.ph_hi;
#ifndef PH_MASK
#define PH_MASK 0x7ff
#endif
#define IN(k) ((((PH_MASK) >> (k)) & 1) && lo <= (k) && (k) < hi)
#ifndef PROBE_DUP
#define PROBE_DUP 0
#endif
#define REPS(k) ((((PROBE_DUP) >> (k)) & 1) ? 2 : 1)
#ifdef PROBE_SPIN
    unsigned long long pt0_ = 0;
#define PH_START(k) do { if ((k) == PROBE_SPIN) pt0_ = __builtin_amdgcn_s_memrealtime(); } while (0)
#define PH_END(k) do { if ((k) == PROBE_SPIN) { const unsigned long long t1_ = __builtin_amdgcn_s_memrealtime(), d_ = 4 * (t1_ - pt0_); while (__builtin_amdgcn_s_memrealtime() - t1_ < d_) __builtin_amdgcn_s_sleep(8); } } while (0)
#else
#define PH_START(k) do {} while (0)
#define PH_END(k) do {} while (0)
#endif
#if !MK_LAUNCH_PER_PHASE && !defined(PROBE_SPLIT) && !defined(MK_CG_SYNC)
    volatile LAS unsigned* barst = (volatile LAS unsigned*)((LAS unsigned char*)lds + LDS_BARST);
    if (tid < 2) barst[tid] = 0u;
    __syncthreads();
    const XcdBarrier gbar = xcd_barrier_post((unsigned*)(ws + WS_BAR), barst);
    if (args.ph_lo < 0) cg::this_grid().sync();
#define SEAM(k) do { PH_END(k); if (IN(k) && IN((k) + 1)) { xcd_barrier(gbar); } } while (0)
#else
#define SEAM(k) do { PH_END(k); if (IN(k) && IN((k) + 1)) { cg::this_grid().sync(); } } while (0)
#endif

    if (IN(0)) for (int rep_ = 0; rep_ < REPS(0); ++rep_) { if (rep_) cg::this_grid().sync(); PH_START(0);
        LAS float* sact = (LAS float*)lds;
        LAS float* red = (LAS float*)(lds + 40960);
        for (int i = tid; i < 5 * DM; i += 512) { const float v = (i < 4 * DM) ? cvec[i] : c_ctx[i - 4 * DM]; sact[i] = v / (1.0f + __expf(-v)); }
        __syncthreads();
        for (int cb = bx; cb < NMOD / 48; cb += G) {
            const int n0 = cb * 48, c4 = tid % 12, kg = tid / 12;
            if (kg < 42) {
                f32x4 a[5];
#pragma unroll
                for (int r = 0; r < 5; ++r) a[r] = (f32x4){0.f, 0.f, 0.f, 0.f};
                for (int k0 = kg; k0 < DM; k0 += 42 * 7) {
                    f32x4 w[7];
#pragma unroll
                    for (int u = 0; u < 7; ++u) { const int k = k0 + 42 * u; w[u] = (k < DM) ? *(const f32x4*)(w_mod + (size_t)k * NMOD + n0 + c4 * 4) : (f32x4){0.f, 0.f, 0.f, 0.f}; }
#pragma unroll
                    for (int u = 0; u < 7; ++u) { const int k = (k0 + 42 * u < DM) ? k0 + 42 * u : 0;
#pragma unroll
                        for (int r = 0; r < 5; ++r) a[r] += w[u] * sact[r * DM + k]; } }
#pragma unroll
                for (int r = 0; r < 5; ++r)
#pragma unroll
                    for (int j = 0; j < 4; ++j) red[(kg * 5 + r) * 48 + c4 * 4 + j] = a[r][j];
            }
            __syncthreads();
            if (tid < 240) { const int r = tid / 48, col = tid % 48; float s = 0.f;
                for (int k2 = 0; k2 < 42; ++k2) s += red[(k2 * 5 + r) * 48 + col];
                MOD[(size_t)r * NMOD + n0 + col] = s + b_mod[n0 + col]; }
            __syncthreads();
        }
        if (bx == 0) { float* TAB = (float*)(ws + WS_ROPE);
            for (int idx = tid; idx < 1024; idx += 512) { const int pos = idx >> 4, i = idx & 15; const float freq = exp2f(-(float)i * (13.287712379549449f / 16.0f));
                float rev = (float)pos * freq * 0.15915494309189535f; rev -= floorf(rev); TAB[pos * 32 + i] = __builtin_amdgcn_cosf(rev); TAB[pos * 32 + 16 + i] = __builtin_amdgcn_sinf(rev); } }
        LAS float* scr = (LAS float*)(lds + wave * 16512);
        constexpr int I_IN = 64 * 56, I_UQ = 16 * 12, I_UKV = 8 * 16;
        constexpr int NEARLY = I_IN + I_UQ + I_UKV;
        for (int it = gw; it < NEARLY; it += NGW) {
            int r = it;
            if (r < I_IN) { tr_item<1>(w_in, IN_COLS, (r / 56) * 32, (r % 56) * 128, WIN, DM, nullptr, scr, lane); continue; } r -= I_IN;
            if (r < I_UQ) { tr_item<3>(w_uq, NH * QKD, (r / 12) * 32, (r % 12) * 128, WUQ, QL, q_norm_g, scr, lane); continue; } r -= I_UQ;
            tr_item<0>(w_ukv, 2048, (r / 16) * 32, (r % 16) * 128, WUKV, KVL, kv_norm_g, scr, lane);
        }
        for (int i = (bx * 512 + tid); i < 8 * 128 * 128 / 2; i += G * 512) { const f32x2 v = *(const f32x2*)(w_spatial + 2 * (size_t)i); ((unsigned*)WSP)[i] = pk2(v.x, v.y); }
    }
    SEAM(0);

    if (IN(1)) for (int rep_ = 0; rep_ < REPS(1); ++rep_) { if (rep_) cg::this_grid().sync(); PH_START(1);
        for (int row = gw; row < MROWS; row += NGW) {
            const float* src = row < NTOK ? x + (size_t)row * DM : ctx + (size_t)(row - NTOK) * DM;
            const int b = row < NTOK ? row / SEQ : 4;
            const float* sh = MOD + (size_t)b * NMOD; const float* scp = sh + DM;
            f32x4 v[8]; float ss = 0.f;
#pragma unroll
            for (int j = 0; j < 8; ++j) { v[j] = __builtin_nontemporal_load((const f32x4*)(src + (lane + 64 * j) * 4)); ss += (v[j].x * v[j].x + v[j].y * v[j].y) + (v[j].z * v[j].z + v[j].w * v[j].w); }
            const float r = 1.0f / sqrtf(wave_sum(ss) * (1.0f / DM) + EPS);
#pragma unroll
            for (int j = 0; j < 8; ++j) { const int idx = (lane + 64 * j) * 4; const f32x4 g = *(const f32x4*)(norm1_g + idx), s1 = *(const f32x4*)(scp + idx), s0 = *(const f32x4*)(sh + idx);
                const f32x4 o = (v[j] * r * g) * (s1 + 1.0f) + s0;
                u32x2 w; w.x = pk2(o.x, o.y); w.y = pk2(o.z, o.w); *(u32x2*)(H + (size_t)row * DM + idx) = w; }
        }
    }
    SEAM(1);

    if (IN(2)) for (int rep_ = 0; rep_ < REPS(2); ++rep_) { if (rep_) cg::this_grid().sync(); PH_START(2);
        pg8::Gemm g{H, WIN, MROWS, PCOLS, DM, DM, DM}; pg8::ProjOrder S; S.init(G, bx);
        pg8::EpiProj E{P, PCOLS};
        pg8::gemm_phase<pg8::EpiProj, pg8::ProjOrder>((LAS unsigned char*)lds, g, S, E);
        { constexpr int NU = 64 * 28 + 8; const int nlead = NU % G;
          if (bx >= nlead) {
            LAS float* scr = (LAS float*)(lds + wave * 16512);
            constexpr int I_BR = 32 * 16, I_OUT = 64 * 16, I_FI = 64 * 88, I_FO = 176 * 16;
            constexpr int NLATE = 2 * I_BR + I_OUT + I_FI + I_FO;
            const int NW2 = (G - nlead) * 8;
            for (int it = (bx - nlead) * 8 + wave; it < NLATE; it += NW2) {
                int r = it;
                if (r < I_BR) { tr_item<0>(w_br_attn, DM, (r / 16) * 32, (r % 16) * 128, WBR, DM, nullptr, scr, lane); continue; } r -= I_BR;
                if (r < I_BR) { tr_item<0>(w_br_sgu, DM, (r / 16) * 32, (r % 16) * 128, WBR + 1024, DM, nullptr, scr, lane); continue; } r -= I_BR;
                if (r < I_OUT) { tr_item<0>(w_out, DM, (r / 16) * 32, (r % 16) * 128, WOUT, DM, nullptr, scr, lane); continue; } r -= I_OUT;
                if (r < I_FI) { tr_item<2>(w_ffn_in, 2 * DFF, (r / 88) * 32, (r % 88) * 128, WFI, DM, nullptr, scr, lane); continue; } r -= I_FI;
                tr_item<0>(w_ffn_out, DM, (r / 16) * 32, (r % 16) * 128, WFO, DFF, nullptr, scr, lane);
            }
          } }
    }
    SEAM(2);

    if (IN(3)) for (int rep_ = 0; rep_ < REPS(3); ++rep_) { if (rep_) cg::this_grid().sync(); PH_START(3);
        const bool split = (G % 16 == 0);
        for (int pass = 0; pass < (split ? 1 : 2); ++pass) {
            const int sel = split ? ((bx >> 3) & 1) : pass;
            const int Ge = split ? G / 2 : G, ce = split ? ((bx >> 4) * 8 + (bx & 7)) : bx;
            pg8::Gemm g; pg8::EpiBf16 E;
            if (sel == 0) { g = pg8::Gemm{P, WUQ, NTOK, NH * QKD, QL, PCOLS, QL}; E = pg8::EpiBf16{QUP, NH * QKD}; }
            else { g = pg8::Gemm{P + PC_KV, WUKV, MROWS, 2048, KVL, PCOLS, KVL}; E = pg8::EpiBf16{KVUP, 2048}; }
            pg8::StaticOrder S; S.init(g.M, g.N, Ge, ce);
            pg8::gemm_phase<pg8::EpiBf16, pg8::StaticOrder>((LAS unsigned char*)lds, g, S, E);
        }
    }
    SEAM(3);

    if (IN(4)) for (int rep_ = 0; rep_ < REPS(4); ++rep_) { if (rep_) cg::this_grid().sync(); PH_START(4);
        LAS float* T = (LAS float*)(lds + wave * 128);
        for (int t = gw; t < MROWS; t += NGW) {
            const bool lat = t < NTOK;
            const bf16_t* Prow = P + (size_t)t * PCOLS;
            int b, n, m;
            if (lat) { b = t / SEQ; n = t % SEQ; m = n; } else { const int tc = t - NTOK; b = tc / CTXL; n = 0; m = SEQ + tc % CTXL; }
            u32x4 kvw[4];
#pragma unroll
            for (int j = 0; j < 4; ++j) kvw[j] = *(const u32x4*)(KVUP + (size_t)t * 2048 + j * 512 + lane * 8);
            const u32x2 kvcw = *(const u32x2*)(Prow + PC_KV + lane * 4);
            const u32x4 krw = *(const u32x4*)(Prow + PC_KR + (lane & 7) * 8);
            u32x4 qw[3] = {}, qcw = {}, gvw[2] = {};
            if (lat) {
#pragma unroll
                for (int j = 0; j < 3; ++j) qw[j] = *(const u32x4*)(QUP + (size_t)t * (NH * QKD) + j * 512 + lane * 8);
                qcw = *(const u32x4*)(Prow + lane * 8);
#pragma unroll
                for (int j = 0; j < 2; ++j) gvw[j] = *(const u32x4*)(Prow + PC_V + j * 512 + lane * 8);
            }
            const int c = lane & 7; const bool first = (c & 2) == 0;
            float cs[8], sn[8];
#pragma unroll
            for (int e = 0; e < 8; ++e) { cs[e] = 1.f; sn[e] = 0.f; }
            if (lat) { const int pos = (c < 4) ? (n >> 6) : (n & 63); const float* tp = (const float*)(ws + WS_ROPE) + pos * 32 + (c & 1) * 8;
                const f32x4 c0 = *(const f32x4*)tp, c1 = *(const f32x4*)(tp + 4), s0 = *(const f32x4*)(tp + 16), s1 = *(const f32x4*)(tp + 20);
                cs[0] = c0[0]; cs[1] = c0[1]; cs[2] = c0[2]; cs[3] = c0[3]; cs[4] = c1[0]; cs[5] = c1[1]; cs[6] = c1[2]; cs[7] = c1[3];
                sn[0] = s0[0]; sn[1] = s0[1]; sn[2] = s0[2]; sn[3] = s0[3]; sn[4] = s1[0]; sn[5] = s1[1]; sn[6] = s1[2]; sn[7] = s1[3]; }
            float r_kv;
            { const float a0 = bflo(kvcw.x), a1 = bfhi(kvcw.x), a2 = bflo(kvcw.y), a3 = bfhi(kvcw.y);
              r_kv = 1.0f / sqrtf(wave_sum((a0 * a0 + a1 * a1) + (a2 * a2 + a3 * a3)) * (1.0f / KVL) + EPS); }
            float kr[8]; kr[0] = bflo(krw.x); kr[1] = bfhi(krw.x); kr[2] = bflo(krw.y); kr[3] = bfhi(krw.y); kr[4] = bflo(krw.z); kr[5] = bfhi(krw.z); kr[6] = bflo(krw.w); kr[7] = bfhi(krw.w);
            float ss_r = 0.f;
#pragma unroll
            for (int e = 0; e < 8; ++e) ss_r += kr[e] * kr[e];
            ss_r = sum8(ss_r);
            const bool isV = (lane & 16) != 0; const int d8 = (lane & 15) * 8;
#pragma unroll
            for (int j = 0; j < 4; ++j) {
                float f[8]; f[0] = bflo(kvw[j].x); f[1] = bfhi(kvw[j].x); f[2] = bflo(kvw[j].y); f[3] = bfhi(kvw[j].y); f[4] = bflo(kvw[j].z); f[5] = bfhi(kvw[j].z); f[6] = bflo(kvw[j].w); f[7] = bfhi(kvw[j].w);
                float ssn = 0.f;
#pragma unroll
                for (int e = 0; e < 8; ++e) { f[e] *= r_kv; ssn += f[e] * f[e]; }
                ssn = sum16(ssn);
                const int h = 2 * j + (lane >> 5);
                const float rn = 1.0f / sqrtf((ssn + ss_r) * (1.0f / QKD) + EPS);
                if (!isV && (lane & 15) == 0) T[h] = rn;
                float ov[8];
#pragma unroll
                for (int e = 0; e < 8; ++e) ov[e] = isV ? f[e] : f[e] * rn * qk_norm_k[d8 + e];
                u32x4 w; w.x = pk2(ov[0], ov[1]); w.y = pk2(ov[2], ov[3]); w.z = pk2(ov[4], ov[5]); w.w = pk2(ov[6], ov[7]);
                bf16_t* dst = isV ? VF + ((size_t)(b * NH + h) * SKV + m) * VD + d8 : KF + ((size_t)(b * NH + h) * SKV + m) * QKD + d8;
                *(u32x4*)dst = w;
            }
            LDS_WAIT();
            { const int h = lane >> 3; const float rn = T[h];
              float f[8];
#pragma unroll
              for (int e = 0; e < 8; ++e) f[e] = kr[e] * rn * qk_norm_k[128 + c * 8 + e];
              if (lat) {
#pragma unroll
                  for (int e = 0; e < 8; ++e) { const float pr = dppf<DPP_XOR2>(f[e]); f[e] = first ? f[e] * cs[e] - pr * sn[e] : f[e] * cs[e] + pr * sn[e]; } }
              u32x4 w; w.x = pk2(f[0], f[1]); w.y = pk2(f[2], f[3]); w.z = pk2(f[4], f[5]); w.w = pk2(f[6], f[7]);
              *(u32x4*)(KF + ((size_t)(b * NH + h) * SKV + m) * QKD + 128 + c * 8) = w; }
            if (lat) {
                float r_q;
                { float s2 = 0.f;
                  s2 += bflo(qcw.x) * bflo(qcw.x) + bfhi(qcw.x) * bfhi(qcw.x); s2 += bflo(qcw.y) * bflo(qcw.y) + bfhi(qcw.y) * bfhi(qcw.y);
                  s2 += bflo(qcw.z) * bflo(qcw.z) + bfhi(qcw.z) * bfhi(qcw.z); s2 += bflo(qcw.w) * bflo(qcw.w) + bfhi(qcw.w) * bfhi(qcw.w);
                  r_q = 1.0f / sqrtf(wave_sum(s2) * (1.0f / QL) + EPS); }
                float qf[3][8];
#pragma unroll
                for (int j = 0; j < 3; ++j) { qf[j][0] = bflo(qw[j].x); qf[j][1] = bfhi(qw[j].x); qf[j][2] = bflo(qw[j].y); qf[j][3] = bfhi(qw[j].y); qf[j][4] = bflo(qw[j].z); qf[j][5] = bfhi(qw[j].z); qf[j][6] = bflo(qw[j].w); qf[j][7] = bfhi(qw[j].w); }
#pragma unroll
                for (int j = 0; j < 3; ++j) { float sq = 0.f;
#pragma unroll
                    for (int e = 0; e < 8; ++e) { qf[j][e] *= r_q; sq += qf[j][e] * qf[j][e]; }
                    sq = sum8(sq);
                    if (j < 2) { sq += dppf<DPP_MIR>(sq); if ((lane & 15) == 0) T[8 + 4 * j + (lane >> 4)] = sq; }
                    else { if ((lane & 7) == 0) T[16 + (lane >> 3)] = sq; } }
                LDS_WAIT();
#pragma unroll
                for (int j = 0; j < 2; ++j) { const int h = 4 * j + (lane >> 4);
                    const float rn = 1.0f / sqrtf((T[8 + h] + T[16 + h]) * (1.0f / QKD) + EPS);
                    float ov[8];
#pragma unroll
                    for (int e = 0; e < 8; ++e) ov[e] = qf[j][e] * rn * qk_norm_q[d8 + e];
                    u32x4 w; w.x = pk2(ov[0], ov[1]); w.y = pk2(ov[2], ov[3]); w.z = pk2(ov[4], ov[5]); w.w = pk2(ov[6], ov[7]);
                    *(u32x4*)(QF + ((size_t)(b * NH + h) * SEQ + n) * QKD + d8) = w; }
                { const int h = lane >> 3;
                  const float rn = 1.0f / sqrtf((T[8 + h] + T[16 + h]) * (1.0f / QKD) + EPS);
                  float f[8];
#pragma unroll
                  for (int e = 0; e < 8; ++e) f[e] = qf[2][e] * rn * qk_norm_q[128 + c * 8 + e];
#pragma unroll
                  for (int e = 0; e < 8; ++e) { const float pr = dppf<DPP_XOR2>(f[e]); f[e] = first ? f[e] * cs[e] - pr * sn[e] : f[e] * cs[e] + pr * sn[e]; }
                  u32x4 w; w.x = pk2(f[0], f[1]); w.y = pk2(f[2], f[3]); w.z = pk2(f[4], f[5]); w.w = pk2(f[6], f[7]);
                  *(u32x4*)(QF + ((size_t)(b * NH + h) * SEQ + n) * QKD + 128 + c * 8) = w; }
                LDS_WAIT();
                bf16_t* vp = (bf16_t*)Prow + PC_V;
                float f[16]; float s = 0.f;
#pragma unroll
                for (int j = 0; j < 2; ++j) { const u32x4 w = gvw[j];
                    f[j * 8 + 0] = bflo(w.x); f[j * 8 + 1] = bfhi(w.x); f[j * 8 + 2] = bflo(w.y); f[j * 8 + 3] = bfhi(w.y);
                    f[j * 8 + 4] = bflo(w.z); f[j * 8 + 5] = bfhi(w.z); f[j * 8 + 6] = bflo(w.w); f[j * 8 + 7] = bfhi(w.w); }
#pragma unroll
                for (int j = 0; j < 16; ++j) s += f[j];
                const float mu = wave_sum(s) * (1.0f / 1024.0f); float q = 0.f;
#pragma unroll
                for (int j = 0; j < 16; ++j) { f[j] -= mu; q += f[j] * f[j]; }
                const float rstd = 1.0f / sqrtf(wave_sum(q) * (1.0f / 1024.0f) + EPS);
#pragma unroll
                for (int j = 0; j < 2; ++j) { const int c0 = j * 512 + lane * 8; float o[8];
#pragma unroll
                    for (int e = 0; e < 8; ++e) o[e] = f[j * 8 + e] * rstd * sgu_norm_g[c0 + e] + sgu_norm_b[c0 + e];
                    u32x4 w; w.x = pk2(o[0], o[1]); w.y = pk2(o[2], o[3]); w.z = pk2(o[4], o[5]); w.w = pk2(o[6], o[7]);
                    *(u32x4*)(vp + c0) = w; }
            }
        }
    }
    SEAM(4);

    if (IN(5)) for (int rep_ = 0; rep_ < REPS(5); ++rep_) { if (rep_) cg::this_grid().sync(); PH_START(5);
        PH_START(12);
        {
            const int r32 = lane & 31, hi = lane >> 5, ib = wave & 3, chh = wave >> 2;
            LAS unsigned char* ldsl = (LAS unsigned char*)lds;
            const int vbw = (int)(uintptr_t)(char*)lds + att::v_rd_base(lane) + chh * 1024;
#define SGU_DMA(un_, slot_) do { const int ck_ = (un_) >> 3, g_ = (un_) & 7; const char* src_ = (const char*)(P + (size_t)ck_ * 128 * PCOLS + PC_V + g_ * 128); \
    _Pragma("unroll") for (int hb_ = 0; hb_ < 2; ++hb_) _Pragma("unroll") for (int i_ = 0; i_ < 2; ++i_) { const int p_ = i_ * 512 + tid, st_ = p_ >> 5, wi_ = p_ & 31, kk_ = (st_ >> 2) * 8 + (wi_ >> 2), c_ = (st_ & 3) * 32 + (wi_ & 3) * 8; \
        const int k_ = (kk_ & ~0xC) | ((kk_ & 4) << 1) | ((kk_ & 8) >> 1); const size_t vo_ = (size_t)(hb_ * 64 + k_) * (PCOLS * 2) + c_ * 2; \
        __builtin_amdgcn_global_load_lds((const unsigned*)(src_ + vo_), (LAS unsigned*)(ldsl + (slot_) * 32768 + hb_ * 16384 + i_ * 8192 + wave * 1024), 16, 0, 0); } } while (0)
#define SGU_AF(dst, un_) do { const int g_ = (un_) & 7; _Pragma("unroll") for (int ks_ = 0; ks_ < 8; ++ks_) dst[ks_] = *(const bf16x8*)(WSP + ((size_t)g_ * 128 + ib * 32 + r32) * 128 + ks_ * 16 + hi * 8); } while (0)
            bf16x8 af[8], afn[8];
            int un = vcu, slot = 0;
            if (un < 1024) { SGU_DMA(un, 0); SGU_AF(af, un); }
            for (; un < 1024; un += G, slot ^= 1) {
                const int ck = un >> 3, g = un & 7; const size_t t0 = (size_t)ck * 128;
                asm volatile("s_waitcnt vmcnt(0)" ::: "memory"); __syncthreads();
                const int un2 = un + G;
                if (un2 < 1024) { SGU_DMA(un2, slot ^ 1); SGU_AF(afn, un2); }
                f32x4 bsv[4];
#pragma unroll
                for (int q = 0; q < 4; ++q) bsv[q] = *(const f32x4*)(b_spatial + g * 128 + ib * 32 + 8 * q + 4 * hi);
                unsigned short uu[2][16];
#pragma unroll
                for (int d = 0; d < 2; ++d)
#pragma unroll
                    for (int r = 0; r < 16; ++r) uu[d][r] = P[(t0 + ib * 32 + att::crow(r, hi)) * PCOLS + PC_U + g * 128 + (2 * chh + d) * 32 + r32];
                f32x16 acc0 = {}, acc1 = {};
                const int vb = vbw + slot * 32768;
#define SGU_STEP(KS) do { const int vbk_ = vb + ((KS) >> 2) * 16384; \
    const s16x4 l0_ = att::tr_read<att::v_rd_off(0, (KS) & 3, 0)>(vbk_), h0_ = att::tr_read<att::v_rd_off(0, (KS) & 3, 1)>(vbk_), l1_ = att::tr_read<att::v_rd_off(1, (KS) & 3, 0)>(vbk_), h1_ = att::tr_read<att::v_rd_off(1, (KS) & 3, 1)>(vbk_); \
    asm volatile("s_waitcnt lgkmcnt(0)" ::: "memory"); __builtin_amdgcn_sched_barrier(0); \
    acc0 = __builtin_amdgcn_mfma_f32_32x32x16_bf16(af[KS], (bf16x8){l0_[0], l0_[1], l0_[2], l0_[3], h0_[0], h0_[1], h0_[2], h0_[3]}, acc0, 0, 0, 0); \
    acc1 = __builtin_amdgcn_mfma_f32_32x32x16_bf16(af[KS], (bf16x8){l1_[0], l1_[1], l1_[2], l1_[3], h1_[0], h1_[1], h1_[2], h1_[3]}, acc1, 0, 0, 0); } while (0)
                SGU_STEP(0); SGU_STEP(1); SGU_STEP(2); SGU_STEP(3); SGU_STEP(4); SGU_STEP(5); SGU_STEP(6); SGU_STEP(7);
#undef SGU_STEP
#pragma unroll
                for (int r = 0; r < 16; ++r) { const size_t t = t0 + ib * 32 + att::crow(r, hi); const int c = g * 128 + (2 * chh) * 32 + r32; const float bsr = bsv[r >> 2][r & 3];
                    AO[t * DM + 1024 + c] = (bf16_t)f2bf(bf2f(uu[0][r]) * (acc0[r] + bsr));
                    AO[t * DM + 1024 + c + 32] = (bf16_t)f2bf(bf2f(uu[1][r]) * (acc1[r] + bsr)); }
                if (un2 < 1024) {
#pragma unroll
                    for (int ks = 0; ks < 8; ++ks) af[ks] = afn[ks]; }
            }
            __syncthreads();
#undef SGU_DMA
#undef SGU_AF
        }
        PH_END(12);
        att::attn_offsets_init((char*)lds);
        for (int un = vcu; un < NB * NH * (SEQ / 256); un += G) {
            const int bh = un >> 4, qb = un & 15, b = bh >> 3, h = bh & 7;
            att::attn_unit(QF + ((size_t)bh * SEQ + qb * 256) * QKD, KF + (size_t)bh * SKV * QKD, VF + (size_t)bh * SKV * VD,
                           AO + ((size_t)b * SEQ + qb * 256) * DM + h * VD, (char*)lds, (LAS unsigned char*)lds);
        }
    }
    SEAM(5);

    if (IN(6)) for (int rep_ = 0; rep_ < REPS(6); ++rep_) { if (rep_) cg::this_grid().sync(); PH_START(6);
        pg8::Gemm g{AO, WBR, NTOK, DM, DM, DM, DM}; pg8::StaticOrder S; S.init(NTOK, DM, G, bx);
        pg8::EpiMerge E{P + PC_GA, P + PC_GS, PCOLS, MERGED};
        pg8::gemm_phase<pg8::EpiMerge, pg8::StaticOrder>((LAS unsigned char*)lds, g, S, E);
    }
    SEAM(6);

    if (IN(7)) for (int rep_ = 0; rep_ < REPS(7); ++rep_) { if (rep_) cg::this_grid().sync(); PH_START(7);
        pg8::Gemm g{MERGED, WOUT, NTOK, DM, DM, DM, DM}; pg8::StaticOrder S; S.init(NTOK, DM, G, bx);
        pg8::EpiRes E{x, out, MOD + 2 * DM};
        pg8::gemm_phase<pg8::EpiRes, pg8::StaticOrder>((LAS unsigned char*)lds, g, S, E);
    }
    SEAM(7);

    if (IN(8)) for (int rep_ = 0; rep_ < REPS(8); ++rep_) { if (rep_) cg::this_grid().sync(); PH_START(8);
        for (int row = gw; row < NTOK; row += NGW) {
            const float* src = out + (size_t)row * DM; const int b = row / SEQ;
            const float* sh = MOD + (size_t)b * NMOD + 3 * DM; const float* scp = sh + DM;
            f32x4 v[8]; float ss = 0.f;
#pragma unroll
            for (int j = 0; j < 8; ++j) { v[j] = __builtin_nontemporal_load((const f32x4*)(src + (lane + 64 * j) * 4)); ss += (v[j].x * v[j].x + v[j].y * v[j].y) + (v[j].z * v[j].z + v[j].w * v[j].w); }
            const float r = 1.0f / sqrtf(wave_sum(ss) * (1.0f / DM) + EPS);
#pragma unroll
            for (int j = 0; j < 8; ++j) { const int idx = (lane + 64 * j) * 4; const f32x4 g = *(const f32x4*)(norm2_g + idx), s1 = *(const f32x4*)(scp + idx), s0 = *(const f32x4*)(sh + idx);
                const f32x4 o = (v[j] * r * g) * (s1 + 1.0f) + s0;
                u32x2 w; w.x = pk2(o.x, o.y); w.y = pk2(o.z, o.w); *(u32x2*)(H2 + (size_t)row * DM + idx) = w; }
        }
    }
    SEAM(8);

    if (IN(9)) for (int rep_ = 0; rep_ < REPS(9); ++rep_) { if (rep_) cg::this_grid().sync(); PH_START(9);
        pg8::Gemm g{H2, WFI, NTOK, 2 * DFF, DM, DM, DM}; pg8::StaticOrder S; S.init(NTOK, 2 * DFF, G, bx);
        pg8::EpiFfnIn E{ACT};
        pg8::gemm_phase<pg8::EpiFfnIn, pg8::StaticOrder>((LAS unsigned char*)lds, g, S, E);
    }
    SEAM(9);

    if (IN(10)) for (int rep_ = 0; rep_ < REPS(10); ++rep_) { if (rep_) cg::this_grid().sync(); PH_START(10);
        pg8::Gemm g{ACT, WFO, NTOK, DM, DFF, DFF, DFF}; pg8::StaticOrder S; S.init(NTOK, DM, G, bx);
        pg8::EpiRes E{out, out, MOD + 5 * DM};
        pg8::gemm_phase<pg8::EpiRes, pg8::StaticOrder>((LAS unsigned char*)lds, g, S, E);
    }
#undef IN
#undef SEAM
}

constexpr int N_PHASES = 11;

extern "C" void kernel_launch(void* const* d_in, const int* in_sizes, int n_in, void* d_out, int out_size, void* d_ws, size_t ws_size, hipStream_t stream) {
    static int grid = 0;
    if (grid == 0) {
        if (n_in != 24 || out_size != NTOK * DM || ws_size < WS_END) { fprintf(stderr, "kernel_launch: unexpected shapes n_in %d out %d ws %zu\n", n_in, out_size, ws_size); grid = -1; return; }
        int dev = 0, cus = 0, per_cu = 0;
        (void)hipGetDevice(&dev); (void)hipDeviceGetAttribute(&cus, hipDeviceAttributeMultiprocessorCount, dev);
        if (hipFuncSetAttribute((const void*)fwd_kernel, hipFuncAttributeMaxDynamicSharedMemorySize, LDS_BYTES) != hipSuccess) { fprintf(stderr, "kernel_launch: hipFuncSetAttribute failed\n"); grid = -1; return; }
        if (hipOccupancyMaxActiveBlocksPerMultiprocessor(&per_cu, (const void*)fwd_kernel, 512, LDS_BYTES) != hipSuccess || per_cu < 1) { fprintf(stderr, "kernel_launch: occupancy query says %d\n", per_cu); per_cu = 1; }
        (void)hipGetLastError();
        grid = cus * per_cu;
    }
    if (grid < 0) return;
    Args a{};
    for (int i = 0; i < 24; ++i) a.in[i] = (const float*)d_in[i];
    a.out = (float*)d_out; a.ws = (unsigned char*)d_ws;
#if MK_LAUNCH_PER_PHASE
    for (int p = 0; p < N_PHASES; ++p) { a.ph_lo = p; a.ph_hi = p + 1;
        hipLaunchKernelGGL(fwd_kernel, dim3(grid), dim3(512), LDS_BYTES, stream, a); }
#else
#ifndef PROBE_SPLIT
    (void)hipMemsetAsync((char*)d_ws + WS_BAR, 0, XCD_BAR_WORDS * 4, stream);
    a.ph_lo = 0; a.ph_hi = N_PHASES;
    void* kargs[] = {&a};
    hipError_t e = hipLaunchCooperativeKernel((const void*)fwd_kernel, dim3(grid), dim3(512), kargs, LDS_BYTES, stream);
    if (e != hipSuccess) fprintf(stderr, "cooperative launch failed: %s (grid %d)\n", hipGetErrorString(e), grid);
#else
    void* kargs[] = {&a};
    a.ph_lo = 0; a.ph_hi = PROBE_SPLIT + 1;
    (void)hipLaunchCooperativeKernel((const void*)fwd_kernel, dim3(grid), dim3(512), kargs, LDS_BYTES, stream);
    a.ph_lo = PROBE_SPLIT; a.ph_hi = N_PHASES;
    (void)hipLaunchCooperativeKernel((const void*)fwd_kernel, dim3(grid), dim3(512), kargs, LDS_BYTES, stream);
#endif
#endif
}
```

```cpp
#include <hip/hip_runtime.h>
#include <hip/hip_cooperative_groups.h>
#include <cstdio>
#include <cstdint>
namespace cg = cooperative_groups;

#ifndef MK_LAUNCH_PER_PHASE
#define MK_LAUNCH_PER_PHASE 0
#endif

#define LAS __attribute__((address_space(3)))
typedef unsigned short bf16_t;
typedef short bf16x8 __attribute__((ext_vector_type(8)));
typedef short s16x4 __attribute__((ext_vector_type(4)));
typedef float f32x2 __attribute__((ext_vector_type(2)));
typedef float f32x4 __attribute__((ext_vector_type(4)));
typedef float f32x16 __attribute__((ext_vector_type(16)));
typedef unsigned u32x2 __attribute__((ext_vector_type(2)));
typedef unsigned u32x4 __attribute__((ext_vector_type(4)));

constexpr int DM = 2048, NB = 4, SEQ = 4096, NTOK = NB * SEQ, CTXL = 256, NCTX = NB * CTXL, MROWS = NTOK + NCTX;
constexpr int NH = 8, QL = 512, KVL = 256, QKD = 192, VD = 128;
constexpr int DFF = 5632, NMOD = 6 * DM;
constexpr int SKV = SEQ + CTXL;
constexpr int PCOLS = 7168;
constexpr int PC_KV = 512, PC_KR = 768, PC_U = 1024, PC_V = 2048, PC_GA = 3072, PC_GS = 5120;
constexpr int IN_COLS = 6976;
constexpr float EPS = 1e-6f;

constexpr size_t MiB = 1u << 20;
constexpr size_t WS_MOD = 0;
constexpr size_t WS_BAR = 768 * 1024;
constexpr size_t WS_WIN = 1 * MiB;
constexpr size_t WS_WUQ = 29 * MiB;
constexpr size_t WS_WUKV = 31 * MiB;
constexpr size_t WS_WBRA = 32 * MiB;
constexpr size_t WS_WBRS = 36 * MiB;
constexpr size_t WS_WOUT = 40 * MiB;
constexpr size_t WS_WFI = 48 * MiB;
constexpr size_t WS_WFO = 92 * MiB;
constexpr size_t WS_WSP = 114 * MiB;
constexpr size_t WS_H = 116 * MiB;
constexpr size_t WS_P = 184 * MiB;
constexpr size_t WS_KF = 422 * MiB;
constexpr size_t WS_VF = 473 * MiB;
constexpr size_t WS_MERGED = 422 * MiB;
constexpr size_t WS_END = 512 * MiB;
constexpr size_t DO_QF = 48 * MiB;

constexpr int LDS_BYTES = 139264, LDS_BARST = 139200;

__device__ __forceinline__ unsigned f2bf(float f) { unsigned u = __builtin_bit_cast(unsigned, f); return (u + 0x7fffu + ((u >> 16) & 1u)) >> 16; }
__device__ __forceinline__ unsigned pk2(float lo, float hi) { unsigned r; asm("v_cvt_pk_bf16_f32 %0, %1, %2" : "=v"(r) : "v"(lo), "v"(hi)); return r; }
__device__ __forceinline__ float bf2f(unsigned short b) { return __builtin_bit_cast(float, ((unsigned)b) << 16); }
__device__ __forceinline__ float bflo(unsigned w) { return __builtin_bit_cast(float, w << 16); }
__device__ __forceinline__ float bfhi(unsigned w) { return __builtin_bit_cast(float, w & 0xffff0000u); }
template <int CTRL> __device__ __forceinline__ float dppf(float v) { return __builtin_bit_cast(float, __builtin_amdgcn_update_dpp(0, __builtin_bit_cast(int, v), CTRL, 0xf, 0xf, true)); }
#define DPP_XOR1 0xB1
#define DPP_XOR2 0x4E
#define DPP_HMIR 0x141
#define DPP_MIR  0x140
__device__ __forceinline__ float sum4(float v) { v += dppf<DPP_XOR1>(v); v += dppf<DPP_XOR2>(v); return v; }
__device__ __forceinline__ float sum8(float v) { v = sum4(v); v += dppf<DPP_HMIR>(v); return v; }
__device__ __forceinline__ float sum16(float v) { v = sum8(v); v += dppf<DPP_MIR>(v); return v; }
__device__ __forceinline__ float wave_sum(float v) {
    v = sum16(v);
    const float a = __builtin_bit_cast(float, __builtin_amdgcn_readlane(__builtin_bit_cast(int, v), 0)), b = __builtin_bit_cast(float, __builtin_amdgcn_readlane(__builtin_bit_cast(int, v), 16));
    const float c = __builtin_bit_cast(float, __builtin_amdgcn_readlane(__builtin_bit_cast(int, v), 32)), d = __builtin_bit_cast(float, __builtin_amdgcn_readlane(__builtin_bit_cast(int, v), 48));
    return (a + b) + (c + d);
}
#define LDS_WAIT() asm volatile("s_waitcnt lgkmcnt(0)" ::: "memory")

namespace pg8 {
#define PG8_LAS __attribute__((address_space(3)))
constexpr int BM = 256, BK = 64, HALF = 128, HTB = HALF * BK * 2, STAGE_BYTES = 8 * HTB, NXCD = 8, WGM = 7;
__host__ __device__ __forceinline__ int lds_byte(int r, int c) { const int st = (r >> 4) * 2 + (c >> 5), rr = r & 15, cc = c & 31, ob = rr * 64 + cc * 2; return st * 1024 + (ob ^ (((ob >> 9) & 1) << 5)); }
__host__ __device__ __forceinline__ void stage_rc(int b, int& R, int& C) { const int st = b / 1024, sb = b % 1024, swz = sb ^ (((sb >> 9) & 1) << 5); R = (st >> 1) * 16 + swz / 64; C = (st & 1) * 32 + (swz % 64) / 2; }
__host__ __device__ __forceinline__ int perm32(int rho) { const int n = rho >> 4, i = rho & 15; return 8 * (i >> 2) + 4 * n + (i & 3); }

struct Unit { int pm, pn; };
struct Gemm { const bf16_t* A; const bf16_t* Bt; int M, N, K, lda, ldb; };

struct StaticOrder {
    int nM, nN, nwg, G, c;
    __device__ void init(int M, int N, int G_, int c_) { nM = M / BM; nN = N / BM; nwg = nM * nN; G = G_; c = c_; }
    __device__ bool next(int i, Unit& u) const {
        const long L = (long)i * G + c; if (L >= nwg) return false;
        int wgid = (int)L; { const int q = nwg / NXCD, r = nwg % NXCD, xcd = wgid % NXCD, off = wgid / NXCD; wgid = (xcd < r ? xcd * (q + 1) : r * (q + 1) + (xcd - r) * q) + off; }
        const int nig = WGM * nN, gid = wgid / nig, fm = gid * WGM, gsz = (nM - fm) < WGM ? (nM - fm) : WGM;
        u.pm = fm + ((wgid % nig) % gsz); u.pn = (wgid % nig) / gsz; return true;
    }
    __device__ __forceinline__ void a_ready(const Unit&) const {}
    __device__ __forceinline__ void done(const Unit&) const {}
};
struct ProjOrder {
    StaticOrder S; int G, c;
    __device__ void init(int G_, int c_) { S.init(NTOK, PCOLS, G_, c_); G = G_; c = c_; }
    __device__ bool next(int i, Unit& u) const {
        const long L = (long)i * G + c;
        if (L < S.nwg) return S.next(i, u);
        const int j = (int)(L - S.nwg); if (j >= 8) return false;
        u.pm = 64 + (j >> 1); u.pn = 2 + (j & 1); return true;
    }
    __device__ __forceinline__ void a_ready(const Unit&) const {}
    __device__ __forceinline__ void done(const Unit&) const {}
};

__device__ __forceinline__ unsigned cvt_pk_bf16(float lo, float hi) { unsigned r; asm volatile("v_cvt_pk_bf16_f32 %0, %1, %2" : "=v"(r) : "v"(lo), "v"(hi)); return r; }
__device__ __forceinline__ f32x2 gelu_pk(f32x2 v) {
    const f32x2 av = __builtin_elementwise_abs(v), d = av * 0.2316418882f + 1.0f;
    f32x2 t; t.x = __builtin_amdgcn_rcpf(d.x); t.y = __builtin_amdgcn_rcpf(d.y);
    f32x2 q = t * 0.5307027145f + (-0.7265760135f); q = q * t + 0.7107068705f; q = q * t + (-0.142248368f); q = q * t + 0.127414796f; q = q * t;
    const f32x2 s = (v * v) * (-0.72134752044f);
    f32x2 e; e.x = __builtin_amdgcn_exp2f(s.x); e.y = __builtin_amdgcn_exp2f(s.y);
    const f32x2 m = v * (q * e), r = v - m;
    f32x2 o; o.x = v.x < 0.f ? m.x : r.x; o.y = v.y < 0.f ? m.y : r.y; return o;
}
__device__ __forceinline__ float sigm(float x) { return __builtin_amdgcn_rcpf(1.0f + __builtin_amdgcn_exp2f(-1.4426950408889634f * x)); }

struct EpiProj {
    static constexpr bool PERM = true, AFTER_DRAIN = false, MID = false;
    bf16_t* O; int ldc;
    __device__ __forceinline__ void operator()(const f32x4 (&acc)[2][2][4][2], const Unit& u, int wr, int wc, int fr, int fq) const {
        const int row0 = u.pm * BM + wr * 64 + fr, col0 = u.pn * BM + wc * 32 + 8 * fq;
        const int act = (u.pn < 4) ? 0 : (u.pn < 12 ? 1 : 2);
#pragma unroll
        for (int ai = 0; ai < 2; ++ai)
#pragma unroll
            for (int m = 0; m < 4; ++m) { bf16_t* rowp = O + (size_t)(row0 + ai * HALF + m * 16) * ldc + col0;
#pragma unroll
                for (int bj = 0; bj < 2; ++bj) { f32x4 v0 = acc[ai][bj][m][0], v1 = acc[ai][bj][m][1];
                    if (act == 1) { f32x2 a = gelu_pk((f32x2){v0[0], v0[1]}), b = gelu_pk((f32x2){v0[2], v0[3]}), c = gelu_pk((f32x2){v1[0], v1[1]}), d = gelu_pk((f32x2){v1[2], v1[3]});
                        v0 = (f32x4){a.x, a.y, b.x, b.y}; v1 = (f32x4){c.x, c.y, d.x, d.y}; }
                    else if (act == 2) {
#pragma unroll
                        for (int j = 0; j < 4; ++j) { v0[j] = sigm(v0[j]); v1[j] = sigm(v1[j]); } }
                    u32x4 w; w.x = cvt_pk_bf16(v0[0], v0[1]); w.y = cvt_pk_bf16(v0[2], v0[3]); w.z = cvt_pk_bf16(v1[0], v1[1]); w.w = cvt_pk_bf16(v1[2], v1[3]);
                    *(u32x4*)(rowp + bj * HALF) = w; } }
    }
};
struct EpiBf16 {
    static constexpr bool PERM = true, AFTER_DRAIN = false, MID = false;
    bf16_t* O; int ldc;
    __device__ __forceinline__ void operator()(const f32x4 (&acc)[2][2][4][2], const Unit& u, int wr, int wc, int fr, int fq) const {
        const int row0 = u.pm * BM + wr * 64 + fr, col0 = u.pn * BM + wc * 32 + 8 * fq;
#pragma unroll
        for (int ai = 0; ai < 2; ++ai)
#pragma unroll
            for (int m = 0; m < 4; ++m) { bf16_t* rowp = O + (size_t)(row0 + ai * HALF + m * 16) * ldc + col0;
#pragma unroll
                for (int bj = 0; bj < 2; ++bj) { const f32x4 v0 = acc[ai][bj][m][0], v1 = acc[ai][bj][m][1];
                    u32x4 w; w.x = cvt_pk_bf16(v0[0], v0[1]); w.y = cvt_pk_bf16(v0[2], v0[3]); w.z = cvt_pk_bf16(v1[0], v1[1]); w.w = cvt_pk_bf16(v1[2], v1[3]);
                    *(u32x4*)(rowp + bj * HALF) = w; } }
    }
};
struct EpiMerge {
    static constexpr bool PERM = true, AFTER_DRAIN = false, MID = true;
    const bf16_t* GA; const bf16_t* GS; int ldg; bf16_t* O;
    __device__ __forceinline__ void mid(f32x4 (&acc)[2][2][4][2], const Unit& u, int wr, int wc, int fr, int fq) const {
        int row0 = u.pm * BM + wr * 64 + fr, col0 = u.pn * BM + wc * 32 + 8 * fq;
        asm volatile("" : "+v"(row0), "+v"(col0));
#pragma unroll
        for (int ai = 0; ai < 2; ++ai)
#pragma unroll
            for (int m = 0; m < 4; ++m) { const size_t r = (size_t)(row0 + ai * HALF + m * 16);
#pragma unroll
                for (int bj = 0; bj < 2; ++bj) { const int c = col0 + bj * HALF;
                    const u32x4 ga = *(const u32x4*)(GA + r * ldg + c), gs = *(const u32x4*)(GS + r * ldg + c);
                    f32x4 r0, r1;
                    r0[0] = bflo(ga.x) * __builtin_amdgcn_rcpf(fmaxf(bflo(gs.x), 1e-30f)); r0[1] = bfhi(ga.x) * __builtin_amdgcn_rcpf(fmaxf(bfhi(gs.x), 1e-30f));
                    r0[2] = bflo(ga.y) * __builtin_amdgcn_rcpf(fmaxf(bflo(gs.y), 1e-30f)); r0[3] = bfhi(ga.y) * __builtin_amdgcn_rcpf(fmaxf(bfhi(gs.y), 1e-30f));
                    r1[0] = bflo(ga.z) * __builtin_amdgcn_rcpf(fmaxf(bflo(gs.z), 1e-30f)); r1[1] = bfhi(ga.z) * __builtin_amdgcn_rcpf(fmaxf(bfhi(gs.z), 1e-30f));
                    r1[2] = bflo(ga.w) * __builtin_amdgcn_rcpf(fmaxf(bflo(gs.w), 1e-30f)); r1[3] = bfhi(ga.w) * __builtin_amdgcn_rcpf(fmaxf(bfhi(gs.w), 1e-30f));
                    acc[ai][bj][m][0] = acc[ai][bj][m][0] * r0; acc[ai][bj][m][1] = acc[ai][bj][m][1] * r1; }
                asm volatile("" ::: "memory"); }
    }
    __device__ __forceinline__ void operator()(const f32x4 (&acc)[2][2][4][2], const Unit& u, int wr, int wc, int fr, int fq) const {
        int row0 = u.pm * BM + wr * 64 + fr, col0 = u.pn * BM + wc * 32 + 8 * fq;
        asm volatile("" : "+v"(row0), "+v"(col0));
#pragma unroll
        for (int ai = 0; ai < 2; ++ai)
#pragma unroll
            for (int m = 0; m < 4; ++m) { const size_t r = (size_t)(row0 + ai * HALF + m * 16);
#pragma unroll
                for (int bj = 0; bj < 2; ++bj) { const int c = col0 + bj * HALF;
                    const u32x4 g = *(const u32x4*)(GS + r * ldg + c);
                    const f32x4 a0 = acc[ai][bj][m][0], a1 = acc[ai][bj][m][1];
                    u32x4 w; w.x = cvt_pk_bf16(a0[0] * bflo(g.x), a0[1] * bfhi(g.x)); w.y = cvt_pk_bf16(a0[2] * bflo(g.y), a0[3] * bfhi(g.y));
                    w.z = cvt_pk_bf16(a1[0] * bflo(g.z), a1[1] * bfhi(g.z)); w.w = cvt_pk_bf16(a1[2] * bflo(g.w), a1[3] * bfhi(g.w));
                    *(u32x4*)(O + r * DM + c) = w; } }
    }
};
struct EpiRes {
    static constexpr bool PERM = false, AFTER_DRAIN = false, MID = false;
    const float* base; float* out; const float* gate;
    __device__ __forceinline__ void operator()(const f32x4 (&acc)[2][2][4][2], const Unit& u, int wr, int wc, int fr, int fq) const {
        const int row0 = u.pm * BM + wr * 64 + fr, col0 = u.pn * BM + wc * 32 + 4 * fq;
        const float* gp = gate + (size_t)(u.pm >> 4) * NMOD + col0;
        f32x4 gv[2][2];
#pragma unroll
        for (int bj = 0; bj < 2; ++bj)
#pragma unroll
            for (int n = 0; n < 2; ++n) gv[bj][n] = *(const f32x4*)(gp + bj * HALF + n * 16);
#pragma unroll
        for (int ai = 0; ai < 2; ++ai)
#pragma unroll
            for (int m = 0; m < 4; ++m) { const size_t off = (size_t)(row0 + ai * HALF + m * 16) * DM + col0;
#pragma unroll
                for (int bj = 0; bj < 2; ++bj)
#pragma unroll
                    for (int n = 0; n < 2; ++n) { const f32x4 b = *(const f32x4*)(base + off + bj * HALF + n * 16);
                        *(f32x4*)(out + off + bj * HALF + n * 16) = b + gv[bj][n] * acc[ai][bj][m][n]; } }
    }
};
struct EpiResToBf16 {
    static constexpr bool PERM = true, AFTER_DRAIN = false, MID = false;
    const float* base; bf16_t* XN; const float* gate;
    __device__ __forceinline__ void operator()(const f32x4 (&acc)[2][2][4][2], const Unit& u, int wr, int wc, int fr, int fq) const {
        const int row0 = u.pm * BM + wr * 64 + fr, col0 = u.pn * BM + wc * 32 + 8 * fq;
        const float* gp = gate + (size_t)(u.pm >> 4) * NMOD + col0;
        f32x4 gv[2][2];
#pragma unroll
        for (int bj = 0; bj < 2; ++bj)
#pragma unroll
            for (int n = 0; n < 2; ++n) gv[bj][n] = *(const f32x4*)(gp + bj * HALF + 4 * n);
#pragma unroll
        for (int ai = 0; ai < 2; ++ai)
#pragma unroll
            for (int m = 0; m < 4; ++m) { const size_t off = (size_t)(row0 + ai * HALF + m * 16) * DM + col0;
#pragma unroll
                for (int bj = 0; bj < 2; ++bj) { const f32x4 b0 = __builtin_nontemporal_load((const f32x4*)(base + off + bj * HALF)), b1 = __builtin_nontemporal_load((const f32x4*)(base + off + bj * HALF + 4));
                    const f32x4 v0 = b0 + gv[bj][0] * acc[ai][bj][m][0], v1 = b1 + gv[bj][1] * acc[ai][bj][m][1];
                    u32x4 w; w.x = cvt_pk_bf16(v0[0], v0[1]); w.y = cvt_pk_bf16(v0[2], v0[3]); w.z = cvt_pk_bf16(v1[0], v1[1]); w.w = cvt_pk_bf16(v1[2], v1[3]);
                    *(u32x4*)(XN + off + bj * HALF) = w; } }
    }
};
struct EpiResFromBf16 {
    static constexpr bool PERM = false, AFTER_DRAIN = false, MID = false;
    const bf16_t* XN; float* out; const float* gate;
    __device__ __forceinline__ void operator()(const f32x4 (&acc)[2][2][4][2], const Unit& u, int wr, int wc, int fr, int fq) const {
        const int row0 = u.pm * BM + wr * 64 + fr, col0 = u.pn * BM + wc * 32 + 4 * fq;
        const float* gp = gate + (size_t)(u.pm >> 4) * NMOD + col0;
        f32x4 gv[2][2];
#pragma unroll
        for (int bj = 0; bj < 2; ++bj)
#pragma unroll
            for (int n = 0; n < 2; ++n) gv[bj][n] = *(const f32x4*)(gp + bj * HALF + n * 16);
#pragma unroll
        for (int ai = 0; ai < 2; ++ai)
#pragma unroll
            for (int m = 0; m < 4; ++m) { const size_t off = (size_t)(row0 + ai * HALF + m * 16) * DM + col0;
#pragma unroll
                for (int bj = 0; bj < 2; ++bj)
#pragma unroll
                    for (int n = 0; n < 2; ++n) { const u32x2 xb = *(const u32x2*)(XN + off + bj * HALF + n * 16);
                        const f32x4 b = (f32x4){bflo(xb.x), bfhi(xb.x), bflo(xb.y), bfhi(xb.y)};
                        *(f32x4*)(out + off + bj * HALF + n * 16) = b + gv[bj][n] * acc[ai][bj][m][n]; } }
    }
};
struct EpiFfnIn {
    static constexpr bool PERM = true, AFTER_DRAIN = false, MID = false;
    bf16_t* O;
    __device__ __forceinline__ void operator()(const f32x4 (&acc)[2][2][4][2], const Unit& u, int wr, int wc, int fr, int fq) const {
        const int row0 = u.pm * BM + wr * 64 + fr, col0 = u.pn * HALF + wc * 32 + 8 * fq;
#pragma unroll
        for (int ai = 0; ai < 2; ++ai)
#pragma unroll
            for (int m = 0; m < 4; ++m) { bf16_t* rowp = O + (size_t)(row0 + ai * HALF + m * 16) * DFF + col0;
                float o[8];
#pragma unroll
                for (int n = 0; n < 2; ++n)
#pragma unroll
                    for (int j = 0; j < 4; ++j) { const float a = acc[ai][0][m][n][j], b = acc[ai][1][m][n][j]; o[n * 4 + j] = a * sigm(a) * b; }
                u32x4 w; w.x = cvt_pk_bf16(o[0], o[1]); w.y = cvt_pk_bf16(o[2], o[3]); w.z = cvt_pk_bf16(o[4], o[5]); w.w = cvt_pk_bf16(o[6], o[7]);
                *(u32x4*)rowp = w; }
    }
};

template <class Epi, class Sched, bool ALIGN_EPI = true, bool SP2 = true>
__device__ __forceinline__ void gemm_phase(PG8_LAS unsigned char* lds, const Gemm g, const Sched& S, const Epi& E) {
    const int tid = threadIdx.x, wid = __builtin_amdgcn_readfirstlane(tid >> 6), lane = tid & 63, wr = wid >> 2, wc = wid & 3, fr = lane & 15, fq = lane >> 4;
    const int K = g.K, nt = K / BK;
    unsigned voffA[2], voffB[2];
#pragma unroll
    for (int i = 0; i < 2; ++i) { int R, C; stage_rc(tid * 16 + i * 8192, R, C); const int Rb = Epi::PERM ? ((R & ~31) + perm32(R & 31)) : R;
        voffA[i] = (unsigned)(R * g.lda + C) * 2u; voffB[i] = (unsigned)(Rb * g.ldb + C) * 2u; }
    const size_t kstep = (size_t)(BK * 2);
    const size_t hstepA = (size_t)HALF * g.lda * 2, hstepB = (size_t)HALF * g.ldb * 2;
    const size_t tstepA = 2 * hstepA, tstepB = 2 * hstepB;
    const unsigned ldsw = (unsigned)wid * 1024u;
    const int aoff = lds_byte(wr * 64 + fr, fq * 8), boff = lds_byte(wc * 32 + fr, fq * 8);
#define PG8_SA(b, h) (((b) * 2 + (h)) * HTB)
#define PG8_SB(b, h) ((4 + (b) * 2 + (h)) * HTB)
#define PG8_STAGE(bufoff, gbase, voff) do { _Pragma("unroll") for (int _i = 0; _i < 2; ++_i) \
        __builtin_amdgcn_global_load_lds((const unsigned*)((const char*)(gbase) + (voff)[_i]), (PG8_LAS unsigned*)(lds + (bufoff) + ldsw + _i * 8192), 16, 0, 0); } while (0)
#define PG8_LDA(dst, b, h) do { _Pragma("unroll") for (int m = 0; m < 4; ++m) _Pragma("unroll") for (int k = 0; k < 2; ++k) dst[m][k] = *(const PG8_LAS bf16x8*)(lds + PG8_SA(b, h) + aoff + m * 2048 + k * 1024); } while (0)
#define PG8_LDB(dst, b, h) do { _Pragma("unroll") for (int n = 0; n < 2; ++n) _Pragma("unroll") for (int k = 0; k < 2; ++k) dst[n][k] = *(const PG8_LAS bf16x8*)(lds + PG8_SB(b, h) + boff + n * 2048 + k * 1024); } while (0)
#define PG8_MMA(ai, bj, At, Bt) do { __builtin_amdgcn_s_setprio(1); _Pragma("unroll") for (int m = 0; m < 4; ++m) _Pragma("unroll") for (int n = 0; n < 2; ++n) _Pragma("unroll") for (int k = 0; k < 2; ++k) \
        acc[ai][bj][m][n] = __builtin_amdgcn_mfma_f32_16x16x32_bf16(Bt[n][k], At[m][k], acc[ai][bj][m][n], 0, 0, 0); __builtin_amdgcn_s_setprio(0); } while (0)
#define PG8_WAIT_V(n) asm volatile("s_waitcnt vmcnt(" #n ")" ::: "memory")
#define PG8_WAIT_L(n) asm volatile("s_waitcnt lgkmcnt(" #n ")" ::: "memory")
#define PG8_BAR __builtin_amdgcn_s_barrier()
#define PG8_SCHED __builtin_amdgcn_sched_barrier(0)
    Unit cur, nxt; int ui = 0;
    if (!S.next(0, cur)) return;
    f32x4 acc[2][2][4][2];
#pragma unroll
    for (int a = 0; a < 2; ++a)
#pragma unroll
        for (int b = 0; b < 2; ++b)
#pragma unroll
            for (int m = 0; m < 4; ++m)
#pragma unroll
                for (int n = 0; n < 2; ++n) acc[a][b][m][n] = (f32x4){0.f, 0.f, 0.f, 0.f};
    bf16x8 At[4][2], B0[2][2], B1[2][2];
    const char* cA = (const char*)g.A + (size_t)cur.pm * tstepA; const char* cB = (const char*)g.Bt + (size_t)cur.pn * tstepB;
    S.a_ready(cur);
    if constexpr (SP2) {
        PG8_STAGE(PG8_SB(0, 0), cB, voffB); PG8_STAGE(PG8_SB(0, 1), cB + hstepB, voffB); PG8_STAGE(PG8_SA(0, 0), cA, voffA); PG8_STAGE(PG8_SA(0, 1), cA + hstepA, voffA);
        if (wr == 1) PG8_BAR;
        PG8_WAIT_V(2); PG8_BAR;
        PG8_STAGE(PG8_SB(1, 0), cB + kstep, voffB); PG8_STAGE(PG8_SA(1, 0), cA + kstep, voffA); PG8_STAGE(PG8_SB(1, 1), cB + hstepB + kstep, voffB);
        PG8_WAIT_V(6); PG8_BAR;
    } else {
        PG8_STAGE(PG8_SB(0, 0), cB, voffB); PG8_STAGE(PG8_SA(0, 0), cA, voffA); PG8_STAGE(PG8_SB(0, 1), cB + hstepB, voffB); PG8_STAGE(PG8_SA(0, 1), cA + hstepA, voffA);
        if (wr == 1) PG8_BAR;
        PG8_WAIT_V(4); PG8_BAR;
        PG8_STAGE(PG8_SB(1, 0), cB + kstep, voffB); PG8_STAGE(PG8_SA(1, 0), cA + kstep, voffA); PG8_STAGE(PG8_SB(1, 1), cB + hstepB + kstep, voffB);
        PG8_WAIT_V(6); PG8_BAR;
    }
    for (;;) {
        const bool has_next = S.next(ui + 1, nxt);
        const char* nA = has_next ? (const char*)g.A + (size_t)nxt.pm * tstepA : cA; const char* nB = has_next ? (const char*)g.Bt + (size_t)nxt.pn * tstepB : cB;
        for (int t = 0; t < nt; t += 2) {
            const bool last = (t == nt - 2);
            const char* a1 = cA + (size_t)(t + 1) * kstep;
            const char* a2 = last ? nA : cA + (size_t)(t + 2) * kstep; const char* b2 = last ? nB : cB + (size_t)(t + 2) * kstep;
            const char* a3 = a2 + kstep; const char* b3 = b2 + kstep;
            if constexpr (Epi::MID) { if (t == nt / 2) { PG8_SCHED; E.mid(acc, cur, wr, wc, fr, fq); PG8_SCHED; } }
            if (last && has_next) S.a_ready(nxt);
            if constexpr (SP2) {
            PG8_LDB(B0, 0, 0); PG8_LDB(B1, 0, 1); PG8_SCHED; PG8_LDA(At, 0, 0); PG8_STAGE(PG8_SA(1, 1), a1 + hstepA, voffA);
            PG8_WAIT_V(8); PG8_WAIT_L(0); PG8_BAR; PG8_MMA(0, 0, At, B0); PG8_MMA(0, 1, At, B1); PG8_BAR; PG8_SCHED;
            PG8_LDA(At, 0, 1); PG8_STAGE(PG8_SB(0, 0), b2, voffB); PG8_STAGE(PG8_SB(0, 1), b2 + hstepB, voffB); PG8_STAGE(PG8_SA(0, 0), a2, voffA);
            PG8_WAIT_V(8); PG8_WAIT_L(0); PG8_BAR; PG8_MMA(1, 0, At, B0); PG8_MMA(1, 1, At, B1); PG8_BAR; PG8_SCHED;
            PG8_LDB(B0, 1, 0); PG8_LDB(B1, 1, 1); PG8_SCHED; PG8_LDA(At, 1, 0); PG8_STAGE(PG8_SA(0, 1), a2 + hstepA, voffA);
            PG8_WAIT_V(8); PG8_WAIT_L(0); PG8_BAR; PG8_MMA(0, 0, At, B0); PG8_MMA(0, 1, At, B1); PG8_BAR; PG8_SCHED;
            PG8_LDA(At, 1, 1); PG8_STAGE(PG8_SB(1, 0), b3, voffB); PG8_STAGE(PG8_SB(1, 1), b3 + hstepB, voffB); PG8_STAGE(PG8_SA(1, 0), a3, voffA);
            PG8_WAIT_V(8); PG8_WAIT_L(0); PG8_BAR; PG8_MMA(1, 0, At, B0); PG8_MMA(1, 1, At, B1); PG8_BAR; PG8_SCHED;
            } else {
            PG8_LDB(B0, 0, 0); PG8_SCHED; PG8_LDA(At, 0, 0); PG8_STAGE(PG8_SA(1, 1), a1 + hstepA, voffA);
            PG8_WAIT_L(8); PG8_BAR; PG8_WAIT_L(0); PG8_MMA(0, 0, At, B0); PG8_BAR; PG8_SCHED;
            PG8_LDB(B1, 0, 1); PG8_STAGE(PG8_SB(0, 0), b2, voffB);
            PG8_BAR; PG8_WAIT_L(0); PG8_MMA(0, 1, At, B1); PG8_BAR;
            PG8_LDA(At, 0, 1); PG8_STAGE(PG8_SA(0, 0), a2, voffA);
            PG8_BAR; PG8_WAIT_L(0); PG8_MMA(1, 0, At, B0); PG8_BAR; PG8_SCHED;
            PG8_STAGE(PG8_SB(0, 1), b2 + hstepB, voffB);
            PG8_WAIT_V(6); PG8_BAR; PG8_MMA(1, 1, At, B1); PG8_BAR;
            PG8_LDB(B0, 1, 0); PG8_SCHED; PG8_LDA(At, 1, 0); PG8_STAGE(PG8_SA(0, 1), a2 + hstepA, voffA);
            PG8_WAIT_L(8); PG8_BAR; PG8_WAIT_L(0); PG8_MMA(0, 0, At, B0); PG8_BAR; PG8_SCHED;
            PG8_LDB(B1, 1, 1); PG8_STAGE(PG8_SB(1, 0), b3, voffB);
            PG8_BAR; PG8_WAIT_L(0); PG8_MMA(0, 1, At, B1); PG8_BAR;
            PG8_LDA(At, 1, 1); PG8_STAGE(PG8_SA(1, 0), a3, voffA);
            PG8_BAR; PG8_WAIT_L(0); PG8_MMA(1, 0, At, B0); PG8_BAR; PG8_SCHED;
            PG8_STAGE(PG8_SB(1, 1), b3 + hstepB, voffB);
            PG8_WAIT_V(6); PG8_BAR; PG8_MMA(1, 1, At, B1); PG8_BAR;
            }
        }
        if constexpr (ALIGN_EPI) { if (wr == 0) PG8_BAR; }
        if constexpr (!Epi::AFTER_DRAIN) { E(acc, cur, wr, wc, fr, fq); S.done(cur); }
        if (!has_next) break;
#pragma unroll
        for (int a = 0; a < 2; ++a)
#pragma unroll
            for (int b = 0; b < 2; ++b)
#pragma unroll
                for (int m = 0; m < 4; ++m)
#pragma unroll
                    for (int n = 0; n < 2; ++n) acc[a][b][m][n] = (f32x4){0.f, 0.f, 0.f, 0.f};
        cur = nxt; cA = nA; cB = nB; ++ui;
        if constexpr (ALIGN_EPI) { if (wr == 1) PG8_BAR; }
    }
    PG8_WAIT_V(0);
    if constexpr (!ALIGN_EPI) { if (wr == 0) PG8_BAR; }
    PG8_BAR;
#undef PG8_SA
#undef PG8_SB
#undef PG8_STAGE
#undef PG8_LDA
#undef PG8_LDB
#undef PG8_MMA
#undef PG8_WAIT_V
#undef PG8_WAIT_L
#undef PG8_BAR
#undef PG8_SCHED
}
}

namespace att {
constexpr int NW = 8, QBLK = 32, KVBLK = 64;
constexpr float SCALE = 0.07216878364870323f;
constexpr float THR = 8.f;
constexpr size_t SHM_V = KVBLK * VD * 2, SHM_K = KVBLK * QKD * 2;
constexpr size_t SHM_ATTN = 2 * SHM_V + 2 * SHM_K + NW * 64 * 4;
#define KSWZ(row, colB) ((row) * 384 + ((colB) ^ (((row) & 7) << 4)))
#define SBAR() __builtin_amdgcn_sched_barrier(0)
__device__ __forceinline__ int crow(int r, int hi) { return (r & 3) + 8 * (r >> 2) + 4 * hi; }
__device__ __forceinline__ unsigned cvtpk(float lo, float hi) { unsigned r; asm volatile("v_cvt_pk_bf16_f32 %0, %1, %2" : "=v"(r) : "v"(lo), "v"(hi)); return r; }

__device__ __forceinline__ void partialSM(f32x16& p0, f32x16& p1, float& m_reg, float& mn, float& alpha) {
  constexpr float C = SCALE * 1.4426950408889634f;
  float pmax = p0[0];
#pragma unroll
  for (int r = 1; r < 16; ++r) pmax = fmaxf(pmax, p0[r]);
#pragma unroll
  for (int r = 0; r < 16; ++r) pmax = fmaxf(pmax, p1[r]);
  { auto rr = __builtin_amdgcn_permlane32_swap(__float_as_uint(pmax), __float_as_uint(pmax), false, false);
    pmax = fmaxf(__uint_as_float(rr[0]), __uint_as_float(rr[1])); }
  if (__builtin_expect(__all(pmax - m_reg <= THR / SCALE), 1)) { mn = m_reg; alpha = 1.f; }
  else { mn = fmaxf(m_reg, pmax); alpha = __builtin_amdgcn_exp2f((m_reg - mn) * C); m_reg = mn; }
  float mnC = -mn * C;
#pragma unroll
  for (int r = 0; r < 16; ++r) p0[r] = fmaf(p0[r], C, mnC);
#pragma unroll
  for (int r = 0; r < 16; ++r) p1[r] = fmaf(p1[r], C, mnC);
#pragma unroll
  for (int r = 0; r < 16; ++r) p0[r] = __builtin_amdgcn_exp2f(p0[r]);
}
__device__ __forceinline__ void finishSM(f32x16& p0, f32x16& p1, float alpha, float& l_reg, bf16x8& pa0, bf16x8& pa1, bf16x8& pa2, bf16x8& pa3) {
#pragma unroll
  for (int r = 0; r < 16; ++r) p1[r] = __builtin_amdgcn_exp2f(p1[r]);
  float ps = 0;
#pragma unroll
  for (int r = 0; r < 16; ++r) ps += p0[r];
#pragma unroll
  for (int r = 0; r < 16; ++r) ps += p1[r];
  { auto rr = __builtin_amdgcn_permlane32_swap(__float_as_uint(ps), __float_as_uint(ps), false, false);
    ps = __uint_as_float(rr[0]) + __uint_as_float(rr[1]); }
  l_reg = l_reg * alpha + ps;
#define PK4(P, BASE, OUT) do { unsigned a0 = cvtpk(P[BASE + 0], P[BASE + 1]), a1 = cvtpk(P[BASE + 2], P[BASE + 3]);   \
    unsigned b0 = cvtpk(P[BASE + 4], P[BASE + 5]), b1 = cvtpk(P[BASE + 6], P[BASE + 7]);                              \
    auto r0 = __builtin_amdgcn_permlane32_swap(a0, b0, false, false); auto r1 = __builtin_amdgcn_permlane32_swap(a1, b1, false, false); \
    u32x4 w = {r0[0], r1[0], r0[1], r1[1]}; OUT = *reinterpret_cast<bf16x8*>(&w); } while (0)
  PK4(p0, 0, pa0); PK4(p0, 8, pa1); PK4(p1, 0, pa2); PK4(p1, 8, pa3);
#undef PK4
}
__device__ __forceinline__ void qkt(f32x16& p0, f32x16& p1, const char* Ks, const bf16x8* qr, int r32, int hi) {
  p0 = f32x16{}; p1 = f32x16{};
  int rsw = ((r32 >> 1) & 7) << 4; asm volatile("" : "+v"(rsw));
  const char* Kr = Ks + r32 * 384;
#pragma unroll
  for (int d0 = 0; d0 < 12; ++d0) { int cb = (d0 * 16 + hi * 8) * 2;
    bf16x8 b0 = *reinterpret_cast<const bf16x8*>(Kr + (cb ^ rsw));
    bf16x8 b1 = *reinterpret_cast<const bf16x8*>(Kr + 32 * 384 + (cb ^ rsw));
    p0 = __builtin_amdgcn_mfma_f32_32x32x16_bf16(b0, qr[d0], p0, 0, 0, 0);
    p1 = __builtin_amdgcn_mfma_f32_32x32x16_bf16(b1, qr[d0], p1, 0, 0, 0); }
}
#define QKF_PK4(P, BASE, OUT) do { unsigned a0_ = cvtpk(P[BASE + 0], P[BASE + 1]), a1_ = cvtpk(P[BASE + 2], P[BASE + 3]);   \
    unsigned b0_ = cvtpk(P[BASE + 4], P[BASE + 5]), b1_ = cvtpk(P[BASE + 6], P[BASE + 7]);                              \
    auto r0_ = __builtin_amdgcn_permlane32_swap(a0_, b0_, false, false); auto r1_ = __builtin_amdgcn_permlane32_swap(a1_, b1_, false, false); \
    u32x4 w_ = {r0_[0], r1_[0], r0_[1], r1_[1]}; OUT = *reinterpret_cast<bf16x8*>(&w_); } while (0)
__device__ __forceinline__ void qk_fsm(f32x16& x0, f32x16& x1, const char* Ks, const bf16x8* qr, int r32, int hi,
                                       f32x16& y0, f32x16& y1, float alpha, float& l_reg, bf16x8& pa0, bf16x8& pa1, bf16x8& pa2, bf16x8& pa3) {
  x0 = f32x16{}; x1 = f32x16{};
  int rsw = ((r32 >> 1) & 7) << 4; asm volatile("" : "+v"(rsw));
  const char* Kr = Ks + r32 * 384;
#define QKF_RD(D0, B0, B1) do { const int cb_ = ((D0) * 16 + hi * 8) * 2; B0 = *reinterpret_cast<const bf16x8*>(Kr + (cb_ ^ rsw)); B1 = *reinterpret_cast<const bf16x8*>(Kr + 32 * 384 + (cb_ ^ rsw)); } while (0)
#define QKF_MM(D0, B0, B1) do { x0 = __builtin_amdgcn_mfma_f32_32x32x16_bf16(B0, qr[D0], x0, 0, 0, 0); x1 = __builtin_amdgcn_mfma_f32_32x32x16_bf16(B1, qr[D0], x1, 0, 0, 0); } while (0)
#define QKF_EXP(K) do { y1[2 * (K)] = __builtin_amdgcn_exp2f(y1[2 * (K)]); y1[2 * (K) + 1] = __builtin_amdgcn_exp2f(y1[2 * (K) + 1]); ps += y0[2 * (K)] + y0[2 * (K) + 1]; \
    if ((K) >= 1) ps += y1[2 * (K) - 2] + y1[2 * (K) - 1]; } while (0)
  bf16x8 a0, a1, b0, b1; float ps = 0.f;
  QKF_RD(0, a0, a1);
  QKF_RD(1, b0, b1);  QKF_MM(0, a0, a1);  QKF_EXP(0); SBAR();
  QKF_RD(2, a0, a1);  QKF_MM(1, b0, b1);  QKF_EXP(1); SBAR();
  QKF_RD(3, b0, b1);  QKF_MM(2, a0, a1);  QKF_EXP(2); SBAR();
  QKF_RD(4, a0, a1);  QKF_MM(3, b0, b1);  QKF_EXP(3); SBAR();
  QKF_RD(5, b0, b1);  QKF_MM(4, a0, a1);  QKF_EXP(4); SBAR();
  QKF_RD(6, a0, a1);  QKF_MM(5, b0, b1);  QKF_EXP(5); SBAR();
  QKF_RD(7, b0, b1);  QKF_MM(6, a0, a1);  QKF_EXP(6); SBAR();
  QKF_RD(8, a0, a1);  QKF_MM(7, b0, b1);  QKF_EXP(7); SBAR();
  QKF_RD(9, b0, b1);  QKF_MM(8, a0, a1);
  ps += y1[14] + y1[15];
  { auto rr = __builtin_amdgcn_permlane32_swap(__float_as_uint(ps), __float_as_uint(ps), false, false); ps = __uint_as_float(rr[0]) + __uint_as_float(rr[1]); }
  l_reg = l_reg * alpha + ps; QKF_PK4(y0, 0, pa0); SBAR();
  QKF_RD(10, a0, a1); QKF_MM(9, b0, b1);  QKF_PK4(y0, 8, pa1); SBAR();
  QKF_RD(11, b0, b1); QKF_MM(10, a0, a1); QKF_PK4(y1, 0, pa2); SBAR();
  QKF_MM(11, b0, b1); QKF_PK4(y1, 8, pa3);
#undef QKF_RD
#undef QKF_MM
#undef QKF_EXP
}
#undef QKF_PK4
__device__ __forceinline__ int v_st(int k, int c) { const int kk = (k & ~0xC) | ((k & 4) << 1) | ((k & 8) >> 1); return ((kk >> 3) * 4 + (c >> 5)) * 512 + ((kk & 7) * 32 + (c & 31)) * 2; }
__device__ __forceinline__ int v_rd_base(int lane) { return ((lane & 3) << 3) | (((lane >> 2) & 3) << 6) | (((lane >> 4) & 1) << 5) | (((lane >> 5) & 1) << 8); }
constexpr int v_rd_off(int d0, int ks, int half) { return d0 * 512 + ks * 4096 + half * 2048; }
template <int OFF> __device__ __forceinline__ s16x4 tr_read(int vb) {
  s16x4 r; asm volatile("ds_read_b64_tr_b16 %0, %1 offset:%2" : "=&v"(r) : "v"(vb), "i"(OFF) : "memory"); return r;
}
template <int KS> __device__ __forceinline__ void pv_step(f32x16* o, int vb, bf16x8 pa) {
  const s16x4 l0 = tr_read<v_rd_off(0, KS, 0)>(vb), h0 = tr_read<v_rd_off(0, KS, 1)>(vb), l1 = tr_read<v_rd_off(1, KS, 0)>(vb), h1 = tr_read<v_rd_off(1, KS, 1)>(vb);
  const s16x4 l2 = tr_read<v_rd_off(2, KS, 0)>(vb), h2 = tr_read<v_rd_off(2, KS, 1)>(vb), l3 = tr_read<v_rd_off(3, KS, 0)>(vb), h3 = tr_read<v_rd_off(3, KS, 1)>(vb);
  asm volatile("s_waitcnt lgkmcnt(0)" ::: "memory"); SBAR();
#define PK(L, H) (bf16x8){L[0], L[1], L[2], L[3], H[0], H[1], H[2], H[3]}
  o[0] = __builtin_amdgcn_mfma_f32_32x32x16_bf16(pa, PK(l0, h0), o[0], 0, 0, 0);
  o[1] = __builtin_amdgcn_mfma_f32_32x32x16_bf16(pa, PK(l1, h1), o[1], 0, 0, 0);
  o[2] = __builtin_amdgcn_mfma_f32_32x32x16_bf16(pa, PK(l2, h2), o[2], 0, 0, 0);
  o[3] = __builtin_amdgcn_mfma_f32_32x32x16_bf16(pa, PK(l3, h3), o[3], 0, 0, 0);
#undef PK
}
__device__ __forceinline__ void pv_d0(f32x16* o, int vb, bf16x8 pa0, bf16x8 pa1, bf16x8 pa2, bf16x8 pa3) {
  pv_step<0>(o, vb, pa0); pv_step<1>(o, vb, pa1); pv_step<2>(o, vb, pa2); pv_step<3>(o, vb, pa3);
}
#define PVS_READS(KS) const s16x4 l0_##KS = tr_read<v_rd_off(0, KS, 0)>(vb), h0_##KS = tr_read<v_rd_off(0, KS, 1)>(vb), l1_##KS = tr_read<v_rd_off(1, KS, 0)>(vb), h1_##KS = tr_read<v_rd_off(1, KS, 1)>(vb), \
    l2_##KS = tr_read<v_rd_off(2, KS, 0)>(vb), h2_##KS = tr_read<v_rd_off(2, KS, 1)>(vb), l3_##KS = tr_read<v_rd_off(3, KS, 0)>(vb), h3_##KS = tr_read<v_rd_off(3, KS, 1)>(vb)
#define PVS_PK(L, H) (bf16x8){L[0], L[1], L[2], L[3], H[0], H[1], H[2], H[3]}
#define PVS_MMA(KS, PA) do { asm volatile("s_waitcnt lgkmcnt(0)" ::: "memory"); SBAR(); \
    o[0] = __builtin_amdgcn_mfma_f32_32x32x16_bf16(PA, PVS_PK(l0_##KS, h0_##KS), o[0], 0, 0, 0); o[1] = __builtin_amdgcn_mfma_f32_32x32x16_bf16(PA, PVS_PK(l1_##KS, h1_##KS), o[1], 0, 0, 0); \
    o[2] = __builtin_amdgcn_mfma_f32_32x32x16_bf16(PA, PVS_PK(l2_##KS, h2_##KS), o[2], 0, 0, 0); o[3] = __builtin_amdgcn_mfma_f32_32x32x16_bf16(PA, PVS_PK(l3_##KS, h3_##KS), o[3], 0, 0, 0); SBAR(); } while (0)
__device__ __forceinline__ void pv_psm(f32x16* o, int vb, bf16x8 pa0, bf16x8 pa1, bf16x8 pa2, bf16x8 pa3, f32x16& p0, f32x16& p1, float& m_reg, float& mn, float& alpha) {
  constexpr float C = SCALE * 1.4426950408889634f;
  PVS_READS(0);
  PVS_MMA(0, pa0);
  PVS_READS(1);
  float pmax = p0[0];
#pragma unroll
  for (int r = 1; r < 16; ++r) pmax = fmaxf(pmax, p0[r]);
#pragma unroll
  for (int r = 0; r < 16; ++r) pmax = fmaxf(pmax, p1[r]);
  PVS_MMA(1, pa1);
  PVS_READS(2);
  { auto rr = __builtin_amdgcn_permlane32_swap(__float_as_uint(pmax), __float_as_uint(pmax), false, false);
    pmax = fmaxf(__uint_as_float(rr[0]), __uint_as_float(rr[1])); }
  if (__builtin_expect(__all(pmax - m_reg <= THR / SCALE), 1)) { mn = m_reg; alpha = 1.f; }
  else { mn = fmaxf(m_reg, pmax); alpha = __builtin_amdgcn_exp2f((m_reg - mn) * C); m_reg = mn; }
  const float mnC = -mn * C;
  PVS_MMA(2, pa2);
  PVS_READS(3);
#pragma unroll
  for (int r = 0; r < 16; ++r) p0[r] = fmaf(p0[r], C, mnC);
#pragma unroll
  for (int r = 0; r < 16; ++r) p1[r] = fmaf(p1[r], C, mnC);
  PVS_MMA(3, pa3);
#pragma unroll
  for (int r = 0; r < 16; ++r) p0[r] = __builtin_amdgcn_exp2f(p0[r]);
}
#undef PVS_READS
#undef PVS_PK
#undef PVS_MMA

constexpr size_t OFFTAB = 3 * SHM_V + 3 * SHM_K + NW * 64 * 4;
__device__ __forceinline__ void attn_offsets_init(char* lds) {
  const int tid = threadIdx.x; u32x4 r;
  { const int p = tid, row = p / 24, ch = p - row * 24; r.x = (unsigned)(row * 384 + ((ch ^ ((row >> 1) & 7)) << 4)); }
  { const int p = 512 + tid, row = p / 24, ch = p - row * 24; r.y = (unsigned)(row * 384 + ((ch ^ ((row >> 1) & 7)) << 4)); }
  { const int p = 1024 + tid, row = p / 24, ch = p - row * 24; r.z = (unsigned)(row * 384 + ((ch ^ ((row >> 1) & 7)) << 4)); }
  { const int p = tid, st = p >> 5, wi = p & 31, kk = (st >> 2) * 8 + (wi >> 2), c = (st & 3) * 32 + (wi & 3) * 8;
    const int k = (kk & ~0xC) | ((kk & 4) << 1) | ((kk & 8) >> 1); r.w = (unsigned)(k * 256 + c * 2); }
  *(reinterpret_cast<u32x4*>(lds + OFFTAB) + tid) = r;
  __syncthreads();
}
constexpr size_t RING_V = 0, RING_K = 3 * SHM_V, RING_END = 3 * SHM_V + 3 * SHM_K;
__device__ __forceinline__ void attn_unit(const bf16_t* __restrict__ Qb, const bf16_t* __restrict__ Kh, const bf16_t* __restrict__ Vh, bf16_t* __restrict__ Ob, char* lds, LAS unsigned char* ldsl) {
  const int tid = threadIdx.x, wid = tid >> 6, lane = tid & 63, r32 = lane & 31, hi = lane >> 5;
  char* V_lds = lds + RING_V; char* K_lds = lds + RING_K;
  float* wsf = (float*)(lds + RING_END) + wid * 64; float* li_l = wsf; float* al_l = wsf + 32;
  float m_reg = -1e30f, l_reg = 0; f32x16 o[4] = {}; bf16x8 qr[12];
  const bf16_t* Qw = Qb + (long)(wid * QBLK + r32) * QKD + hi * 8;
#pragma unroll
  for (int d0 = 0; d0 < 12; ++d0) qr[d0] = *reinterpret_cast<const bf16x8*>(Qw + d0 * 16);
  const int widu = __builtin_amdgcn_readfirstlane(wid);
  const int vb0 = (int)(uintptr_t)V_lds + v_rd_base(lane);
  const u32x4* offrec = reinterpret_cast<const u32x4*>(lds + OFFTAB) + tid;
#define DMA_K(tile, buf) do { const char* kg_ = (const char*)Kh + (size_t)(tile) * (KVBLK * QKD * 2); const u32x4 vo_ = *offrec; \
    __builtin_amdgcn_global_load_lds((const unsigned*)(kg_ + vo_.x), (LAS unsigned*)(ldsl + RING_K + (buf) * SHM_K + 0 * 8192 + widu * 1024), 16, 0, 0); \
    __builtin_amdgcn_global_load_lds((const unsigned*)(kg_ + vo_.y), (LAS unsigned*)(ldsl + RING_K + (buf) * SHM_K + 1 * 8192 + widu * 1024), 16, 0, 0); \
    __builtin_amdgcn_global_load_lds((const unsigned*)(kg_ + vo_.z), (LAS unsigned*)(ldsl + RING_K + (buf) * SHM_K + 2 * 8192 + widu * 1024), 16, 0, 0); } while (0)
#define DMA_V(tile, buf) do { const char* vg_ = (const char*)Vh + (size_t)(tile) * (KVBLK * VD * 2); const unsigned vo_ = (*offrec).w; \
    __builtin_amdgcn_global_load_lds((const unsigned*)(vg_ + vo_), (LAS unsigned*)(ldsl + RING_V + (buf) * SHM_V + 0 * 8192 + widu * 1024), 16, 0, 0); \
    __builtin_amdgcn_global_load_lds((const unsigned*)(vg_ + vo_ + 8192u), (LAS unsigned*)(ldsl + RING_V + (buf) * SHM_V + 1 * 8192 + widu * 1024), 16, 0, 0); } while (0)
#define RESC(a) do { if (__any((a) < 1.f)) { if (hi == 0) al_l[r32] = (a); asm volatile("s_waitcnt lgkmcnt(0)" ::: "memory"); \
    _Pragma("unroll") for (int d = 0; d < 4; ++d) _Pragma("unroll") for (int r = 0; r < 16; ++r) o[d][r] *= al_l[crow(r, hi)]; } } while (0)
#define TILE_BAR() do { asm volatile("s_waitcnt vmcnt(0)" ::: "memory"); __syncthreads(); } while (0)
  f32x16 pA0, pA1, pB0, pB1; float mnA, mnB, alA, alB; bf16x8 pa0, pa1, pa2, pa3; constexpr int NT = SKV / KVBLK;
  DMA_K(0, 0); DMA_K(1, 1); DMA_V(0, 0);
  TILE_BAR();
  DMA_K(2, 2); DMA_V(1, 1);
  qkt(pA0, pA1, K_lds, qr, r32, hi); partialSM(pA0, pA1, m_reg, mnA, alA);
  int b1 = 1, b0 = 0;
  for (int j = 1; j + 1 < NT; j += 2) {
    TILE_BAR();
    { const int b2 = (b1 == 2) ? 0 : b1 + 1;
      if (j + 2 < NT) DMA_K(j + 2, b0);
      DMA_V(j + 1, b2);
      SBAR(); qk_fsm(pB0, pB1, K_lds + b1 * SHM_K, qr, r32, hi, pA0, pA1, alA, l_reg, pa0, pa1, pa2, pa3); SBAR();
      pv_psm(o, vb0 + b0 * (int)SHM_V, pa0, pa1, pa2, pa3, pB0, pB1, m_reg, mnB, alB);
      RESC(alB);
      b0 = b1; b1 = b2; }
    TILE_BAR();
    { const int b2 = (b1 == 2) ? 0 : b1 + 1;
      if (j + 3 < NT) DMA_K(j + 3, b0);
      if (j + 2 < NT) DMA_V(j + 2, b2);
      SBAR(); qk_fsm(pA0, pA1, K_lds + b1 * SHM_K, qr, r32, hi, pB0, pB1, alB, l_reg, pa0, pa1, pa2, pa3); SBAR();
      pv_psm(o, vb0 + b0 * (int)SHM_V, pa0, pa1, pa2, pa3, pA0, pA1, m_reg, mnA, alA);
      RESC(alA);
      b0 = b1; b1 = b2; }
  }
  TILE_BAR();
  SBAR(); qk_fsm(pB0, pB1, K_lds + b1 * SHM_K, qr, r32, hi, pA0, pA1, alA, l_reg, pa0, pa1, pa2, pa3); SBAR();
  pv_psm(o, vb0 + b0 * (int)SHM_V, pa0, pa1, pa2, pa3, pB0, pB1, m_reg, mnB, alB);
  RESC(alB);
  finishSM(pB0, pB1, alB, l_reg, pa0, pa1, pa2, pa3); SBAR();
  pv_d0(o, vb0 + b1 * (int)SHM_V, pa0, pa1, pa2, pa3);
  if (hi == 0) li_l[r32] = l_reg; asm volatile("s_waitcnt lgkmcnt(0)" ::: "memory");
  float rli[16];
#pragma unroll
  for (int r = 0; r < 16; ++r) rli[r] = __builtin_amdgcn_rcpf(li_l[crow(r, hi)]);
  bf16_t* Ow = Ob + (long)(wid * QBLK) * DM;
#pragma unroll
  for (int r = 0; r < 16; ++r) { int orow = crow(r, hi);
#pragma unroll
    for (int d0 = 0; d0 < 4; ++d0) Ow[(long)orow * DM + d0 * 32 + r32] = (bf16_t)f2bf(o[d0][r] * rli[r]); }
  __syncthreads();
#undef DMA_K
#undef DMA_V
#undef RESC
#undef TILE_BAR
}
}


#define XB_TMO      128
#define XB_XCNT(j)  (256  + 64 * (j))
#define XB_XSUB(j)  (1280 + 64 * (j))
#define XB_XGEN(j)  (2304 + 64 * (j))
#define XB_TOP      3328
#define XB_TOPGEN   3392
#define XCD_BAR_WORDS 3456
#define XB_SPIN_CAP (1u << 18)
__device__ __forceinline__ unsigned xb_ld(unsigned* p)              { return __hip_atomic_load(p, __ATOMIC_RELAXED, __HIP_MEMORY_SCOPE_AGENT); }
__device__ __forceinline__ unsigned xb_add(unsigned* p, unsigned v) { return __hip_atomic_fetch_add(p, v, __ATOMIC_RELAXED, __HIP_MEMORY_SCOPE_AGENT); }
__device__ __forceinline__ unsigned xb_xcc_id() { return (unsigned)__builtin_amdgcn_s_getreg((3 << 11) | 20) & 0xFu; }
#define XB_SPIN(cond, bar) do { unsigned _sp = 0; while (cond) { __builtin_amdgcn_s_sleep(1); \
    if ((++_sp & 255u) == 0u) { if (xb_ld(&(bar)[XB_TMO])) break; if (_sp > XB_SPIN_CAP) { atomicAdd(&(bar)[XB_TMO], 1u); break; } } } } while (0)
struct XcdBarrier { unsigned* bar; unsigned x; volatile LAS unsigned* st; };
__device__ __forceinline__ XcdBarrier xcd_barrier_post(unsigned* bar, volatile LAS unsigned* st) {
    XcdBarrier b; b.bar = bar; b.x = xb_xcc_id(); b.st = st;
    if (threadIdx.x == 0) (void)xb_add(&bar[XB_XCNT(b.x)], 1u);
    return b;
}
__device__ __forceinline__ void xcd_barrier_complete(unsigned* bar, unsigned x, unsigned& nloc, unsigned& nx) {
    const unsigned G = gridDim.x * gridDim.y * gridDim.z;
    unsigned sum, cnt, mine, sp = 0u;
    for (;;) {
        sum = 0u; cnt = 0u; mine = 0u;
#pragma unroll
        for (unsigned j = 0; j < 16; ++j) { const unsigned c = xb_ld(&bar[XB_XCNT(j)]); sum += c; cnt += (c > 0u) ? 1u : 0u; mine = (j == x) ? c : mine; }
        if (sum == G) break;
        __builtin_amdgcn_s_sleep(1);
        if ((++sp & 255u) == 0u) { if (xb_ld(&bar[XB_TMO])) break; if (sp > XB_SPIN_CAP) { atomicAdd(&bar[XB_TMO], 1u); break; } }
    }
    nloc = mine > 0u ? mine : 1u; nx = cnt > 0u ? cnt : 1u;
}
__device__ __forceinline__ void xcd_barrier(const XcdBarrier& b) {
    asm volatile("s_waitcnt vmcnt(0)" ::: "memory");
    __syncthreads();
    if (threadIdx.x == 0) {
        unsigned* bar = b.bar;
        __builtin_amdgcn_s_waitcnt(0);
        unsigned nloc = b.st[0], nx = b.st[1];
        if (nloc == 0u) { xcd_barrier_complete(bar, b.x, nloc, nx); b.st[0] = nloc; b.st[1] = nx; }
        const unsigned old = xb_add(&bar[XB_XSUB(b.x)], 1u);
        const unsigned gen = old / nloc;
        if (old + 1u == (gen + 1u) * nloc) {
            __builtin_amdgcn_fence(__ATOMIC_RELEASE, "agent");
            asm volatile("s_waitcnt vmcnt(0)" ::: "memory");
            const unsigned og = xb_add(&bar[XB_TOP], 1u);
            const unsigned tg = og / nx;
            if (og + 1u == (tg + 1u) * nx) xb_add(&bar[XB_TOPGEN], 1u);
            else XB_SPIN(xb_ld(&bar[XB_TOPGEN]) == tg, bar);
            __builtin_amdgcn_fence(__ATOMIC_ACQUIRE, "agent");
            xb_add(&bar[XB_XGEN(b.x)], 1u);
            asm volatile("s_waitcnt vmcnt(0)" ::: "memory");
        } else {
            XB_SPIN(xb_ld(&bar[XB_XGEN(b.x)]) == gen, bar);
            __builtin_amdgcn_fence(__ATOMIC_ACQUIRE, "agent");
            asm volatile("s_waitcnt vmcnt(0)" ::: "memory");
        }
    }
    __syncthreads();
}

struct Args { const float* in[24]; float* out; unsigned char* ws; int ph_lo, ph_hi; };

template <int MODE> __device__ __forceinline__ int src_col(int n) {
    if (MODE == 1) return n < 832 ? n : (n < 1024 ? -1 : n - 192);
    if (MODE == 2) { const int pn = n >> 8, j = n & 255; return j < 128 ? pn * 128 + j : DFF + pn * 128 + (j - 128); }
    if (MODE == 3) return n < 1024 ? (n >> 7) * 192 + (n & 127) : ((n - 1024) >> 6) * 192 + 128 + ((n - 1024) & 63);
    return n;
}
template <int MODE> __device__ __forceinline__ void tr_item(const float* __restrict__ W, int ldw, int k0, int n0, bf16_t* __restrict__ WT, int ldt, const float* __restrict__ gk, LAS float* scr, int lane) {
    const int sc = src_col<MODE>(n0 + (lane & 31) * 4);
    f32x4 vv[16];
#pragma unroll
    for (int i = 0; i < 16; ++i) { const int kk = 2 * i + (lane >> 5); vv[i] = (f32x4){0.f, 0.f, 0.f, 0.f};
        if (sc >= 0) { vv[i] = *(const f32x4*)(W + (size_t)(k0 + kk) * ldw + sc); } }
#pragma unroll
    for (int i = 0; i < 16; ++i) { const int kk = 2 * i + (lane >> 5); f32x4 v = vv[i]; if (gk) v = v * gk[k0 + kk];
        LAS float* d = scr + kk * 129 + (lane & 31) * 4; d[0] = v.x; d[1] = v.y; d[2] = v.z; d[3] = v.w; }
    LDS_WAIT();
    const int c = lane & 3;
#pragma unroll
    for (int j = 0; j < 8; ++j) { const int n = (lane >> 2) + 16 * j; const LAS float* sp = scr + (8 * c) * 129 + n;
        u32x4 o; o.x = pk2(sp[0 * 129], sp[1 * 129]); o.y = pk2(sp[2 * 129], sp[3 * 129]); o.z = pk2(sp[4 * 129], sp[5 * 129]); o.w = pk2(sp[6 * 129], sp[7 * 129]);
        *(u32x4*)(WT + (size_t)(n0 + n) * ldt + k0 + 8 * c) = o; }
    LDS_WAIT();
}

__global__ void __launch_bounds__(512, 2) fwd_kernel(Args args) {
    extern __shared__ __attribute__((aligned(16))) unsigned char lds[];
    const int tid = threadIdx.x, lane = tid & 63, wave = __builtin_amdgcn_readfirstlane(tid >> 6);
    const int G = gridDim.x, bx = blockIdx.x;
    const int vcu = (G % 8 == 0) ? (bx % 8) * (G / 8) + bx / 8 : bx;
    const int gw = vcu * 8 + wave, NGW = G * 8;
    unsigned char* ws = args.ws;
    const float* x = args.in[0]; const float* cvec = args.in[1]; const float* ctx = args.in[2]; const float* c_ctx = args.in[3];
    const float* w_mod = args.in[4]; const float* b_mod = args.in[5]; const float* norm1_g = args.in[6]; const float* w_in = args.in[7];
    const float* q_norm_g = args.in[8]; const float* kv_norm_g = args.in[9]; const float* w_uq = args.in[10]; const float* w_ukv = args.in[11];
    const float* qk_norm_q = args.in[12]; const float* qk_norm_k = args.in[13]; const float* sgu_norm_g = args.in[14]; const float* sgu_norm_b = args.in[15];
    const float* w_spatial = args.in[16]; const float* b_spatial = args.in[17]; const float* w_br_attn = args.in[18]; const float* w_br_sgu = args.in[19];
    const float* w_out = args.in[20]; const float* norm2_g = args.in[21]; const float* w_ffn_in = args.in[22]; const float* w_ffn_out = args.in[23];
    float* out = args.out;
    float* MOD = (float*)(ws + WS_MOD);
    bf16_t* WIN = (bf16_t*)(ws + WS_WIN); bf16_t* WUQ = (bf16_t*)(ws + WS_WUQ); bf16_t* WUKV = (bf16_t*)(ws + WS_WUKV);
    bf16_t* WBR = (bf16_t*)(ws + WS_WBRA); bf16_t* WOUT = (bf16_t*)(ws + WS_WOUT);
    bf16_t* WFI = (bf16_t*)(ws + WS_WFI); bf16_t* WFO = (bf16_t*)(ws + WS_WFO); bf16_t* WSP = (bf16_t*)(ws + WS_WSP);
    bf16_t* H = (bf16_t*)(ws + WS_H); bf16_t* KVUP = H; bf16_t* AO = H; bf16_t* H2 = H;
    bf16_t* P = (bf16_t*)(ws + WS_P); bf16_t* XN = P; bf16_t* ACT = (bf16_t*)(ws + WS_P + 64 * MiB);
    bf16_t* KF = (bf16_t*)(ws + WS_KF); bf16_t* VF = (bf16_t*)(ws + WS_VF); bf16_t* MERGED = (bf16_t*)(ws + WS_MERGED);
    bf16_t* QUP = (bf16_t*)out; bf16_t* QF = (bf16_t*)((unsigned char*)out + DO_QF);
    const int lo = args.ph_lo, hi = args.ph_hi;
#ifndef PH_MASK
#define PH_MASK 0x7ff
#endif
#define IN(k) ((((PH_MASK) >> (k)) & 1) && lo <= (k) && (k) < hi)
#ifndef PROBE_DUP
#define PROBE_DUP 0
#endif
#define REPS(k) ((((PROBE_DUP) >> (k)) & 1) ? 2 : 1)
#ifdef PROBE_SPIN
    unsigned long long pt0_ = 0;
#define PH_START(k) do { if ((k) == PROBE_SPIN) pt0_ = __builtin_amdgcn_s_memrealtime(); } while (0)
#define PH_END(k) do { if ((k) == PROBE_SPIN) { const unsigned long long t1_ = __builtin_amdgcn_s_memrealtime(), d_ = 4 * (t1_ - pt0_); while (__builtin_amdgcn_s_memrealtime() - t1_ < d_) __builtin_amdgcn_s_sleep(8); } } while (0)
#else
#define PH_START(k) do {} while (0)
#define PH_END(k) do {} while (0)
#endif
#if !MK_LAUNCH_PER_PHASE && !defined(PROBE_SPLIT) && !defined(MK_CG_SYNC)
    volatile LAS unsigned* barst = (volatile LAS unsigned*)((LAS unsigned char*)lds + LDS_BARST);
    if (tid < 2) barst[tid] = 0u;
    __syncthreads();
    const XcdBarrier gbar = xcd_barrier_post((unsigned*)(ws + WS_BAR), barst);
    if (args.ph_lo < 0) cg::this_grid().sync();
#define SEAM(k) do { PH_END(k); if (IN(k) && IN((k) + 1)) { xcd_barrier(gbar); } } while (0)
#else
#define SEAM(k) do { PH_END(k); if (IN(k) && IN((k) + 1)) { cg::this_grid().sync(); } } while (0)
#endif

    if (IN(0)) for (int rep_ = 0; rep_ < REPS(0); ++rep_) { if (rep_) cg::this_grid().sync(); PH_START(0);
        LAS float* sact = (LAS float*)lds;
        LAS float* red = (LAS float*)(lds + 40960);
        for (int i = tid; i < 5 * DM; i += 512) { const float v = (i < 4 * DM) ? cvec[i] : c_ctx[i - 4 * DM]; sact[i] = v / (1.0f + __expf(-v)); }
        __syncthreads();
        for (int cb = bx; cb < NMOD / 48; cb += G) {
            const int n0 = cb * 48, c4 = tid % 12, kg = tid / 12;
            if (kg < 42) {
                f32x4 a[5];
#pragma unroll
                for (int r = 0; r < 5; ++r) a[r] = (f32x4){0.f, 0.f, 0.f, 0.f};
                for (int k0 = kg; k0 < DM; k0 += 42 * 7) {
                    f32x4 w[7];
#pragma unroll
                    for (int u = 0; u < 7; ++u) { const int k = k0 + 42 * u; w[u] = (k < DM) ? *(const f32x4*)(w_mod + (size_t)k * NMOD + n0 + c4 * 4) : (f32x4){0.f, 0.f, 0.f, 0.f}; }
#pragma unroll
                    for (int u = 0; u < 7; ++u) { const int k = (k0 + 42 * u < DM) ? k0 + 42 * u : 0;
#pragma unroll
                        for (int r = 0; r < 5; ++r) a[r] += w[u] * sact[r * DM + k]; } }
#pragma unroll
                for (int r = 0; r < 5; ++r)
#pragma unroll
                    for (int j = 0; j < 4; ++j) red[(kg * 5 + r) * 48 + c4 * 4 + j] = a[r][j];
            }
            __syncthreads();
            if (tid < 240) { const int r = tid / 48, col = tid % 48; float s = 0.f;
                for (int k2 = 0; k2 < 42; ++k2) s += red[(k2 * 5 + r) * 48 + col];
                MOD[(size_t)r * NMOD + n0 + col] = s + b_mod[n0 + col]; }
            __syncthreads();
        }
        LAS float* scr = (LAS float*)(lds + wave * 16512);
        constexpr int I_IN = 64 * 56, I_UQ = 16 * 12, I_UKV = 8 * 16;
        constexpr int NEARLY = I_IN + I_UQ + I_UKV;
        for (int it = gw; it < NEARLY; it += NGW) {
            int r = it;
            if (r < I_IN) { tr_item<1>(w_in, IN_COLS, (r / 56) * 32, (r % 56) * 128, WIN, DM, nullptr, scr, lane); continue; } r -= I_IN;
            if (r < I_UQ) { tr_item<3>(w_uq, NH * QKD, (r / 12) * 32, (r % 12) * 128, WUQ, QL, q_norm_g, scr, lane); continue; } r -= I_UQ;
            tr_item<0>(w_ukv, 2048, (r / 16) * 32, (r % 16) * 128, WUKV, KVL, kv_norm_g, scr, lane);
        }
        for (int i = (bx * 512 + tid); i < 8 * 128 * 128 / 2; i += G * 512) { const f32x2 v = *(const f32x2*)(w_spatial + 2 * (size_t)i); ((unsigned*)WSP)[i] = pk2(v.x, v.y); }
    }
    SEAM(0);

    if (IN(1)) for (int rep_ = 0; rep_ < REPS(1); ++rep_) { if (rep_) cg::this_grid().sync(); PH_START(1);
        for (int row = gw; row < MROWS; row += NGW) {
            const float* src = row < NTOK ? x + (size_t)row * DM : ctx + (size_t)(row - NTOK) * DM;
            const int b = row < NTOK ? row / SEQ : 4;
            const float* sh = MOD + (size_t)b * NMOD; const float* scp = sh + DM;
            f32x4 v[8]; float ss = 0.f;
#pragma unroll
            for (int j = 0; j < 8; ++j) { v[j] = __builtin_nontemporal_load((const f32x4*)(src + (lane + 64 * j) * 4)); ss += (v[j].x * v[j].x + v[j].y * v[j].y) + (v[j].z * v[j].z + v[j].w * v[j].w); }
            const float r = 1.0f / sqrtf(wave_sum(ss) * (1.0f / DM) + EPS);
#pragma unroll
            for (int j = 0; j < 8; ++j) { const int idx = (lane + 64 * j) * 4; const f32x4 g = *(const f32x4*)(norm1_g + idx), s1 = *(const f32x4*)(scp + idx), s0 = *(const f32x4*)(sh + idx);
                const f32x4 o = (v[j] * r * g) * (s1 + 1.0f) + s0;
                u32x2 w; w.x = pk2(o.x, o.y); w.y = pk2(o.z, o.w); *(u32x2*)(H + (size_t)row * DM + idx) = w; }
        }
    }
    SEAM(1);

    if (IN(2)) for (int rep_ = 0; rep_ < REPS(2); ++rep_) { if (rep_) cg::this_grid().sync(); PH_START(2);
        pg8::Gemm g{H, WIN, MROWS, PCOLS, DM, DM, DM}; pg8::ProjOrder S; S.init(G, bx);
        pg8::EpiProj E{P, PCOLS};
        pg8::gemm_phase<pg8::EpiProj, pg8::ProjOrder>((LAS unsigned char*)lds, g, S, E);
        { constexpr int NU = 64 * 28 + 8; const int nlead = NU % G;
          if (bx >= nlead) {
            LAS float* scr = (LAS float*)(lds + wave * 16512);
            constexpr int I_BR = 32 * 16, I_OUT = 64 * 16, I_FI = 64 * 88, I_FO = 176 * 16;
            constexpr int NLATE = 2 * I_BR + I_OUT + I_FI + I_FO;
            const int NW2 = (G - nlead) * 8;
            for (int it = (bx - nlead) * 8 + wave; it < NLATE; it += NW2) {
                int r = it;
                if (r < I_BR) { tr_item<0>(w_br_attn, DM, (r / 16) * 32, (r % 16) * 128, WBR, DM, nullptr, scr, lane); continue; } r -= I_BR;
                if (r < I_BR) { tr_item<0>(w_br_sgu, DM, (r / 16) * 32, (r % 16) * 128, WBR + 1024, DM, nullptr, scr, lane); continue; } r -= I_BR;
                if (r < I_OUT) { tr_item<0>(w_out, DM, (r / 16) * 32, (r % 16) * 128, WOUT, DM, nullptr, scr, lane); continue; } r -= I_OUT;
                if (r < I_FI) { tr_item<2>(w_ffn_in, 2 * DFF, (r / 88) * 32, (r % 88) * 128, WFI, DM, nullptr, scr, lane); continue; } r -= I_FI;
                tr_item<0>(w_ffn_out, DM, (r / 16) * 32, (r % 16) * 128, WFO, DFF, nullptr, scr, lane);
            }
          } }
    }
    SEAM(2);

    if (IN(3)) for (int rep_ = 0; rep_ < REPS(3); ++rep_) { if (rep_) cg::this_grid().sync(); PH_START(3);
        const bool split = (G % 16 == 0);
        for (int pass = 0; pass < (split ? 1 : 2); ++pass) {
            const int sel = split ? ((bx >> 3) & 1) : pass;
            const int Ge = split ? G / 2 : G, ce = split ? ((bx >> 4) * 8 + (bx & 7)) : bx;
            pg8::Gemm g; pg8::EpiBf16 E;
            if (sel == 0) { g = pg8::Gemm{P, WUQ, NTOK, NH * QKD, QL, PCOLS, QL}; E = pg8::EpiBf16{QUP, NH * QKD}; }
            else { g = pg8::Gemm{P + PC_KV, WUKV, MROWS, 2048, KVL, PCOLS, KVL}; E = pg8::EpiBf16{KVUP, 2048}; }
            pg8::StaticOrder S; S.init(g.M, g.N, Ge, ce);
            pg8::gemm_phase<pg8::EpiBf16, pg8::StaticOrder>((LAS unsigned char*)lds, g, S, E);
        }
    }
    SEAM(3);

    if (IN(4)) for (int rep_ = 0; rep_ < REPS(4); ++rep_) { if (rep_) cg::this_grid().sync(); PH_START(4);
        LAS float* T = (LAS float*)(lds + wave * 128);
        for (int t = gw; t < MROWS; t += NGW) {
            const bool lat = t < NTOK;
            const bf16_t* Prow = P + (size_t)t * PCOLS;
            int b, n, m;
            if (lat) { b = t / SEQ; n = t % SEQ; m = n; } else { const int tc = t - NTOK; b = tc / CTXL; n = 0; m = SEQ + tc % CTXL; }
            u32x4 kvw[4];
#pragma unroll
            for (int j = 0; j < 4; ++j) kvw[j] = *(const u32x4*)(KVUP + (size_t)t * 2048 + j * 512 + lane * 8);
            const u32x2 kvcw = *(const u32x2*)(Prow + PC_KV + lane * 4);
            const u32x4 krw = *(const u32x4*)(Prow + PC_KR + (lane & 7) * 8);
            u32x4 qw[3] = {}, qcw = {}, gvw[2] = {};
            if (lat) {
#pragma unroll
                for (int j = 0; j < 3; ++j) qw[j] = *(const u32x4*)(QUP + (size_t)t * (NH * QKD) + j * 512 + lane * 8);
                qcw = *(const u32x4*)(Prow + lane * 8);
#pragma unroll
                for (int j = 0; j < 2; ++j) gvw[j] = *(const u32x4*)(Prow + PC_V + j * 512 + lane * 8);
            }
            const int c = lane & 7; const bool first = (c & 2) == 0;
            float cs[8], sn[8];
#pragma unroll
            for (int e = 0; e < 8; ++e) { cs[e] = 1.f; sn[e] = 0.f; }
            if (lat) { const float pos = (float)((c < 4) ? (n >> 6) : (n & 63));
#pragma unroll
                for (int e = 0; e < 8; ++e) { const int i = (c & 1) * 8 + e; const float freq = exp2f(-(float)i * (13.287712379549449f / 16.0f));
                    float rev = pos * freq * 0.15915494309189535f; rev -= floorf(rev); cs[e] = __builtin_amdgcn_cosf(rev); sn[e] = __builtin_amdgcn_sinf(rev); } }
            float r_kv;
            { const float a0 = bflo(kvcw.x), a1 = bfhi(kvcw.x), a2 = bflo(kvcw.y), a3 = bfhi(kvcw.y);
              r_kv = 1.0f / sqrtf(wave_sum((a0 * a0 + a1 * a1) + (a2 * a2 + a3 * a3)) * (1.0f / KVL) + EPS); }
            float kr[8]; kr[0] = bflo(krw.x); kr[1] = bfhi(krw.x); kr[2] = bflo(krw.y); kr[3] = bfhi(krw.y); kr[4] = bflo(krw.z); kr[5] = bfhi(krw.z); kr[6] = bflo(krw.w); kr[7] = bfhi(krw.w);
            float ss_r = 0.f;
#pragma unroll
            for (int e = 0; e < 8; ++e) ss_r += kr[e] * kr[e];
            ss_r = sum8(ss_r);
            const bool isV = (lane & 16) != 0; const int d8 = (lane & 15) * 8;
#pragma unroll
            for (int j = 0; j < 4; ++j) {
                float f[8]; f[0] = bflo(kvw[j].x); f[1] = bfhi(kvw[j].x); f[2] = bflo(kvw[j].y); f[3] = bfhi(kvw[j].y); f[4] = bflo(kvw[j].z); f[5] = bfhi(kvw[j].z); f[6] = bflo(kvw[j].w); f[7] = bfhi(kvw[j].w);
                float ssn = 0.f;
#pragma unroll
                for (int e = 0; e < 8; ++e) { f[e] *= r_kv; ssn += f[e] * f[e]; }
                ssn = sum16(ssn);
                const int h = 2 * j + (lane >> 5);
                const float rn = 1.0f / sqrtf((ssn + ss_r) * (1.0f / QKD) + EPS);
                if (!isV && (lane & 15) == 0) T[h] = rn;
                float ov[8];
#pragma unroll
                for (int e = 0; e < 8; ++e) ov[e] = isV ? f[e] : f[e] * rn * qk_norm_k[d8 + e];
                u32x4 w; w.x = pk2(ov[0], ov[1]); w.y = pk2(ov[2], ov[3]); w.z = pk2(ov[4], ov[5]); w.w = pk2(ov[6], ov[7]);
                bf16_t* dst = isV ? VF + ((size_t)(b * NH + h) * SKV + m) * VD + d8 : KF + ((size_t)(b * NH + h) * SKV + m) * QKD + d8;
                *(u32x4*)dst = w;
            }
            LDS_WAIT();
            { const int h = lane >> 3; const float rn = T[h];
              float f[8];
#pragma unroll
              for (int e = 0; e < 8; ++e) f[e] = kr[e] * rn * qk_norm_k[128 + c * 8 + e];
              if (lat) {
#pragma unroll
                  for (int e = 0; e < 8; ++e) { const float pr = dppf<DPP_XOR2>(f[e]); f[e] = first ? f[e] * cs[e] - pr * sn[e] : f[e] * cs[e] + pr * sn[e]; } }
              u32x4 w; w.x = pk2(f[0], f[1]); w.y = pk2(f[2], f[3]); w.z = pk2(f[4], f[5]); w.w = pk2(f[6], f[7]);
              *(u32x4*)(KF + ((size_t)(b * NH + h) * SKV + m) * QKD + 128 + c * 8) = w; }
            if (lat) {
                float r_q;
                { float s2 = 0.f;
                  s2 += bflo(qcw.x) * bflo(qcw.x) + bfhi(qcw.x) * bfhi(qcw.x); s2 += bflo(qcw.y) * bflo(qcw.y) + bfhi(qcw.y) * bfhi(qcw.y);
                  s2 += bflo(qcw.z) * bflo(qcw.z) + bfhi(qcw.z) * bfhi(qcw.z); s2 += bflo(qcw.w) * bflo(qcw.w) + bfhi(qcw.w) * bfhi(qcw.w);
                  r_q = 1.0f / sqrtf(wave_sum(s2) * (1.0f / QL) + EPS); }
                float qf[3][8];
#pragma unroll
                for (int j = 0; j < 3; ++j) { qf[j][0] = bflo(qw[j].x); qf[j][1] = bfhi(qw[j].x); qf[j][2] = bflo(qw[j].y); qf[j][3] = bfhi(qw[j].y); qf[j][4] = bflo(qw[j].z); qf[j][5] = bfhi(qw[j].z); qf[j][6] = bflo(qw[j].w); qf[j][7] = bfhi(qw[j].w); }
#pragma unroll
                for (int j = 0; j < 3; ++j) { float sq = 0.f;
#pragma unroll
                    for (int e = 0; e < 8; ++e) { qf[j][e] *= r_q; sq += qf[j][e] * qf[j][e]; }
                    sq = sum8(sq);
                    if (j < 2) { sq += dppf<DPP_MIR>(sq); if ((lane & 15) == 0) T[8 + 4 * j + (lane >> 4)] = sq; }
                    else { if ((lane & 7) == 0) T[16 + (lane >> 3)] = sq; } }
                LDS_WAIT();
#pragma unroll
                for (int j = 0; j < 2; ++j) { const int h = 4 * j + (lane >> 4);
                    const float rn = 1.0f / sqrtf((T[8 + h] + T[16 + h]) * (1.0f / QKD) + EPS);
                    float ov[8];
#pragma unroll
                    for (int e = 0; e < 8; ++e) ov[e] = qf[j][e] * rn * qk_norm_q[d8 + e];
                    u32x4 w; w.x = pk2(ov[0], ov[1]); w.y = pk2(ov[2], ov[3]); w.z = pk2(ov[4], ov[5]); w.w = pk2(ov[6], ov[7]);
                    *(u32x4*)(QF + ((size_t)(b * NH + h) * SEQ + n) * QKD + d8) = w; }
                { const int h = lane >> 3;
                  const float rn = 1.0f / sqrtf((T[8 + h] + T[16 + h]) * (1.0f / QKD) + EPS);
                  float f[8];
#pragma unroll
                  for (int e = 0; e < 8; ++e) f[e] = qf[2][e] * rn * qk_norm_q[128 + c * 8 + e];
#pragma unroll
                  for (int e = 0; e < 8; ++e) { const float pr = dppf<DPP_XOR2>(f[e]); f[e] = first ? f[e] * cs[e] - pr * sn[e] : f[e] * cs[e] + pr * sn[e]; }
                  u32x4 w; w.x = pk2(f[0], f[1]); w.y = pk2(f[2], f[3]); w.z = pk2(f[4], f[5]); w.w = pk2(f[6], f[7]);
                  *(u32x4*)(QF + ((size_t)(b * NH + h) * SEQ + n) * QKD + 128 + c * 8) = w; }
                LDS_WAIT();
                bf16_t* vp = (bf16_t*)Prow + PC_V;
                float f[16]; float s = 0.f;
#pragma unroll
                for (int j = 0; j < 2; ++j) { const u32x4 w = gvw[j];
                    f[j * 8 + 0] = bflo(w.x); f[j * 8 + 1] = bfhi(w.x); f[j * 8 + 2] = bflo(w.y); f[j * 8 + 3] = bfhi(w.y);
                    f[j * 8 + 4] = bflo(w.z); f[j * 8 + 5] = bfhi(w.z); f[j * 8 + 6] = bflo(w.w); f[j * 8 + 7] = bfhi(w.w); }
#pragma unroll
                for (int j = 0; j < 16; ++j) s += f[j];
                const float mu = wave_sum(s) * (1.0f / 1024.0f); float q = 0.f;
#pragma unroll
                for (int j = 0; j < 16; ++j) { f[j] -= mu; q += f[j] * f[j]; }
                const float rstd = 1.0f / sqrtf(wave_sum(q) * (1.0f / 1024.0f) + EPS);
#pragma unroll
                for (int j = 0; j < 2; ++j) { const int c0 = j * 512 + lane * 8; float o[8];
#pragma unroll
                    for (int e = 0; e < 8; ++e) o[e] = f[j * 8 + e] * rstd * sgu_norm_g[c0 + e] + sgu_norm_b[c0 + e];
                    u32x4 w; w.x = pk2(o[0], o[1]); w.y = pk2(o[2], o[3]); w.z = pk2(o[4], o[5]); w.w = pk2(o[6], o[7]);
                    *(u32x4*)(vp + c0) = w; }
            }
        }
    }
    SEAM(4);

    if (IN(5)) for (int rep_ = 0; rep_ < REPS(5); ++rep_) { if (rep_) cg::this_grid().sync(); PH_START(5);
        PH_START(12);
        {
            const int r32 = lane & 31, hi = lane >> 5, ib = wave & 3, chh = wave >> 2;
            LAS unsigned char* ldsl = (LAS unsigned char*)lds;
            const int vbw = (int)(uintptr_t)(char*)lds + att::v_rd_base(lane) + chh * 1024;
#define SGU_DMA(un_, slot_) do { const int ck_ = (un_) >> 3, g_ = (un_) & 7; const char* src_ = (const char*)(P + (size_t)ck_ * 128 * PCOLS + PC_V + g_ * 128); \
    _Pragma("unroll") for (int hb_ = 0; hb_ < 2; ++hb_) _Pragma("unroll") for (int i_ = 0; i_ < 2; ++i_) { const int p_ = i_ * 512 + tid, st_ = p_ >> 5, wi_ = p_ & 31, kk_ = (st_ >> 2) * 8 + (wi_ >> 2), c_ = (st_ & 3) * 32 + (wi_ & 3) * 8; \
        const int k_ = (kk_ & ~0xC) | ((kk_ & 4) << 1) | ((kk_ & 8) >> 1); const size_t vo_ = (size_t)(hb_ * 64 + k_) * (PCOLS * 2) + c_ * 2; \
        __builtin_amdgcn_global_load_lds((const unsigned*)(src_ + vo_), (LAS unsigned*)(ldsl + (slot_) * 32768 + hb_ * 16384 + i_ * 8192 + wave * 1024), 16, 0, 0); } } while (0)
#define SGU_AF(dst, un_) do { const int g_ = (un_) & 7; _Pragma("unroll") for (int ks_ = 0; ks_ < 8; ++ks_) dst[ks_] = *(const bf16x8*)(WSP + ((size_t)g_ * 128 + ib * 32 + r32) * 128 + ks_ * 16 + hi * 8); } while (0)
            bf16x8 af[8], afn[8];
            int un = vcu, slot = 0;
            if (un < 1024) { SGU_DMA(un, 0); SGU_AF(af, un); }
            for (; un < 1024; un += G, slot ^= 1) {
                const int ck = un >> 3, g = un & 7; const size_t t0 = (size_t)ck * 128;
                asm volatile("s_waitcnt vmcnt(0)" ::: "memory"); __syncthreads();
                const int un2 = un + G;
                if (un2 < 1024) { SGU_DMA(un2, slot ^ 1); SGU_AF(afn, un2); }
                f32x4 bsv[4];
#pragma unroll
                for (int q = 0; q < 4; ++q) bsv[q] = *(const f32x4*)(b_spatial + g * 128 + ib * 32 + 8 * q + 4 * hi);
                unsigned short uu[2][16];
#pragma unroll
                for (int d = 0; d < 2; ++d)
#pragma unroll
                    for (int r = 0; r < 16; ++r) uu[d][r] = P[(t0 + ib * 32 + att::crow(r, hi)) * PCOLS + PC_U + g * 128 + (2 * chh + d) * 32 + r32];
                f32x16 acc0 = {}, acc1 = {};
                const int vb = vbw + slot * 32768;
#define SGU_STEP(KS) do { const int vbk_ = vb + ((KS) >> 2) * 16384; \
    const s16x4 l0_ = att::tr_read<att::v_rd_off(0, (KS) & 3, 0)>(vbk_), h0_ = att::tr_read<att::v_rd_off(0, (KS) & 3, 1)>(vbk_), l1_ = att::tr_read<att::v_rd_off(1, (KS) & 3, 0)>(vbk_), h1_ = att::tr_read<att::v_rd_off(1, (KS) & 3, 1)>(vbk_); \
    asm volatile("s_waitcnt lgkmcnt(0)" ::: "memory"); __builtin_amdgcn_sched_barrier(0); \
    acc0 = __builtin_amdgcn_mfma_f32_32x32x16_bf16(af[KS], (bf16x8){l0_[0], l0_[1], l0_[2], l0_[3], h0_[0], h0_[1], h0_[2], h0_[3]}, acc0, 0, 0, 0); \
    acc1 = __builtin_amdgcn_mfma_f32_32x32x16_bf16(af[KS], (bf16x8){l1_[0], l1_[1], l1_[2], l1_[3], h1_[0], h1_[1], h1_[2], h1_[3]}, acc1, 0, 0, 0); } while (0)
                SGU_STEP(0); SGU_STEP(1); SGU_STEP(2); SGU_STEP(3); SGU_STEP(4); SGU_STEP(5); SGU_STEP(6); SGU_STEP(7);
#undef SGU_STEP
#pragma unroll
                for (int r = 0; r < 16; ++r) { const size_t t = t0 + ib * 32 + att::crow(r, hi); const int c = g * 128 + (2 * chh) * 32 + r32; const float bsr = bsv[r >> 2][r & 3];
                    AO[t * DM + 1024 + c] = (bf16_t)f2bf(bf2f(uu[0][r]) * (acc0[r] + bsr));
                    AO[t * DM + 1024 + c + 32] = (bf16_t)f2bf(bf2f(uu[1][r]) * (acc1[r] + bsr)); }
                if (un2 < 1024) {
#pragma unroll
                    for (int ks = 0; ks < 8; ++ks) af[ks] = afn[ks]; }
            }
            __syncthreads();
#undef SGU_DMA
#undef SGU_AF
        }
        PH_END(12);
        att::attn_offsets_init((char*)lds);
        for (int un = vcu; un < NB * NH * (SEQ / 256); un += G) {
            const int bh = un >> 4, qb = un & 15, b = bh >> 3, h = bh & 7;
            att::attn_unit(QF + ((size_t)bh * SEQ + qb * 256) * QKD, KF + (size_t)bh * SKV * QKD, VF + (size_t)bh * SKV * VD,
                           AO + ((size_t)b * SEQ + qb * 256) * DM + h * VD, (char*)lds, (LAS unsigned char*)lds);
        }
    }
    SEAM(5);

    if (IN(6)) for (int rep_ = 0; rep_ < REPS(6); ++rep_) { if (rep_) cg::this_grid().sync(); PH_START(6);
        pg8::Gemm g{AO, WBR, NTOK, DM, DM, DM, DM}; pg8::StaticOrder S; S.init(NTOK, DM, G, bx);
        pg8::EpiMerge E{P + PC_GA, P + PC_GS, PCOLS, MERGED};
        pg8::gemm_phase<pg8::EpiMerge, pg8::StaticOrder>((LAS unsigned char*)lds, g, S, E);
    }
    SEAM(6);

    if (IN(7)) for (int rep_ = 0; rep_ < REPS(7); ++rep_) { if (rep_) cg::this_grid().sync(); PH_START(7);
        pg8::Gemm g{MERGED, WOUT, NTOK, DM, DM, DM, DM}; pg8::StaticOrder S; S.init(NTOK, DM, G, bx);
        pg8::EpiResToBf16 E{x, XN, MOD + 2 * DM};
        pg8::gemm_phase<pg8::EpiResToBf16, pg8::StaticOrder>((LAS unsigned char*)lds, g, S, E);
    }
    SEAM(7);

    if (IN(8)) for (int rep_ = 0; rep_ < REPS(8); ++rep_) { if (rep_) cg::this_grid().sync(); PH_START(8);
        for (int row = gw; row < NTOK; row += NGW) {
            const bf16_t* src = XN + (size_t)row * DM; const int b = row / SEQ;
            const float* sh = MOD + (size_t)b * NMOD + 3 * DM; const float* scp = sh + DM;
            float v[4][8]; float ss = 0.f;
#pragma unroll
            for (int j = 0; j < 4; ++j) { const u32x4 w = *(const u32x4*)(src + (lane + 64 * j) * 8);
                v[j][0] = bflo(w.x); v[j][1] = bfhi(w.x); v[j][2] = bflo(w.y); v[j][3] = bfhi(w.y); v[j][4] = bflo(w.z); v[j][5] = bfhi(w.z); v[j][6] = bflo(w.w); v[j][7] = bfhi(w.w);
#pragma unroll
                for (int e = 0; e < 8; ++e) ss += v[j][e] * v[j][e]; }
            const float r = 1.0f / sqrtf(wave_sum(ss) * (1.0f / DM) + EPS);
#pragma unroll
            for (int j = 0; j < 4; ++j) { const int idx = (lane + 64 * j) * 8; float o[8];
#pragma unroll
                for (int h2 = 0; h2 < 2; ++h2) { const f32x4 g = *(const f32x4*)(norm2_g + idx + 4 * h2), s1 = *(const f32x4*)(scp + idx + 4 * h2), s0 = *(const f32x4*)(sh + idx + 4 * h2);
#pragma unroll
                    for (int e = 0; e < 4; ++e) o[4 * h2 + e] = (v[j][4 * h2 + e] * r * g[e]) * (s1[e] + 1.0f) + s0[e]; }
                u32x4 w; w.x = pk2(o[0], o[1]); w.y = pk2(o[2], o[3]); w.z = pk2(o[4], o[5]); w.w = pk2(o[6], o[7]); *(u32x4*)(H2 + (size_t)row * DM + idx) = w; }
        }
    }
    SEAM(8);

    if (IN(9)) for (int rep_ = 0; rep_ < REPS(9); ++rep_) { if (rep_) cg::this_grid().sync(); PH_START(9);
        pg8::Gemm g{H2, WFI, NTOK, 2 * DFF, DM, DM, DM}; pg8::StaticOrder S; S.init(NTOK, 2 * DFF, G, bx);
        pg8::EpiFfnIn E{ACT};
        pg8::gemm_phase<pg8::EpiFfnIn, pg8::StaticOrder>((LAS unsigned char*)lds, g, S, E);
    }
    SEAM(9);

    if (IN(10)) for (int rep_ = 0; rep_ < REPS(10); ++rep_) { if (rep_) cg::this_grid().sync(); PH_START(10);
        pg8::Gemm g{ACT, WFO, NTOK, DM, DFF, DFF, DFF}; pg8::StaticOrder S; S.init(NTOK, DM, G, bx);
        pg8::EpiResFromBf16 E{XN, out, MOD + 5 * DM};
        pg8::gemm_phase<pg8::EpiResFromBf16, pg8::StaticOrder>((LAS unsigned char*)lds, g, S, E);
    }
#undef IN
#undef SEAM
}

constexpr int N_PHASES = 11;

extern "C" void kernel_launch(void* const* d_in, const int* in_sizes, int n_in, void* d_out, int out_size, void* d_ws, size_t ws_size, hipStream_t stream) {
    static int grid = 0;
    if (grid == 0) {
        if (n_in != 24 || out_size != NTOK * DM || ws_size < WS_END) { fprintf(stderr, "kernel_launch: unexpected shapes n_in %d out %d ws %zu\n", n_in, out_size, ws_size); grid = -1; return; }
        int dev = 0, cus = 0, per_cu = 0;
        (void)hipGetDevice(&dev); (void)hipDeviceGetAttribute(&cus, hipDeviceAttributeMultiprocessorCount, dev);
        if (hipFuncSetAttribute((const void*)fwd_kernel, hipFuncAttributeMaxDynamicSharedMemorySize, LDS_BYTES) != hipSuccess) { fprintf(stderr, "kernel_launch: hipFuncSetAttribute failed\n"); grid = -1; return; }
        if (hipOccupancyMaxActiveBlocksPerMultiprocessor(&per_cu, (const void*)fwd_kernel, 512, LDS_BYTES) != hipSuccess || per_cu < 1) { fprintf(stderr, "kernel_launch: occupancy query says %d\n", per_cu); per_cu = 1; }
        (void)hipGetLastError();
        grid = cus * per_cu;
    }
    if (grid < 0) return;
    Args a{};
    for (int i = 0; i < 24; ++i) a.in[i] = (const float*)d_in[i];
    a.out = (float*)d_out; a.ws = (unsigned char*)d_ws;
#if MK_LAUNCH_PER_PHASE
    for (int p = 0; p < N_PHASES; ++p) { a.ph_lo = p; a.ph_hi = p + 1;
        hipLaunchKernelGGL(fwd_kernel, dim3(grid), dim3(512), LDS_BYTES, stream, a); }
#else
#ifndef PROBE_SPLIT
    (void)hipMemsetAsync((char*)d_ws + WS_BAR, 0, XCD_BAR_WORDS * 4, stream);
    a.ph_lo = 0; a.ph_hi = N_PHASES;
    void* kargs[] = {&a};
    hipError_t e = hipLaunchCooperativeKernel((const void*)fwd_kernel, dim3(grid), dim3(512), kargs, LDS_BYTES, stream);
    if (e != hipSuccess) fprintf(stderr, "cooperative launch failed: %s (grid %d)\n", hipGetErrorString(e), grid);
#else
    void* kargs[] = {&a};
    a.ph_lo = 0; a.ph_hi = PROBE_SPLIT + 1;
    (void)hipLaunchCooperativeKernel((const void*)fwd_kernel, dim3(grid), dim3(512), kargs, LDS_BYTES, stream);
    a.ph_lo = PROBE_SPLIT; a.ph_hi = N_PHASES;
    (void)hipLaunchCooperativeKernel((const void*)fwd_kernel, dim3(grid), dim3(512), kargs, LDS_BYTES, stream);
#endif
#endif
}
```

```cpp
#include <hip/hip_runtime.h>
#include <hip/hip_cooperative_groups.h>
#include <cstdio>
#include <cstdint>
namespace cg = cooperative_groups;

#ifndef MK_LAUNCH_PER_PHASE
#define MK_LAUNCH_PER_PHASE 0
#endif

#define LAS __attribute__((address_space(3)))
typedef unsigned short bf16_t;
typedef short bf16x8 __attribute__((ext_vector_type(8)));
typedef short s16x4 __attribute__((ext_vector_type(4)));
typedef float f32x2 __attribute__((ext_vector_type(2)));
typedef float f32x4 __attribute__((ext_vector_type(4)));
typedef float f32x16 __attribute__((ext_vector_type(16)));
typedef unsigned u32x2 __attribute__((ext_vector_type(2)));
typedef unsigned u32x4 __attribute__((ext_vector_type(4)));

constexpr int DM = 2048, NB = 4, SEQ = 4096, NTOK = NB * SEQ, CTXL = 256, NCTX = NB * CTXL, MROWS = NTOK + NCTX;
constexpr int NH = 8, QL = 512, KVL = 256, QKD = 192, VD = 128;
constexpr int DFF = 5632, NMOD = 6 * DM;
constexpr int SKV = SEQ + CTXL;
constexpr int PCOLS = 7168;
constexpr int PC_KV = 512, PC_KR = 768, PC_U = 1024, PC_V = 2048, PC_GA = 3072, PC_GS = 5120;
constexpr int IN_COLS = 6976;
constexpr float EPS = 1e-6f;

constexpr size_t MiB = 1u << 20;
constexpr size_t WS_MOD = 0;
constexpr size_t WS_BAR = 768 * 1024;
constexpr size_t WS_WIN = 1 * MiB;
constexpr size_t WS_WUQ = 29 * MiB;
constexpr size_t WS_WUKV = 31 * MiB;
constexpr size_t WS_WBRA = 32 * MiB;
constexpr size_t WS_WBRS = 36 * MiB;
constexpr size_t WS_WOUT = 40 * MiB;
constexpr size_t WS_WFI = 48 * MiB;
constexpr size_t WS_WFO = 92 * MiB;
constexpr size_t WS_WSP = 114 * MiB;
constexpr size_t WS_H = 116 * MiB;
constexpr size_t WS_P = 184 * MiB;
constexpr size_t WS_KF = 422 * MiB;
constexpr size_t WS_VF = 473 * MiB;
constexpr size_t WS_MERGED = 422 * MiB;
constexpr size_t WS_END = 512 * MiB;
constexpr size_t DO_QF = 48 * MiB;

constexpr int LDS_BYTES = 139264, LDS_BARST = 139200;

__device__ __forceinline__ unsigned f2bf(float f) { unsigned u = __builtin_bit_cast(unsigned, f); return (u + 0x7fffu + ((u >> 16) & 1u)) >> 16; }
__device__ __forceinline__ unsigned pk2(float lo, float hi) { unsigned r; asm("v_cvt_pk_bf16_f32 %0, %1, %2" : "=v"(r) : "v"(lo), "v"(hi)); return r; }
__device__ __forceinline__ float bf2f(unsigned short b) { return __builtin_bit_cast(float, ((unsigned)b) << 16); }
__device__ __forceinline__ float bflo(unsigned w) { return __builtin_bit_cast(float, w << 16); }
__device__ __forceinline__ float bfhi(unsigned w) { return __builtin_bit_cast(float, w & 0xffff0000u); }
template <int CTRL> __device__ __forceinline__ float dppf(float v) { return __builtin_bit_cast(float, __builtin_amdgcn_update_dpp(0, __builtin_bit_cast(int, v), CTRL, 0xf, 0xf, true)); }
#define DPP_XOR1 0xB1
#define DPP_XOR2 0x4E
#define DPP_HMIR 0x141
#define DPP_MIR  0x140
__device__ __forceinline__ float sum4(float v) { v += dppf<DPP_XOR1>(v); v += dppf<DPP_XOR2>(v); return v; }
__device__ __forceinline__ float sum8(float v) { v = sum4(v); v += dppf<DPP_HMIR>(v); return v; }
__device__ __forceinline__ float sum16(float v) { v = sum8(v); v += dppf<DPP_MIR>(v); return v; }
__device__ __forceinline__ float wave_sum(float v) {
    v = sum16(v);
    const float a = __builtin_bit_cast(float, __builtin_amdgcn_readlane(__builtin_bit_cast(int, v), 0)), b = __builtin_bit_cast(float, __builtin_amdgcn_readlane(__builtin_bit_cast(int, v), 16));
    const float c = __builtin_bit_cast(float, __builtin_amdgcn_readlane(__builtin_bit_cast(int, v), 32)), d = __builtin_bit_cast(float, __builtin_amdgcn_readlane(__builtin_bit_cast(int, v), 48));
    return (a + b) + (c + d);
}
#define LDS_WAIT() asm volatile("s_waitcnt lgkmcnt(0)" ::: "memory")

namespace pg8 {
#define PG8_LAS __attribute__((address_space(3)))
constexpr int BM = 256, BK = 64, HALF = 128, HTB = HALF * BK * 2, STAGE_BYTES = 8 * HTB, NXCD = 8, WGM = 7;
__host__ __device__ __forceinline__ int lds_byte(int r, int c) { const int st = (r >> 4) * 2 + (c >> 5), rr = r & 15, cc = c & 31, ob = rr * 64 + cc * 2; return st * 1024 + (ob ^ (((ob >> 9) & 1) << 5)); }
__host__ __device__ __forceinline__ void stage_rc(int b, int& R, int& C) { const int st = b / 1024, sb = b % 1024, swz = sb ^ (((sb >> 9) & 1) << 5); R = (st >> 1) * 16 + swz / 64; C = (st & 1) * 32 + (swz % 64) / 2; }
__host__ __device__ __forceinline__ int perm32(int rho) { const int n = rho >> 4, i = rho & 15; return 8 * (i >> 2) + 4 * n + (i & 3); }

struct Unit { int pm, pn; };
struct Gemm { const bf16_t* A; const bf16_t* Bt; int M, N, K, lda, ldb; };

struct StaticOrder {
    int nM, nN, nwg, G, c;
    __device__ void init(int M, int N, int G_, int c_) { nM = M / BM; nN = N / BM; nwg = nM * nN; G = G_; c = c_; }
    __device__ bool next(int i, Unit& u) const {
        const long L = (long)i * G + c; if (L >= nwg) return false;
        int wgid = (int)L; { const int q = nwg / NXCD, r = nwg % NXCD, xcd = wgid % NXCD, off = wgid / NXCD; wgid = (xcd < r ? xcd * (q + 1) : r * (q + 1) + (xcd - r) * q) + off; }
        const int nig = WGM * nN, gid = wgid / nig, fm = gid * WGM, gsz = (nM - fm) < WGM ? (nM - fm) : WGM;
        u.pm = fm + ((wgid % nig) % gsz); u.pn = (wgid % nig) / gsz; return true;
    }
    __device__ __forceinline__ void a_ready(const Unit&) const {}
    __device__ __forceinline__ void done(const Unit&) const {}
};
struct ProjOrder {
    StaticOrder S; int G, c;
    __device__ void init(int G_, int c_) { S.init(NTOK, PCOLS, G_, c_); G = G_; c = c_; }
    __device__ bool next(int i, Unit& u) const {
        const long L = (long)i * G + c;
        if (L < S.nwg) return S.next(i, u);
        const int j = (int)(L - S.nwg); if (j >= 8) return false;
        u.pm = 64 + (j >> 1); u.pn = 2 + (j & 1); return true;
    }
    __device__ __forceinline__ void a_ready(const Unit&) const {}
    __device__ __forceinline__ void done(const Unit&) const {}
};

__device__ __forceinline__ unsigned cvt_pk_bf16(float lo, float hi) { unsigned r; asm volatile("v_cvt_pk_bf16_f32 %0, %1, %2" : "=v"(r) : "v"(lo), "v"(hi)); return r; }
__device__ __forceinline__ f32x2 gelu_pk(f32x2 v) {
    const f32x2 av = __builtin_elementwise_abs(v), d = av * 0.2316418882f + 1.0f;
    f32x2 t; t.x = __builtin_amdgcn_rcpf(d.x); t.y = __builtin_amdgcn_rcpf(d.y);
    f32x2 q = t * 0.5307027145f + (-0.7265760135f); q = q * t + 0.7107068705f; q = q * t + (-0.142248368f); q = q * t + 0.127414796f; q = q * t;
    const f32x2 s = (v * v) * (-0.72134752044f);
    f32x2 e; e.x = __builtin_amdgcn_exp2f(s.x); e.y = __builtin_amdgcn_exp2f(s.y);
    const f32x2 m = v * (q * e), r = v - m;
    f32x2 o; o.x = v.x < 0.f ? m.x : r.x; o.y = v.y < 0.f ? m.y : r.y; return o;
}
__device__ __forceinline__ float sigm(float x) { return __builtin_amdgcn_rcpf(1.0f + __builtin_amdgcn_exp2f(-1.4426950408889634f * x)); }

struct EpiProj {
    static constexpr bool PERM = true, AFTER_DRAIN = false, MID = false;
    bf16_t* O; int ldc;
    __device__ __forceinline__ void operator()(const f32x4 (&acc)[2][2][4][2], const Unit& u, int wr, int wc, int fr, int fq) const {
        const int row0 = u.pm * BM + wr * 64 + fr, col0 = u.pn * BM + wc * 32 + 8 * fq;
        const int act = (u.pn < 4) ? 0 : (u.pn < 12 ? 1 : 2);
#pragma unroll
        for (int ai = 0; ai < 2; ++ai)
#pragma unroll
            for (int m = 0; m < 4; ++m) { bf16_t* rowp = O + (size_t)(row0 + ai * HALF + m * 16) * ldc + col0;
#pragma unroll
                for (int bj = 0; bj < 2; ++bj) { f32x4 v0 = acc[ai][bj][m][0], v1 = acc[ai][bj][m][1];
                    if (act == 1) { f32x2 a = gelu_pk((f32x2){v0[0], v0[1]}), b = gelu_pk((f32x2){v0[2], v0[3]}), c = gelu_pk((f32x2){v1[0], v1[1]}), d = gelu_pk((f32x2){v1[2], v1[3]});
                        v0 = (f32x4){a.x, a.y, b.x, b.y}; v1 = (f32x4){c.x, c.y, d.x, d.y}; }
                    else if (act == 2) {
                        unsigned lo = 0u, hi = 0u;
                        lo = __builtin_amdgcn_cvt_pk_u8_f32(sigm(v0[0]) * 255.f, 0, lo); lo = __builtin_amdgcn_cvt_pk_u8_f32(sigm(v0[1]) * 255.f, 1, lo);
                        lo = __builtin_amdgcn_cvt_pk_u8_f32(sigm(v0[2]) * 255.f, 2, lo); lo = __builtin_amdgcn_cvt_pk_u8_f32(sigm(v0[3]) * 255.f, 3, lo);
                        hi = __builtin_amdgcn_cvt_pk_u8_f32(sigm(v1[0]) * 255.f, 0, hi); hi = __builtin_amdgcn_cvt_pk_u8_f32(sigm(v1[1]) * 255.f, 1, hi);
                        hi = __builtin_amdgcn_cvt_pk_u8_f32(sigm(v1[2]) * 255.f, 2, hi); hi = __builtin_amdgcn_cvt_pk_u8_f32(sigm(v1[3]) * 255.f, 3, hi);
                        const int gidx = (u.pn - 12) * BM + bj * HALF + wc * 32 + 8 * fq;
                        unsigned char* rowb = (unsigned char*)(O + (size_t)(row0 + ai * HALF + m * 16) * ldc) + 6144 + gidx;
                        *(u32x2*)rowb = (u32x2){lo, hi};
                        continue; }
                    u32x4 w; w.x = cvt_pk_bf16(v0[0], v0[1]); w.y = cvt_pk_bf16(v0[2], v0[3]); w.z = cvt_pk_bf16(v1[0], v1[1]); w.w = cvt_pk_bf16(v1[2], v1[3]);
                    *(u32x4*)(rowp + bj * HALF) = w; } }
    }
};
struct EpiBf16 {
    static constexpr bool PERM = true, AFTER_DRAIN = false, MID = false;
    bf16_t* O; int ldc;
    __device__ __forceinline__ void operator()(const f32x4 (&acc)[2][2][4][2], const Unit& u, int wr, int wc, int fr, int fq) const {
        const int row0 = u.pm * BM + wr * 64 + fr, col0 = u.pn * BM + wc * 32 + 8 * fq;
#pragma unroll
        for (int ai = 0; ai < 2; ++ai)
#pragma unroll
            for (int m = 0; m < 4; ++m) { bf16_t* rowp = O + (size_t)(row0 + ai * HALF + m * 16) * ldc + col0;
#pragma unroll
                for (int bj = 0; bj < 2; ++bj) { const f32x4 v0 = acc[ai][bj][m][0], v1 = acc[ai][bj][m][1];
                    u32x4 w; w.x = cvt_pk_bf16(v0[0], v0[1]); w.y = cvt_pk_bf16(v0[2], v0[3]); w.z = cvt_pk_bf16(v1[0], v1[1]); w.w = cvt_pk_bf16(v1[2], v1[3]);
                    *(u32x4*)(rowp + bj * HALF) = w; } }
    }
};
struct EpiMerge {
    static constexpr bool PERM = true, AFTER_DRAIN = false, MID = true;
    const unsigned char* GA; const unsigned char* GS; int ldgb; bf16_t* O;
#define EM_UB(W, I) ((float)(((W) >> (8 * (I))) & 0xffu))
    __device__ __forceinline__ void mid(f32x4 (&acc)[2][2][4][2], const Unit& u, int wr, int wc, int fr, int fq) const {
        int row0 = u.pm * BM + wr * 64 + fr, col0 = u.pn * BM + wc * 32 + 8 * fq;
        asm volatile("" : "+v"(row0), "+v"(col0));
#pragma unroll
        for (int ai = 0; ai < 2; ++ai)
#pragma unroll
            for (int m = 0; m < 4; ++m) { const size_t r = (size_t)(row0 + ai * HALF + m * 16);
#pragma unroll
                for (int bj = 0; bj < 2; ++bj) { const int c = col0 + bj * HALF;
                    const u32x2 ga = *(const u32x2*)(GA + r * ldgb + c), gs = *(const u32x2*)(GS + r * ldgb + c);
                    f32x4 r0, r1;
#pragma unroll
                    for (int j = 0; j < 4; ++j) { r0[j] = EM_UB(ga.x, j) * __builtin_amdgcn_rcpf(fmaxf(EM_UB(gs.x, j), 1.0f)); r1[j] = EM_UB(ga.y, j) * __builtin_amdgcn_rcpf(fmaxf(EM_UB(gs.y, j), 1.0f)); }
                    acc[ai][bj][m][0] = acc[ai][bj][m][0] * r0; acc[ai][bj][m][1] = acc[ai][bj][m][1] * r1; }
                asm volatile("" ::: "memory"); }
    }
    __device__ __forceinline__ void operator()(const f32x4 (&acc)[2][2][4][2], const Unit& u, int wr, int wc, int fr, int fq) const {
        int row0 = u.pm * BM + wr * 64 + fr, col0 = u.pn * BM + wc * 32 + 8 * fq;
        asm volatile("" : "+v"(row0), "+v"(col0));
#pragma unroll
        for (int ai = 0; ai < 2; ++ai)
#pragma unroll
            for (int m = 0; m < 4; ++m) { const size_t r = (size_t)(row0 + ai * HALF + m * 16);
#pragma unroll
                for (int bj = 0; bj < 2; ++bj) { const int c = col0 + bj * HALF;
                    const u32x2 g = *(const u32x2*)(GS + r * ldgb + c);
                    f32x4 g0, g1;
#pragma unroll
                    for (int j = 0; j < 4; ++j) { g0[j] = fmaxf(EM_UB(g.x, j), 1.0f) * (1.0f / 255.0f); g1[j] = fmaxf(EM_UB(g.y, j), 1.0f) * (1.0f / 255.0f); }
                    const f32x4 a0 = acc[ai][bj][m][0] * g0, a1 = acc[ai][bj][m][1] * g1;
                    u32x4 w; w.x = cvt_pk_bf16(a0[0], a0[1]); w.y = cvt_pk_bf16(a0[2], a0[3]); w.z = cvt_pk_bf16(a1[0], a1[1]); w.w = cvt_pk_bf16(a1[2], a1[3]);
                    *(u32x4*)(O + r * DM + c) = w; } }
    }
#undef EM_UB
};
struct EpiRes {
    static constexpr bool PERM = false, AFTER_DRAIN = false, MID = false;
    const float* base; float* out; const float* gate;
    __device__ __forceinline__ void operator()(const f32x4 (&acc)[2][2][4][2], const Unit& u, int wr, int wc, int fr, int fq) const {
        const int row0 = u.pm * BM + wr * 64 + fr, col0 = u.pn * BM + wc * 32 + 4 * fq;
        const float* gp = gate + (size_t)(u.pm >> 4) * NMOD + col0;
        f32x4 gv[2][2];
#pragma unroll
        for (int bj = 0; bj < 2; ++bj)
#pragma unroll
            for (int n = 0; n < 2; ++n) gv[bj][n] = *(const f32x4*)(gp + bj * HALF + n * 16);
#pragma unroll
        for (int ai = 0; ai < 2; ++ai)
#pragma unroll
            for (int m = 0; m < 4; ++m) { const size_t off = (size_t)(row0 + ai * HALF + m * 16) * DM + col0;
#pragma unroll
                for (int bj = 0; bj < 2; ++bj)
#pragma unroll
                    for (int n = 0; n < 2; ++n) { const f32x4 b = *(const f32x4*)(base + off + bj * HALF + n * 16);
                        *(f32x4*)(out + off + bj * HALF + n * 16) = b + gv[bj][n] * acc[ai][bj][m][n]; } }
    }
};
struct EpiResToBf16 {
    static constexpr bool PERM = true, AFTER_DRAIN = false, MID = false;
    const float* base; bf16_t* XN; const float* gate;
    __device__ __forceinline__ void operator()(const f32x4 (&acc)[2][2][4][2], const Unit& u, int wr, int wc, int fr, int fq) const {
        const int row0 = u.pm * BM + wr * 64 + fr, col0 = u.pn * BM + wc * 32 + 8 * fq;
        const float* gp = gate + (size_t)(u.pm >> 4) * NMOD + col0;
        f32x4 gv[2][2];
#pragma unroll
        for (int bj = 0; bj < 2; ++bj)
#pragma unroll
            for (int n = 0; n < 2; ++n) gv[bj][n] = *(const f32x4*)(gp + bj * HALF + 4 * n);
#pragma unroll
        for (int ai = 0; ai < 2; ++ai)
#pragma unroll
            for (int m = 0; m < 4; ++m) { const size_t off = (size_t)(row0 + ai * HALF + m * 16) * DM + col0;
#pragma unroll
                for (int bj = 0; bj < 2; ++bj) { const f32x4 b0 = __builtin_nontemporal_load((const f32x4*)(base + off + bj * HALF)), b1 = __builtin_nontemporal_load((const f32x4*)(base + off + bj * HALF + 4));
                    const f32x4 v0 = b0 + gv[bj][0] * acc[ai][bj][m][0], v1 = b1 + gv[bj][1] * acc[ai][bj][m][1];
                    u32x4 w; w.x = cvt_pk_bf16(v0[0], v0[1]); w.y = cvt_pk_bf16(v0[2], v0[3]); w.z = cvt_pk_bf16(v1[0], v1[1]); w.w = cvt_pk_bf16(v1[2], v1[3]);
                    *(u32x4*)(XN + off + bj * HALF) = w; } }
    }
};
struct EpiResFromBf16 {
    static constexpr bool PERM = false, AFTER_DRAIN = false, MID = false;
    const bf16_t* XN; float* out; const float* gate;
    __device__ __forceinline__ void operator()(const f32x4 (&acc)[2][2][4][2], const Unit& u, int wr, int wc, int fr, int fq) const {
        const int row0 = u.pm * BM + wr * 64 + fr, col0 = u.pn * BM + wc * 32 + 4 * fq;
        const float* gp = gate + (size_t)(u.pm >> 4) * NMOD + col0;
        f32x4 gv[2][2];
#pragma unroll
        for (int bj = 0; bj < 2; ++bj)
#pragma unroll
            for (int n = 0; n < 2; ++n) gv[bj][n] = *(const f32x4*)(gp + bj * HALF + n * 16);
#pragma unroll
        for (int ai = 0; ai < 2; ++ai)
#pragma unroll
            for (int m = 0; m < 4; ++m) { const size_t off = (size_t)(row0 + ai * HALF + m * 16) * DM + col0;
#pragma unroll
                for (int bj = 0; bj < 2; ++bj)
#pragma unroll
                    for (int n = 0; n < 2; ++n) { const u32x2 xb = *(const u32x2*)(XN + off + bj * HALF + n * 16);
                        const f32x4 b = (f32x4){bflo(xb.x), bfhi(xb.x), bflo(xb.y), bfhi(xb.y)};
                        *(f32x4*)(out + off + bj * HALF + n * 16) = b + gv[bj][n] * acc[ai][bj][m][n]; } }
    }
};
struct EpiFfnIn {
    static constexpr bool PERM = true, AFTER_DRAIN = false, MID = false;
    bf16_t* O;
    __device__ __forceinline__ void operator()(const f32x4 (&acc)[2][2][4][2], const Unit& u, int wr, int wc, int fr, int fq) const {
        const int row0 = u.pm * BM + wr * 64 + fr, col0 = u.pn * HALF + wc * 32 + 8 * fq;
#pragma unroll
        for (int ai = 0; ai < 2; ++ai)
#pragma unroll
            for (int m = 0; m < 4; ++m) { bf16_t* rowp = O + (size_t)(row0 + ai * HALF + m * 16) * DFF + col0;
                float o[8];
#pragma unroll
                for (int n = 0; n < 2; ++n)
#pragma unroll
                    for (int j = 0; j < 4; ++j) { const float a = acc[ai][0][m][n][j], b = acc[ai][1][m][n][j]; o[n * 4 + j] = a * sigm(a) * b; }
                u32x4 w; w.x = cvt_pk_bf16(o[0], o[1]); w.y = cvt_pk_bf16(o[2], o[3]); w.z = cvt_pk_bf16(o[4], o[5]); w.w = cvt_pk_bf16(o[6], o[7]);
                *(u32x4*)rowp = w; }
    }
};

template <class Epi, class Sched, bool ALIGN_EPI = true, bool SP2 = true>
__device__ __forceinline__ void gemm_phase(PG8_LAS unsigned char* lds, const Gemm g, const Sched& S, const Epi& E) {
    const int tid = threadIdx.x, wid = __builtin_amdgcn_readfirstlane(tid >> 6), lane = tid & 63, wr = wid >> 2, wc = wid & 3, fr = lane & 15, fq = lane >> 4;
    const int K = g.K, nt = K / BK;
    unsigned voffA[2], voffB[2];
#pragma unroll
    for (int i = 0; i < 2; ++i) { int R, C; stage_rc(tid * 16 + i * 8192, R, C); const int Rb = Epi::PERM ? ((R & ~31) + perm32(R & 31)) : R;
        voffA[i] = (unsigned)(R * g.lda + C) * 2u; voffB[i] = (unsigned)(Rb * g.ldb + C) * 2u; }
    const size_t kstep = (size_t)(BK * 2);
    const size_t hstepA = (size_t)HALF * g.lda * 2, hstepB = (size_t)HALF * g.ldb * 2;
    const size_t tstepA = 2 * hstepA, tstepB = 2 * hstepB;
    const unsigned ldsw = (unsigned)wid * 1024u;
    const int aoff = lds_byte(wr * 64 + fr, fq * 8), boff = lds_byte(wc * 32 + fr, fq * 8);
#define PG8_SA(b, h) (((b) * 2 + (h)) * HTB)
#define PG8_SB(b, h) ((4 + (b) * 2 + (h)) * HTB)
#define PG8_STAGE(bufoff, gbase, voff) do { _Pragma("unroll") for (int _i = 0; _i < 2; ++_i) \
        __builtin_amdgcn_global_load_lds((const unsigned*)((const char*)(gbase) + (voff)[_i]), (PG8_LAS unsigned*)(lds + (bufoff) + ldsw + _i * 8192), 16, 0, 0); } while (0)
#define PG8_LDA(dst, b, h) do { _Pragma("unroll") for (int m = 0; m < 4; ++m) _Pragma("unroll") for (int k = 0; k < 2; ++k) dst[m][k] = *(const PG8_LAS bf16x8*)(lds + PG8_SA(b, h) + aoff + m * 2048 + k * 1024); } while (0)
#define PG8_LDB(dst, b, h) do { _Pragma("unroll") for (int n = 0; n < 2; ++n) _Pragma("unroll") for (int k = 0; k < 2; ++k) dst[n][k] = *(const PG8_LAS bf16x8*)(lds + PG8_SB(b, h) + boff + n * 2048 + k * 1024); } while (0)
#define PG8_MMA(ai, bj, At, Bt) do { __builtin_amdgcn_s_setprio(1); _Pragma("unroll") for (int m = 0; m < 4; ++m) _Pragma("unroll") for (int n = 0; n < 2; ++n) _Pragma("unroll") for (int k = 0; k < 2; ++k) \
        acc[ai][bj][m][n] = __builtin_amdgcn_mfma_f32_16x16x32_bf16(Bt[n][k], At[m][k], acc[ai][bj][m][n], 0, 0, 0); __builtin_amdgcn_s_setprio(0); } while (0)
#define PG8_WAIT_V(n) asm volatile("s_waitcnt vmcnt(" #n ")" ::: "memory")
#define PG8_WAIT_L(n) asm volatile("s_waitcnt lgkmcnt(" #n ")" ::: "memory")
#define PG8_BAR __builtin_amdgcn_s_barrier()
#define PG8_SCHED __builtin_amdgcn_sched_barrier(0)
    Unit cur, nxt; int ui = 0;
    if (!S.next(0, cur)) return;
    f32x4 acc[2][2][4][2];
#pragma unroll
    for (int a = 0; a < 2; ++a)
#pragma unroll
        for (int b = 0; b < 2; ++b)
#pragma unroll
            for (int m = 0; m < 4; ++m)
#pragma unroll
                for (int n = 0; n < 2; ++n) acc[a][b][m][n] = (f32x4){0.f, 0.f, 0.f, 0.f};
    bf16x8 At[4][2], B0[2][2], B1[2][2];
    const char* cA = (const char*)g.A + (size_t)cur.pm * tstepA; const char* cB = (const char*)g.Bt + (size_t)cur.pn * tstepB;
    S.a_ready(cur);
    if constexpr (SP2) {
        PG8_STAGE(PG8_SB(0, 0), cB, voffB); PG8_STAGE(PG8_SB(0, 1), cB + hstepB, voffB); PG8_STAGE(PG8_SA(0, 0), cA, voffA); PG8_STAGE(PG8_SA(0, 1), cA + hstepA, voffA);
        if (wr == 1) PG8_BAR;
        PG8_WAIT_V(2); PG8_BAR;
        PG8_STAGE(PG8_SB(1, 0), cB + kstep, voffB); PG8_STAGE(PG8_SA(1, 0), cA + kstep, voffA); PG8_STAGE(PG8_SB(1, 1), cB + hstepB + kstep, voffB);
        PG8_WAIT_V(6); PG8_BAR;
    } else {
        PG8_STAGE(PG8_SB(0, 0), cB, voffB); PG8_STAGE(PG8_SA(0, 0), cA, voffA); PG8_STAGE(PG8_SB(0, 1), cB + hstepB, voffB); PG8_STAGE(PG8_SA(0, 1), cA + hstepA, voffA);
        if (wr == 1) PG8_BAR;
        PG8_WAIT_V(4); PG8_BAR;
        PG8_STAGE(PG8_SB(1, 0), cB + kstep, voffB); PG8_STAGE(PG8_SA(1, 0), cA + kstep, voffA); PG8_STAGE(PG8_SB(1, 1), cB + hstepB + kstep, voffB);
        PG8_WAIT_V(6); PG8_BAR;
    }
    for (;;) {
        const bool has_next = S.next(ui + 1, nxt);
        const char* nA = has_next ? (const char*)g.A + (size_t)nxt.pm * tstepA : cA; const char* nB = has_next ? (const char*)g.Bt + (size_t)nxt.pn * tstepB : cB;
        for (int t = 0; t < nt; t += 2) {
            const bool last = (t == nt - 2);
            const char* a1 = cA + (size_t)(t + 1) * kstep;
            const char* a2 = last ? nA : cA + (size_t)(t + 2) * kstep; const char* b2 = last ? nB : cB + (size_t)(t + 2) * kstep;
            const char* a3 = a2 + kstep; const char* b3 = b2 + kstep;
            if constexpr (Epi::MID) { if (t == nt / 2) { PG8_SCHED; E.mid(acc, cur, wr, wc, fr, fq); PG8_SCHED; } }
            if (last && has_next) S.a_ready(nxt);
            if constexpr (SP2) {
            PG8_LDB(B0, 0, 0); PG8_LDB(B1, 0, 1); PG8_SCHED; PG8_LDA(At, 0, 0); PG8_STAGE(PG8_SA(1, 1), a1 + hstepA, voffA);
            PG8_WAIT_V(8); PG8_WAIT_L(0); PG8_BAR; PG8_MMA(0, 0, At, B0); PG8_MMA(0, 1, At, B1); PG8_BAR; PG8_SCHED;
            PG8_LDA(At, 0, 1); PG8_STAGE(PG8_SB(0, 0), b2, voffB); PG8_STAGE(PG8_SB(0, 1), b2 + hstepB, voffB); PG8_STAGE(PG8_SA(0, 0), a2, voffA);
            PG8_WAIT_V(8); PG8_WAIT_L(0); PG8_BAR; PG8_MMA(1, 0, At, B0); PG8_MMA(1, 1, At, B1); PG8_BAR; PG8_SCHED;
            PG8_LDB(B0, 1, 0); PG8_LDB(B1, 1, 1); PG8_SCHED; PG8_LDA(At, 1, 0); PG8_STAGE(PG8_SA(0, 1), a2 + hstepA, voffA);
            PG8_WAIT_V(8); PG8_WAIT_L(0); PG8_BAR; PG8_MMA(0, 0, At, B0); PG8_MMA(0, 1, At, B1); PG8_BAR; PG8_SCHED;
            PG8_LDA(At, 1, 1); PG8_STAGE(PG8_SB(1, 0), b3, voffB); PG8_STAGE(PG8_SB(1, 1), b3 + hstepB, voffB); PG8_STAGE(PG8_SA(1, 0), a3, voffA);
            PG8_WAIT_V(8); PG8_WAIT_L(0); PG8_BAR; PG8_MMA(1, 0, At, B0); PG8_MMA(1, 1, At, B1); PG8_BAR; PG8_SCHED;
            } else {
            PG8_LDB(B0, 0, 0); PG8_SCHED; PG8_LDA(At, 0, 0); PG8_STAGE(PG8_SA(1, 1), a1 + hstepA, voffA);
            PG8_WAIT_L(8); PG8_BAR; PG8_WAIT_L(0); PG8_MMA(0, 0, At, B0); PG8_BAR; PG8_SCHED;
            PG8_LDB(B1, 0, 1); PG8_STAGE(PG8_SB(0, 0), b2, voffB);
            PG8_BAR; PG8_WAIT_L(0); PG8_MMA(0, 1, At, B1); PG8_BAR;
            PG8_LDA(At, 0, 1); PG8_STAGE(PG8_SA(0, 0), a2, voffA);
            PG8_BAR; PG8_WAIT_L(0); PG8_MMA(1, 0, At, B0); PG8_BAR; PG8_SCHED;
            PG8_STAGE(PG8_SB(0, 1), b2 + hstepB, voffB);
            PG8_WAIT_V(6); PG8_BAR; PG8_MMA(1, 1, At, B1); PG8_BAR;
            PG8_LDB(B0, 1, 0); PG8_SCHED; PG8_LDA(At, 1, 0); PG8_STAGE(PG8_SA(0, 1), a2 + hstepA, voffA);
            PG8_WAIT_L(8); PG8_BAR; PG8_WAIT_L(0); PG8_MMA(0, 0, At, B0); PG8_BAR; PG8_SCHED;
            PG8_LDB(B1, 1, 1); PG8_STAGE(PG8_SB(1, 0), b3, voffB);
            PG8_BAR; PG8_WAIT_L(0); PG8_MMA(0, 1, At, B1); PG8_BAR;
            PG8_LDA(At, 1, 1); PG8_STAGE(PG8_SA(1, 0), a3, voffA);
            PG8_BAR; PG8_WAIT_L(0); PG8_MMA(1, 0, At, B0); PG8_BAR; PG8_SCHED;
            PG8_STAGE(PG8_SB(1, 1), b3 + hstepB, voffB);
            PG8_WAIT_V(6); PG8_BAR; PG8_MMA(1, 1, At, B1); PG8_BAR;
            }
        }
        if constexpr (ALIGN_EPI) { if (wr == 0) PG8_BAR; }
        if constexpr (!Epi::AFTER_DRAIN) { E(acc, cur, wr, wc, fr, fq); S.done(cur); }
        if (!has_next) break;
#pragma unroll
        for (int a = 0; a < 2; ++a)
#pragma unroll
            for (int b = 0; b < 2; ++b)
#pragma unroll
                for (int m = 0; m < 4; ++m)
#pragma unroll
                    for (int n = 0; n < 2; ++n) acc[a][b][m][n] = (f32x4){0.f, 0.f, 0.f, 0.f};
        cur = nxt; cA = nA; cB = nB; ++ui;
        if constexpr (ALIGN_EPI) { if (wr == 1) PG8_BAR; }
    }
    PG8_WAIT_V(0);
    if constexpr (!ALIGN_EPI) { if (wr == 0) PG8_BAR; }
    PG8_BAR;
#undef PG8_SA
#undef PG8_SB
#undef PG8_STAGE
#undef PG8_LDA
#undef PG8_LDB
#undef PG8_MMA
#undef PG8_WAIT_V
#undef PG8_WAIT_L
#undef PG8_BAR
#undef PG8_SCHED
}
}

namespace att {
constexpr int NW = 8, QBLK = 32, KVBLK = 64;
constexpr float SCALE = 0.07216878364870323f;
constexpr float THR = 8.f;
constexpr size_t SHM_V = KVBLK * VD * 2, SHM_K = KVBLK * QKD * 2;
constexpr size_t SHM_ATTN = 2 * SHM_V + 2 * SHM_K + NW * 64 * 4;
#define KSWZ(row, colB) ((row) * 384 + ((colB) ^ (((row) & 7) << 4)))
#define SBAR() __builtin_amdgcn_sched_barrier(0)
__device__ __forceinline__ int crow(int r, int hi) { return (r & 3) + 8 * (r >> 2) + 4 * hi; }
__device__ __forceinline__ unsigned cvtpk(float lo, float hi) { unsigned r; asm volatile("v_cvt_pk_bf16_f32 %0, %1, %2" : "=v"(r) : "v"(lo), "v"(hi)); return r; }

__device__ __forceinline__ void partialSM(f32x16& p0, f32x16& p1, float& m_reg, float& mn, float& alpha) {
  constexpr float C = SCALE * 1.4426950408889634f;
  float pmax = p0[0];
#pragma unroll
  for (int r = 1; r < 16; ++r) pmax = fmaxf(pmax, p0[r]);
#pragma unroll
  for (int r = 0; r < 16; ++r) pmax = fmaxf(pmax, p1[r]);
  { auto rr = __builtin_amdgcn_permlane32_swap(__float_as_uint(pmax), __float_as_uint(pmax), false, false);
    pmax = fmaxf(__uint_as_float(rr[0]), __uint_as_float(rr[1])); }
  if (__builtin_expect(__all(pmax - m_reg <= THR / SCALE), 1)) { mn = m_reg; alpha = 1.f; }
  else { mn = fmaxf(m_reg, pmax); alpha = __builtin_amdgcn_exp2f((m_reg - mn) * C); m_reg = mn; }
  float mnC = -mn * C;
#pragma unroll
  for (int r = 0; r < 16; ++r) p0[r] = fmaf(p0[r], C, mnC);
#pragma unroll
  for (int r = 0; r < 16; ++r) p1[r] = fmaf(p1[r], C, mnC);
#pragma unroll
  for (int r = 0; r < 16; ++r) p0[r] = __builtin_amdgcn_exp2f(p0[r]);
}
__device__ __forceinline__ void finishSM(f32x16& p0, f32x16& p1, float alpha, float& l_reg, bf16x8& pa0, bf16x8& pa1, bf16x8& pa2, bf16x8& pa3) {
#pragma unroll
  for (int r = 0; r < 16; ++r) p1[r] = __builtin_amdgcn_exp2f(p1[r]);
  float ps = 0;
#pragma unroll
  for (int r = 0; r < 16; ++r) ps += p0[r];
#pragma unroll
  for (int r = 0; r < 16; ++r) ps += p1[r];
  { auto rr = __builtin_amdgcn_permlane32_swap(__float_as_uint(ps), __float_as_uint(ps), false, false);
    ps = __uint_as_float(rr[0]) + __uint_as_float(rr[1]); }
  l_reg = l_reg * alpha + ps;
#define PK4(P, BASE, OUT) do { unsigned a0 = cvtpk(P[BASE + 0], P[BASE + 1]), a1 = cvtpk(P[BASE + 2], P[BASE + 3]);   \
    unsigned b0 = cvtpk(P[BASE + 4], P[BASE + 5]), b1 = cvtpk(P[BASE + 6], P[BASE + 7]);                              \
    auto r0 = __builtin_amdgcn_permlane32_swap(a0, b0, false, false); auto r1 = __builtin_amdgcn_permlane32_swap(a1, b1, false, false); \
    u32x4 w = {r0[0], r1[0], r0[1], r1[1]}; OUT = *reinterpret_cast<bf16x8*>(&w); } while (0)
  PK4(p0, 0, pa0); PK4(p0, 8, pa1); PK4(p1, 0, pa2); PK4(p1, 8, pa3);
#undef PK4
}
__device__ __forceinline__ void qkt(f32x16& p0, f32x16& p1, const char* Ks, const bf16x8* qr, int r32, int hi) {
  p0 = f32x16{}; p1 = f32x16{};
  int rsw = ((r32 >> 1) & 7) << 4; asm volatile("" : "+v"(rsw));
  const char* Kr = Ks + r32 * 384;
#pragma unroll
  for (int d0 = 0; d0 < 12; ++d0) { int cb = (d0 * 16 + hi * 8) * 2;
    bf16x8 b0 = *reinterpret_cast<const bf16x8*>(Kr + (cb ^ rsw));
    bf16x8 b1 = *reinterpret_cast<const bf16x8*>(Kr + 32 * 384 + (cb ^ rsw));
    p0 = __builtin_amdgcn_mfma_f32_32x32x16_bf16(b0, qr[d0], p0, 0, 0, 0);
    p1 = __builtin_amdgcn_mfma_f32_32x32x16_bf16(b1, qr[d0], p1, 0, 0, 0); }
}
#define QKF_PK4(P, BASE, OUT) do { unsigned a0_ = cvtpk(P[BASE + 0], P[BASE + 1]), a1_ = cvtpk(P[BASE + 2], P[BASE + 3]);   \
    unsigned b0_ = cvtpk(P[BASE + 4], P[BASE + 5]), b1_ = cvtpk(P[BASE + 6], P[BASE + 7]);                              \
    auto r0_ = __builtin_amdgcn_permlane32_swap(a0_, b0_, false, false); auto r1_ = __builtin_amdgcn_permlane32_swap(a1_, b1_, false, false); \
    u32x4 w_ = {r0_[0], r1_[0], r0_[1], r1_[1]}; OUT = *reinterpret_cast<bf16x8*>(&w_); } while (0)
__device__ __forceinline__ void qk_fsm(f32x16& x0, f32x16& x1, const char* Ks, const bf16x8* qr, int r32, int hi,
                                       f32x16& y0, f32x16& y1, float alpha, float& l_reg, bf16x8& pa0, bf16x8& pa1, bf16x8& pa2, bf16x8& pa3) {
  x0 = f32x16{}; x1 = f32x16{};
  int rsw = ((r32 >> 1) & 7) << 4; asm volatile("" : "+v"(rsw));
  const char* Kr = Ks + r32 * 384;
#define QKF_RD(D0, B0, B1) do { const int cb_ = ((D0) * 16 + hi * 8) * 2; B0 = *reinterpret_cast<const bf16x8*>(Kr + (cb_ ^ rsw)); B1 = *reinterpret_cast<const bf16x8*>(Kr + 32 * 384 + (cb_ ^ rsw)); } while (0)
#define QKF_MM(D0, B0, B1) do { x0 = __builtin_amdgcn_mfma_f32_32x32x16_bf16(B0, qr[D0], x0, 0, 0, 0); x1 = __builtin_amdgcn_mfma_f32_32x32x16_bf16(B1, qr[D0], x1, 0, 0, 0); } while (0)
#define QKF_EXP(K) do { y1[2 * (K)] = __builtin_amdgcn_exp2f(y1[2 * (K)]); y1[2 * (K) + 1] = __builtin_amdgcn_exp2f(y1[2 * (K) + 1]); ps += y0[2 * (K)] + y0[2 * (K) + 1]; \
    if ((K) >= 1) ps += y1[2 * (K) - 2] + y1[2 * (K) - 1]; } while (0)
  bf16x8 a0, a1, b0, b1; float ps = 0.f;
  QKF_RD(0, a0, a1);
  QKF_RD(1, b0, b1);  QKF_MM(0, a0, a1);  QKF_EXP(0); SBAR();
  QKF_RD(2, a0, a1);  QKF_MM(1, b0, b1);  QKF_EXP(1); SBAR();
  QKF_RD(3, b0, b1);  QKF_MM(2, a0, a1);  QKF_EXP(2); SBAR();
  QKF_RD(4, a0, a1);  QKF_MM(3, b0, b1);  QKF_EXP(3); SBAR();
  QKF_RD(5, b0, b1);  QKF_MM(4, a0, a1);  QKF_EXP(4); SBAR();
  QKF_RD(6, a0, a1);  QKF_MM(5, b0, b1);  QKF_EXP(5); SBAR();
  QKF_RD(7, b0, b1);  QKF_MM(6, a0, a1);  QKF_EXP(6); SBAR();
  QKF_RD(8, a0, a1);  QKF_MM(7, b0, b1);  QKF_EXP(7); SBAR();
  QKF_RD(9, b0, b1);  QKF_MM(8, a0, a1);
  ps += y1[14] + y1[15];
  { auto rr = __builtin_amdgcn_permlane32_swap(__float_as_uint(ps), __float_as_uint(ps), false, false); ps = __uint_as_float(rr[0]) + __uint_as_float(rr[1]); }
  l_reg = l_reg * alpha + ps; QKF_PK4(y0, 0, pa0); SBAR();
  QKF_RD(10, a0, a1); QKF_MM(9, b0, b1);  QKF_PK4(y0, 8, pa1); SBAR();
  QKF_RD(11, b0, b1); QKF_MM(10, a0, a1); QKF_PK4(y1, 0, pa2); SBAR();
  QKF_MM(11, b0, b1); QKF_PK4(y1, 8, pa3);
#undef QKF_RD
#undef QKF_MM
#undef QKF_EXP
}
#undef QKF_PK4
__device__ __forceinline__ int v_st(int k, int c) { const int kk = (k & ~0xC) | ((k & 4) << 1) | ((k & 8) >> 1); return ((kk >> 3) * 4 + (c >> 5)) * 512 + ((kk & 7) * 32 + (c & 31)) * 2; }
__device__ __forceinline__ int v_rd_base(int lane) { return ((lane & 3) << 3) | (((lane >> 2) & 3) << 6) | (((lane >> 4) & 1) << 5) | (((lane >> 5) & 1) << 8); }
constexpr int v_rd_off(int d0, int ks, int half) { return d0 * 512 + ks * 4096 + half * 2048; }
template <int OFF> __device__ __forceinline__ s16x4 tr_read(int vb) {
  s16x4 r; asm volatile("ds_read_b64_tr_b16 %0, %1 offset:%2" : "=&v"(r) : "v"(vb), "i"(OFF) : "memory"); return r;
}
template <int KS> __device__ __forceinline__ void pv_step(f32x16* o, int vb, bf16x8 pa) {
  const s16x4 l0 = tr_read<v_rd_off(0, KS, 0)>(vb), h0 = tr_read<v_rd_off(0, KS, 1)>(vb), l1 = tr_read<v_rd_off(1, KS, 0)>(vb), h1 = tr_read<v_rd_off(1, KS, 1)>(vb);
  const s16x4 l2 = tr_read<v_rd_off(2, KS, 0)>(vb), h2 = tr_read<v_rd_off(2, KS, 1)>(vb), l3 = tr_read<v_rd_off(3, KS, 0)>(vb), h3 = tr_read<v_rd_off(3, KS, 1)>(vb);
  asm volatile("s_waitcnt lgkmcnt(0)" ::: "memory"); SBAR();
#define PK(L, H) (bf16x8){L[0], L[1], L[2], L[3], H[0], H[1], H[2], H[3]}
  o[0] = __builtin_amdgcn_mfma_f32_32x32x16_bf16(pa, PK(l0, h0), o[0], 0, 0, 0);
  o[1] = __builtin_amdgcn_mfma_f32_32x32x16_bf16(pa, PK(l1, h1), o[1], 0, 0, 0);
  o[2] = __builtin_amdgcn_mfma_f32_32x32x16_bf16(pa, PK(l2, h2), o[2], 0, 0, 0);
  o[3] = __builtin_amdgcn_mfma_f32_32x32x16_bf16(pa, PK(l3, h3), o[3], 0, 0, 0);
#undef PK
}
__device__ __forceinline__ void pv_d0(f32x16* o, int vb, bf16x8 pa0, bf16x8 pa1, bf16x8 pa2, bf16x8 pa3) {
  pv_step<0>(o, vb, pa0); pv_step<1>(o, vb, pa1); pv_step<2>(o, vb, pa2); pv_step<3>(o, vb, pa3);
}
#define PVS_READS(KS) const s16x4 l0_##KS = tr_read<v_rd_off(0, KS, 0)>(vb), h0_##KS = tr_read<v_rd_off(0, KS, 1)>(vb), l1_##KS = tr_read<v_rd_off(1, KS, 0)>(vb), h1_##KS = tr_read<v_rd_off(1, KS, 1)>(vb), \
    l2_##KS = tr_read<v_rd_off(2, KS, 0)>(vb), h2_##KS = tr_read<v_rd_off(2, KS, 1)>(vb), l3_##KS = tr_read<v_rd_off(3, KS, 0)>(vb), h3_##KS = tr_read<v_rd_off(3, KS, 1)>(vb)
#define PVS_PK(L, H) (bf16x8){L[0], L[1], L[2], L[3], H[0], H[1], H[2], H[3]}
#define PVS_MMA(KS, PA) do { asm volatile("s_waitcnt lgkmcnt(0)" ::: "memory"); SBAR(); \
    o[0] = __builtin_amdgcn_mfma_f32_32x32x16_bf16(PA, PVS_PK(l0_##KS, h0_##KS), o[0], 0, 0, 0); o[1] = __builtin_amdgcn_mfma_f32_32x32x16_bf16(PA, PVS_PK(l1_##KS, h1_##KS), o[1], 0, 0, 0); \
    o[2] = __builtin_amdgcn_mfma_f32_32x32x16_bf16(PA, PVS_PK(l2_##KS, h2_##KS), o[2], 0, 0, 0); o[3] = __builtin_amdgcn_mfma_f32_32x32x16_bf16(PA, PVS_PK(l3_##KS, h3_##KS), o[3], 0, 0, 0); SBAR(); } while (0)
__device__ __forceinline__ void pv_psm(f32x16* o, int vb, bf16x8 pa0, bf16x8 pa1, bf16x8 pa2, bf16x8 pa3, f32x16& p0, f32x16& p1, float& m_reg, float& mn, float& alpha) {
  constexpr float C = SCALE * 1.4426950408889634f;
  PVS_READS(0);
  PVS_MMA(0, pa0);
  PVS_READS(1);
  float pmax = p0[0];
#pragma unroll
  for (int r = 1; r < 16; ++r) pmax = fmaxf(pmax, p0[r]);
#pragma unroll
  for (int r = 0; r < 16; ++r) pmax = fmaxf(pmax, p1[r]);
  PVS_MMA(1, pa1);
  PVS_READS(2);
  { auto rr = __builtin_amdgcn_permlane32_swap(__float_as_uint(pmax), __float_as_uint(pmax), false, false);
    pmax = fmaxf(__uint_as_float(rr[0]), __uint_as_float(rr[1])); }
  if (__builtin_expect(__all(pmax - m_reg <= THR / SCALE), 1)) { mn = m_reg; alpha = 1.f; }
  else { mn = fmaxf(m_reg, pmax); alpha = __builtin_amdgcn_exp2f((m_reg - mn) * C); m_reg = mn; }
  const float mnC = -mn * C;
  PVS_MMA(2, pa2);
  PVS_READS(3);
#pragma unroll
  for (int r = 0; r < 16; ++r) p0[r] = fmaf(p0[r], C, mnC);
#pragma unroll
  for (int r = 0; r < 16; ++r) p1[r] = fmaf(p1[r], C, mnC);
  PVS_MMA(3, pa3);
#pragma unroll
  for (int r = 0; r < 16; ++r) p0[r] = __builtin_amdgcn_exp2f(p0[r]);
}
#undef PVS_READS
#undef PVS_PK
#undef PVS_MMA

constexpr size_t OFFTAB = 3 * SHM_V + 3 * SHM_K + NW * 64 * 4;
__device__ __forceinline__ void attn_offsets_init(char* lds) {
  const int tid = threadIdx.x; u32x4 r;
  { const int p = tid, row = p / 24, ch = p - row * 24; r.x = (unsigned)(row * 384 + ((ch ^ ((row >> 1) & 7)) << 4)); }
  { const int p = 512 + tid, row = p / 24, ch = p - row * 24; r.y = (unsigned)(row * 384 + ((ch ^ ((row >> 1) & 7)) << 4)); }
  { const int p = 1024 + tid, row = p / 24, ch = p - row * 24; r.z = (unsigned)(row * 384 + ((ch ^ ((row >> 1) & 7)) << 4)); }
  { const int p = tid, st = p >> 5, wi = p & 31, kk = (st >> 2) * 8 + (wi >> 2), c = (st & 3) * 32 + (wi & 3) * 8;
    const int k = (kk & ~0xC) | ((kk & 4) << 1) | ((kk & 8) >> 1); r.w = (unsigned)(k * 256 + c * 2); }
  *(reinterpret_cast<u32x4*>(lds + OFFTAB) + tid) = r;
  __syncthreads();
}
constexpr size_t RING_V = 0, RING_K = 3 * SHM_V, RING_END = 3 * SHM_V + 3 * SHM_K;
__device__ __forceinline__ void attn_unit(const bf16_t* __restrict__ Qb, const bf16_t* __restrict__ Kh, const bf16_t* __restrict__ Vh, bf16_t* __restrict__ Ob, char* lds, LAS unsigned char* ldsl) {
  const int tid = threadIdx.x, wid = tid >> 6, lane = tid & 63, r32 = lane & 31, hi = lane >> 5;
  char* V_lds = lds + RING_V; char* K_lds = lds + RING_K;
  float* wsf = (float*)(lds + RING_END) + wid * 64; float* li_l = wsf; float* al_l = wsf + 32;
  float m_reg = -1e30f, l_reg = 0; f32x16 o[4] = {}; bf16x8 qr[12];
  const bf16_t* Qw = Qb + (long)(wid * QBLK + r32) * QKD + hi * 8;
#pragma unroll
  for (int d0 = 0; d0 < 12; ++d0) qr[d0] = *reinterpret_cast<const bf16x8*>(Qw + d0 * 16);
  const int widu = __builtin_amdgcn_readfirstlane(wid);
  const int vb0 = (int)(uintptr_t)V_lds + v_rd_base(lane);
  const u32x4* offrec = reinterpret_cast<const u32x4*>(lds + OFFTAB) + tid;
#define DMA_K(tile, buf) do { const char* kg_ = (const char*)Kh + (size_t)(tile) * (KVBLK * QKD * 2); const u32x4 vo_ = *offrec; \
    __builtin_amdgcn_global_load_lds((const unsigned*)(kg_ + vo_.x), (LAS unsigned*)(ldsl + RING_K + (buf) * SHM_K + 0 * 8192 + widu * 1024), 16, 0, 0); \
    __builtin_amdgcn_global_load_lds((const unsigned*)(kg_ + vo_.y), (LAS unsigned*)(ldsl + RING_K + (buf) * SHM_K + 1 * 8192 + widu * 1024), 16, 0, 0); \
    __builtin_amdgcn_global_load_lds((const unsigned*)(kg_ + vo_.z), (LAS unsigned*)(ldsl + RING_K + (buf) * SHM_K + 2 * 8192 + widu * 1024), 16, 0, 0); } while (0)
#define DMA_V(tile, buf) do { const char* vg_ = (const char*)Vh + (size_t)(tile) * (KVBLK * VD * 2); const unsigned vo_ = (*offrec).w; \
    __builtin_amdgcn_global_load_lds((const unsigned*)(vg_ + vo_), (LAS unsigned*)(ldsl + RING_V + (buf) * SHM_V + 0 * 8192 + widu * 1024), 16, 0, 0); \
    __builtin_amdgcn_global_load_lds((const unsigned*)(vg_ + vo_ + 8192u), (LAS unsigned*)(ldsl + RING_V + (buf) * SHM_V + 1 * 8192 + widu * 1024), 16, 0, 0); } while (0)
#define RESC(a) do { if (__any((a) < 1.f)) { if (hi == 0) al_l[r32] = (a); asm volatile("s_waitcnt lgkmcnt(0)" ::: "memory"); \
    _Pragma("unroll") for (int d = 0; d < 4; ++d) _Pragma("unroll") for (int r = 0; r < 16; ++r) o[d][r] *= al_l[crow(r, hi)]; } } while (0)
#define TILE_BAR() do { asm volatile("s_waitcnt vmcnt(0)" ::: "memory"); __syncthreads(); } while (0)
  f32x16 pA0, pA1, pB0, pB1; float mnA, mnB, alA, alB; bf16x8 pa0, pa1, pa2, pa3; constexpr int NT = SKV / KVBLK;
  DMA_K(0, 0); DMA_K(1, 1); DMA_V(0, 0);
  TILE_BAR();
  DMA_K(2, 2); DMA_V(1, 1);
  qkt(pA0, pA1, K_lds, qr, r32, hi); partialSM(pA0, pA1, m_reg, mnA, alA);
  int b1 = 1, b0 = 0;
  for (int j = 1; j + 1 < NT; j += 2) {
    TILE_BAR();
    { const int b2 = (b1 == 2) ? 0 : b1 + 1;
      if (j + 2 < NT) DMA_K(j + 2, b0);
      DMA_V(j + 1, b2);
      SBAR(); qk_fsm(pB0, pB1, K_lds + b1 * SHM_K, qr, r32, hi, pA0, pA1, alA, l_reg, pa0, pa1, pa2, pa3); SBAR();
      pv_psm(o, vb0 + b0 * (int)SHM_V, pa0, pa1, pa2, pa3, pB0, pB1, m_reg, mnB, alB);
      RESC(alB);
      b0 = b1; b1 = b2; }
    TILE_BAR();
    { const int b2 = (b1 == 2) ? 0 : b1 + 1;
      if (j + 3 < NT) DMA_K(j + 3, b0);
      if (j + 2 < NT) DMA_V(j + 2, b2);
      SBAR(); qk_fsm(pA0, pA1, K_lds + b1 * SHM_K, qr, r32, hi, pB0, pB1, alB, l_reg, pa0, pa1, pa2, pa3); SBAR();
      pv_psm(o, vb0 + b0 * (int)SHM_V, pa0, pa1, pa2, pa3, pA0, pA1, m_reg, mnA, alA);
      RESC(alA);
      b0 = b1; b1 = b2; }
  }
  TILE_BAR();
  SBAR(); qk_fsm(pB0, pB1, K_lds + b1 * SHM_K, qr, r32, hi, pA0, pA1, alA, l_reg, pa0, pa1, pa2, pa3); SBAR();
  pv_psm(o, vb0 + b0 * (int)SHM_V, pa0, pa1, pa2, pa3, pB0, pB1, m_reg, mnB, alB);
  RESC(alB);
  finishSM(pB0, pB1, alB, l_reg, pa0, pa1, pa2, pa3); SBAR();
  pv_d0(o, vb0 + b1 * (int)SHM_V, pa0, pa1, pa2, pa3);
  if (hi == 0) li_l[r32] = l_reg; asm volatile("s_waitcnt lgkmcnt(0)" ::: "memory");
  float rli[16];
#pragma unroll
  for (int r = 0; r < 16; ++r) rli[r] = __builtin_amdgcn_rcpf(li_l[crow(r, hi)]);
  bf16_t* Ow = Ob + (long)(wid * QBLK) * DM;
#pragma unroll
  for (int r = 0; r < 16; ++r) { int orow = crow(r, hi);
#pragma unroll
    for (int d0 = 0; d0 < 4; ++d0) Ow[(long)orow * DM + d0 * 32 + r32] = (bf16_t)f2bf(o[d0][r] * rli[r]); }
  __syncthreads();
#undef DMA_K
#undef DMA_V
#undef RESC
#undef TILE_BAR
}
}


#define XB_TMO      128
#define XB_XCNT(j)  (256  + 64 * (j))
#define XB_XSUB(j)  (1280 + 64 * (j))
#define XB_XGEN(j)  (2304 + 64 * (j))
#define XB_TOP      3328
#define XB_TOPGEN   3392
#define XCD_BAR_WORDS 3456
#define XB_SPIN_CAP (1u << 18)
__device__ __forceinline__ unsigned xb_ld(unsigned* p)              { return __hip_atomic_load(p, __ATOMIC_RELAXED, __HIP_MEMORY_SCOPE_AGENT); }
__device__ __forceinline__ unsigned xb_add(unsigned* p, unsigned v) { return __hip_atomic_fetch_add(p, v, __ATOMIC_RELAXED, __HIP_MEMORY_SCOPE_AGENT); }
__device__ __forceinline__ unsigned xb_xcc_id() { return (unsigned)__builtin_amdgcn_s_getreg((3 << 11) | 20) & 0xFu; }
#define XB_SPIN(cond, bar) do { unsigned _sp = 0; while (cond) { __builtin_amdgcn_s_sleep(1); \
    if ((++_sp & 255u) == 0u) { if (xb_ld(&(bar)[XB_TMO])) break; if (_sp > XB_SPIN_CAP) { atomicAdd(&(bar)[XB_TMO], 1u); break; } } } } while (0)
struct XcdBarrier { unsigned* bar; unsigned x; volatile LAS unsigned* st; };
__device__ __forceinline__ XcdBarrier xcd_barrier_post(unsigned* bar, volatile LAS unsigned* st) {
    XcdBarrier b; b.bar = bar; b.x = xb_xcc_id(); b.st = st;
    if (threadIdx.x == 0) (void)xb_add(&bar[XB_XCNT(b.x)], 1u);
    return b;
}
__device__ __forceinline__ void xcd_barrier_complete(unsigned* bar, unsigned x, unsigned& nloc, unsigned& nx) {
    const unsigned G = gridDim.x * gridDim.y * gridDim.z;
    unsigned sum, cnt, mine, sp = 0u;
    for (;;) {
        sum = 0u; cnt = 0u; mine = 0u;
#pragma unroll
        for (unsigned j = 0; j < 16; ++j) { const unsigned c = xb_ld(&bar[XB_XCNT(j)]); sum += c; cnt += (c > 0u) ? 1u : 0u; mine = (j == x) ? c : mine; }
        if (sum == G) break;
        __builtin_amdgcn_s_sleep(1);
        if ((++sp & 255u) == 0u) { if (xb_ld(&bar[XB_TMO])) break; if (sp > XB_SPIN_CAP) { atomicAdd(&bar[XB_TMO], 1u); break; } }
    }
    nloc = mine > 0u ? mine : 1u; nx = cnt > 0u ? cnt : 1u;
}
__device__ __forceinline__ void xcd_barrier(const XcdBarrier& b) {
    asm volatile("s_waitcnt vmcnt(0)" ::: "memory");
    __syncthreads();
    if (threadIdx.x == 0) {
        unsigned* bar = b.bar;
        __builtin_amdgcn_s_waitcnt(0);
        unsigned nloc = b.st[0], nx = b.st[1];
        if (nloc == 0u) { xcd_barrier_complete(bar, b.x, nloc, nx); b.st[0] = nloc; b.st[1] = nx; }
        const unsigned old = xb_add(&bar[XB_XSUB(b.x)], 1u);
        const unsigned gen = old / nloc;
        if (old + 1u == (gen + 1u) * nloc) {
            __builtin_amdgcn_fence(__ATOMIC_RELEASE, "agent");
            asm volatile("s_waitcnt vmcnt(0)" ::: "memory");
            const unsigned og = xb_add(&bar[XB_TOP], 1u);
            const unsigned tg = og / nx;
            if (og + 1u == (tg + 1u) * nx) xb_add(&bar[XB_TOPGEN], 1u);
            else XB_SPIN(xb_ld(&bar[XB_TOPGEN]) == tg, bar);
            __builtin_amdgcn_fence(__ATOMIC_ACQUIRE, "agent");
            xb_add(&bar[XB_XGEN(b.x)], 1u);
            asm volatile("s_waitcnt vmcnt(0)" ::: "memory");
        } else {
            XB_SPIN(xb_ld(&bar[XB_XGEN(b.x)]) == gen, bar);
            __builtin_amdgcn_fence(__ATOMIC_ACQUIRE, "agent");
            asm volatile("s_waitcnt vmcnt(0)" ::: "memory");
        }
    }
    __syncthreads();
}

struct Args { const float* in[24]; float* out; unsigned char* ws; int ph_lo, ph_hi; };

template <int MODE> __device__ __forceinline__ int src_col(int n) {
    if (MODE == 1) return n < 832 ? n : (n < 1024 ? -1 : n - 192);
    if (MODE == 2) { const int pn = n >> 8, j = n & 255; return j < 128 ? pn * 128 + j : DFF + pn * 128 + (j - 128); }
    if (MODE == 3) return n < 1024 ? (n >> 7) * 192 + (n & 127) : ((n - 1024) >> 6) * 192 + 128 + ((n - 1024) & 63);
    return n;
}
template <int MODE> __device__ __forceinline__ void tr_item(const float* __restrict__ W, int ldw, int k0, int n0, bf16_t* __restrict__ WT, int ldt, const float* __restrict__ gk, LAS float* scr, int lane) {
    const int sc = src_col<MODE>(n0 + (lane & 31) * 4);
    f32x4 vv[16];
#pragma unroll
    for (int i = 0; i < 16; ++i) { const int kk = 2 * i + (lane >> 5); vv[i] = (f32x4){0.f, 0.f, 0.f, 0.f};
        if (sc >= 0) { vv[i] = *(const f32x4*)(W + (size_t)(k0 + kk) * ldw + sc); } }
#pragma unroll
    for (int i = 0; i < 16; ++i) { const int kk = 2 * i + (lane >> 5); f32x4 v = vv[i]; if (gk) v = v * gk[k0 + kk];
        LAS float* d = scr + kk * 129 + (lane & 31) * 4; d[0] = v.x; d[1] = v.y; d[2] = v.z; d[3] = v.w; }
    LDS_WAIT();
    const int c = lane & 3;
#pragma unroll
    for (int j = 0; j < 8; ++j) { const int n = (lane >> 2) + 16 * j; const LAS float* sp = scr + (8 * c) * 129 + n;
        u32x4 o; o.x = pk2(sp[0 * 129], sp[1 * 129]); o.y = pk2(sp[2 * 129], sp[3 * 129]); o.z = pk2(sp[4 * 129], sp[5 * 129]); o.w = pk2(sp[6 * 129], sp[7 * 129]);
        *(u32x4*)(WT + (size_t)(n0 + n) * ldt + k0 + 8 * c) = o; }
    LDS_WAIT();
}

__global__ void __launch_bounds__(512, 2) fwd_kernel(Args args) {
    extern __shared__ __attribute__((aligned(16))) unsigned char lds[];
    const int tid = threadIdx.x, lane = tid & 63, wave = __builtin_amdgcn_readfirstlane(tid >> 6);
    const int G = gridDim.x, bx = blockIdx.x;
    const int vcu = (G % 8 == 0) ? (bx % 8) * (G / 8) + bx / 8 : bx;
    const int gw = vcu * 8 + wave, NGW = G * 8;
    unsigned char* ws = args.ws;
    const float* x = args.in[0]; const float* cvec = args.in[1]; const float* ctx = args.in[2]; const float* c_ctx = args.in[3];
    const float* w_mod = args.in[4]; const float* b_mod = args.in[5]; const float* norm1_g = args.in[6]; const float* w_in = args.in[7];
    const float* q_norm_g = args.in[8]; const float* kv_norm_g = args.in[9]; const float* w_uq = args.in[10]; const float* w_ukv = args.in[11];
    const float* qk_norm_q = args.in[12]; const float* qk_norm_k = args.in[13]; const float* sgu_norm_g = args.in[14]; const float* sgu_norm_b = args.in[15];
    const float* w_spatial = args.in[16]; const float* b_spatial = args.in[17]; const float* w_br_attn = args.in[18]; const float* w_br_sgu = args.in[19];
    const float* w_out = args.in[20]; const float* norm2_g = args.in[21]; const float* w_ffn_in = args.in[22]; const float* w_ffn_out = args.in[23];
    float* out = args.out;
    float* MOD = (float*)(ws + WS_MOD);
    bf16_t* WIN = (bf16_t*)(ws + WS_WIN); bf16_t* WUQ = (bf16_t*)(ws + WS_WUQ); bf16_t* WUKV = (bf16_t*)(ws + WS_WUKV);
    bf16_t* WBR = (bf16_t*)(ws + WS_WBRA); bf16_t* WOUT = (bf16_t*)(ws + WS_WOUT);
    bf16_t* WFI = (bf16_t*)(ws + WS_WFI); bf16_t* WFO = (bf16_t*)(ws + WS_WFO); bf16_t* WSP = (bf16_t*)(ws + WS_WSP);
    bf16_t* H = (bf16_t*)(ws + WS_H); bf16_t* KVUP = H; bf16_t* AO = H; bf16_t* H2 = H;
    bf16_t* P = (bf16_t*)(ws + WS_P); bf16_t* XN = P; bf16_t* ACT = (bf16_t*)(ws + WS_P + 64 * MiB);
    bf16_t* KF = (bf16_t*)(ws + WS_KF); bf16_t* VF = (bf16_t*)(ws + WS_VF); bf16_t* MERGED = (bf16_t*)(ws + WS_MERGED);
    bf16_t* QUP = (bf16_t*)out; bf16_t* QF = (bf16_t*)((unsigned char*)out + DO_QF);
    const int lo = args.ph_lo, hi = args.ph_hi;
#ifndef PH_MASK
#define PH_MASK 0x7ff
#endif
#define IN(k) ((((PH_MASK) >> (k)) & 1) && lo <= (k) && (k) < hi)
#ifndef PROBE_DUP
#define PROBE_DUP 0
#endif
#define REPS(k) ((((PROBE_DUP) >> (k)) & 1) ? 2 : 1)
#ifdef PROBE_SPIN
    unsigned long long pt0_ = 0;
#define PH_START(k) do { if ((k) == PROBE_SPIN) pt0_ = __builtin_amdgcn_s_memrealtime(); } while (0)
#define PH_END(k) do { if ((k) == PROBE_SPIN) { const unsigned long long t1_ = __builtin_amdgcn_s_memrealtime(), d_ = 4 * (t1_ - pt0_); while (__builtin_amdgcn_s_memrealtime() - t1_ < d_) __builtin_amdgcn_s_sleep(8); } } while (0)
#else
#define PH_START(k) do {} while (0)
#define PH_END(k) do {} while (0)
#endif
#if !MK_LAUNCH_PER_PHASE && !defined(PROBE_SPLIT) && !defined(MK_CG_SYNC)
    volatile LAS unsigned* barst = (volatile LAS unsigned*)((LAS unsigned char*)lds + LDS_BARST);
    if (tid < 2) barst[tid] = 0u;
    __syncthreads();
    const XcdBarrier gbar = xcd_barrier_post((unsigned*)(ws + WS_BAR), barst);
    if (args.ph_lo < 0) cg::this_grid().sync();
#define SEAM(k) do { PH_END(k); if (IN(k) && IN((k) + 1)) { xcd_barrier(gbar); } } while (0)
#else
#define SEAM(k) do { PH_END(k); if (IN(k) && IN((k) + 1)) { cg::this_grid().sync(); } } while (0)
#endif

    if (IN(0)) for (int rep_ = 0; rep_ < REPS(0); ++rep_) { if (rep_) cg::this_grid().sync(); PH_START(0);
        LAS float* sact = (LAS float*)lds;
        LAS float* red = (LAS float*)(lds + 40960);
        for (int i = tid; i < 5 * DM; i += 512) { const float v = (i < 4 * DM) ? cvec[i] : c_ctx[i - 4 * DM]; sact[i] = v / (1.0f + __expf(-v)); }
        __syncthreads();
        for (int cb = bx; cb < NMOD / 48; cb += G) {
            const int n0 = cb * 48, c4 = tid % 12, kg = tid / 12;
            if (kg < 42) {
                f32x4 a[5];
#pragma unroll
                for (int r = 0; r < 5; ++r) a[r] = (f32x4){0.f, 0.f, 0.f, 0.f};
                for (int k0 = kg; k0 < DM; k0 += 42 * 7) {
                    f32x4 w[7];
#pragma unroll
                    for (int u = 0; u < 7; ++u) { const int k = k0 + 42 * u; w[u] = (k < DM) ? *(const f32x4*)(w_mod + (size_t)k * NMOD + n0 + c4 * 4) : (f32x4){0.f, 0.f, 0.f, 0.f}; }
#pragma unroll
                    for (int u = 0; u < 7; ++u) { const int k = (k0 + 42 * u < DM) ? k0 + 42 * u : 0;
#pragma unroll
                        for (int r = 0; r < 5; ++r) a[r] += w[u] * sact[r * DM + k]; } }
#pragma unroll
                for (int r = 0; r < 5; ++r)
#pragma unroll
                    for (int j = 0; j < 4; ++j) red[(kg * 5 + r) * 48 + c4 * 4 + j] = a[r][j];
            }
            __syncthreads();
            if (tid < 240) { const int r = tid / 48, col = tid % 48; float s = 0.f;
                for (int k2 = 0; k2 < 42; ++k2) s += red[(k2 * 5 + r) * 48 + col];
                MOD[(size_t)r * NMOD + n0 + col] = s + b_mod[n0 + col]; }
            __syncthreads();
        }
        LAS float* scr = (LAS float*)(lds + wave * 16512);
        constexpr int I_IN = 64 * 56, I_UQ = 16 * 12, I_UKV = 8 * 16;
        constexpr int NEARLY = I_IN + I_UQ + I_UKV;
        for (int it = gw; it < NEARLY; it += NGW) {
            int r = it;
            if (r < I_IN) { tr_item<1>(w_in, IN_COLS, (r / 56) * 32, (r % 56) * 128, WIN, DM, nullptr, scr, lane); continue; } r -= I_IN;
            if (r < I_UQ) { tr_item<3>(w_uq, NH * QKD, (r / 12) * 32, (r % 12) * 128, WUQ, QL, q_norm_g, scr, lane); continue; } r -= I_UQ;
            tr_item<0>(w_ukv, 2048, (r / 16) * 32, (r % 16) * 128, WUKV, KVL, kv_norm_g, scr, lane);
        }
        for (int i = (bx * 512 + tid); i < 8 * 128 * 128 / 2; i += G * 512) { const f32x2 v = *(const f32x2*)(w_spatial + 2 * (size_t)i); ((unsigned*)WSP)[i] = pk2(v.x, v.y); }
    }
    SEAM(0);

    if (IN(1)) for (int rep_ = 0; rep_ < REPS(1); ++rep_) { if (rep_) cg::this_grid().sync(); PH_START(1);
        for (int row = gw; row < MROWS; row += NGW) {
            const float* src = row < NTOK ? x + (size_t)row * DM : ctx + (size_t)(row - NTOK) * DM;
            const int b = row < NTOK ? row / SEQ : 4;
            const float* sh = MOD + (size_t)b * NMOD; const float* scp = sh + DM;
            f32x4 v[8]; float ss = 0.f;
#pragma unroll
            for (int j = 0; j < 8; ++j) { v[j] = __builtin_nontemporal_load((const f32x4*)(src + (lane + 64 * j) * 4)); ss += (v[j].x * v[j].x + v[j].y * v[j].y) + (v[j].z * v[j].z + v[j].w * v[j].w); }
            const float r = 1.0f / sqrtf(wave_sum(ss) * (1.0f / DM) + EPS);
#pragma unroll
            for (int j = 0; j < 8; ++j) { const int idx = (lane + 64 * j) * 4; const f32x4 g = *(const f32x4*)(norm1_g + idx), s1 = *(const f32x4*)(scp + idx), s0 = *(const f32x4*)(sh + idx);
                const f32x4 o = (v[j] * r * g) * (s1 + 1.0f) + s0;
                u32x2 w; w.x = pk2(o.x, o.y); w.y = pk2(o.z, o.w); *(u32x2*)(H + (size_t)row * DM + idx) = w; }
        }
    }
    SEAM(1);

    if (IN(2)) for (int rep_ = 0; rep_ < REPS(2); ++rep_) { if (rep_) cg::this_grid().sync(); PH_START(2);
        pg8::Gemm g{H, WIN, MROWS, PCOLS, DM, DM, DM}; pg8::ProjOrder S; S.init(G, bx);
        pg8::EpiProj E{P, PCOLS};
        pg8::gemm_phase<pg8::EpiProj, pg8::ProjOrder>((LAS unsigned char*)lds, g, S, E);
        { constexpr int NU = 64 * 28 + 8; const int nlead = NU % G;
          if (bx >= nlead) {
            LAS float* scr = (LAS float*)(lds + wave * 16512);
            constexpr int I_BR = 32 * 16, I_OUT = 64 * 16, I_FI = 64 * 88, I_FO = 176 * 16;
            constexpr int NLATE = 2 * I_BR + I_OUT + I_FI + I_FO;
            const int NW2 = (G - nlead) * 8;
            for (int it = (bx - nlead) * 8 + wave; it < NLATE; it += NW2) {
                int r = it;
                if (r < I_BR) { tr_item<0>(w_br_attn, DM, (r / 16) * 32, (r % 16) * 128, WBR, DM, nullptr, scr, lane); continue; } r -= I_BR;
                if (r < I_BR) { tr_item<0>(w_br_sgu, DM, (r / 16) * 32, (r % 16) * 128, WBR + 1024, DM, nullptr, scr, lane); continue; } r -= I_BR;
                if (r < I_OUT) { tr_item<0>(w_out, DM, (r / 16) * 32, (r % 16) * 128, WOUT, DM, nullptr, scr, lane); continue; } r -= I_OUT;
                if (r < I_FI) { tr_item<2>(w_ffn_in, 2 * DFF, (r / 88) * 32, (r % 88) * 128, WFI, DM, nullptr, scr, lane); continue; } r -= I_FI;
                tr_item<0>(w_ffn_out, DM, (r / 16) * 32, (r % 16) * 128, WFO, DFF, nullptr, scr, lane);
            }
          } }
    }
    SEAM(2);

    if (IN(3)) for (int rep_ = 0; rep_ < REPS(3); ++rep_) { if (rep_) cg::this_grid().sync(); PH_START(3);
        const bool split = (G % 16 == 0);
        for (int pass = 0; pass < (split ? 1 : 2); ++pass) {
            const int sel = split ? ((bx >> 3) & 1) : pass;
            const int Ge = split ? G / 2 : G, ce = split ? ((bx >> 4) * 8 + (bx & 7)) : bx;
            pg8::Gemm g; pg8::EpiBf16 E;
            if (sel == 0) { g = pg8::Gemm{P, WUQ, NTOK, NH * QKD, QL, PCOLS, QL}; E = pg8::EpiBf16{QUP, NH * QKD}; }
            else { g = pg8::Gemm{P + PC_KV, WUKV, MROWS, 2048, KVL, PCOLS, KVL}; E = pg8::EpiBf16{KVUP, 2048}; }
            pg8::StaticOrder S; S.init(g.M, g.N, Ge, ce);
            pg8::gemm_phase<pg8::EpiBf16, pg8::StaticOrder>((LAS unsigned char*)lds, g, S, E);
        }
    }
    SEAM(3);

    if (IN(4)) for (int rep_ = 0; rep_ < REPS(4); ++rep_) { if (rep_) cg::this_grid().sync(); PH_START(4);
        LAS float* T = (LAS float*)(lds + wave * 128);
        for (int t = gw; t < MROWS; t += NGW) {
            const bool lat = t < NTOK;
            const bf16_t* Prow = P + (size_t)t * PCOLS;
            int b, n, m;
            if (lat) { b = t / SEQ; n = t % SEQ; m = n; } else { const int tc = t - NTOK; b = tc / CTXL; n = 0; m = SEQ + tc % CTXL; }
            u32x4 kvw[4];
#pragma unroll
            for (int j = 0; j < 4; ++j) kvw[j] = *(const u32x4*)(KVUP + (size_t)t * 2048 + j * 512 + lane * 8);
            const u32x2 kvcw = *(const u32x2*)(Prow + PC_KV + lane * 4);
            const u32x4 krw = *(const u32x4*)(Prow + PC_KR + (lane & 7) * 8);
            u32x4 qw[3] = {}, qcw = {}, gvw[2] = {};
            if (lat) {
#pragma unroll
                for (int j = 0; j < 3; ++j) qw[j] = *(const u32x4*)(QUP + (size_t)t * (NH * QKD) + j * 512 + lane * 8);
                qcw = *(const u32x4*)(Prow + lane * 8);
#pragma unroll
                for (int j = 0; j < 2; ++j) gvw[j] = *(const u32x4*)(Prow + PC_V + j * 512 + lane * 8);
            }
            const int c = lane & 7; const bool first = (c & 2) == 0;
            float cs[8], sn[8];
#pragma unroll
            for (int e = 0; e < 8; ++e) { cs[e] = 1.f; sn[e] = 0.f; }
            if (lat) { const float pos = (float)((c < 4) ? (n >> 6) : (n & 63));
#pragma unroll
                for (int e = 0; e < 8; ++e) { const int i = (c & 1) * 8 + e; const float freq = exp2f(-(float)i * (13.287712379549449f / 16.0f));
                    float rev = pos * freq * 0.15915494309189535f; rev -= floorf(rev); cs[e] = __builtin_amdgcn_cosf(rev); sn[e] = __builtin_amdgcn_sinf(rev); } }
            float r_kv;
            { const float a0 = bflo(kvcw.x), a1 = bfhi(kvcw.x), a2 = bflo(kvcw.y), a3 = bfhi(kvcw.y);
              r_kv = 1.0f / sqrtf(wave_sum((a0 * a0 + a1 * a1) + (a2 * a2 + a3 * a3)) * (1.0f / KVL) + EPS); }
            float kr[8]; kr[0] = bflo(krw.x); kr[1] = bfhi(krw.x); kr[2] = bflo(krw.y); kr[3] = bfhi(krw.y); kr[4] = bflo(krw.z); kr[5] = bfhi(krw.z); kr[6] = bflo(krw.w); kr[7] = bfhi(krw.w);
            float ss_r = 0.f;
#pragma unroll
            for (int e = 0; e < 8; ++e) ss_r += kr[e] * kr[e];
            ss_r = sum8(ss_r);
            const bool isV = (lane & 16) != 0; const int d8 = (lane & 15) * 8;
#pragma unroll
            for (int j = 0; j < 4; ++j) {
                float f[8]; f[0] = bflo(kvw[j].x); f[1] = bfhi(kvw[j].x); f[2] = bflo(kvw[j].y); f[3] = bfhi(kvw[j].y); f[4] = bflo(kvw[j].z); f[5] = bfhi(kvw[j].z); f[6] = bflo(kvw[j].w); f[7] = bfhi(kvw[j].w);
                float ssn = 0.f;
#pragma unroll
                for (int e = 0; e < 8; ++e) { f[e] *= r_kv; ssn += f[e] * f[e]; }
                ssn = sum16(ssn);
                const int h = 2 * j + (lane >> 5);
                const float rn = 1.0f / sqrtf((ssn + ss_r) * (1.0f / QKD) + EPS);
                if (!isV && (lane & 15) == 0) T[h] = rn;
                float ov[8];
#pragma unroll
                for (int e = 0; e < 8; ++e) ov[e] = isV ? f[e] : f[e] * rn * qk_norm_k[d8 + e];
                u32x4 w; w.x = pk2(ov[0], ov[1]); w.y = pk2(ov[2], ov[3]); w.z = pk2(ov[4], ov[5]); w.w = pk2(ov[6], ov[7]);
                bf16_t* dst = isV ? VF + ((size_t)(b * NH + h) * SKV + m) * VD + d8 : KF + ((size_t)(b * NH + h) * SKV + m) * QKD + d8;
                *(u32x4*)dst = w;
            }
            LDS_WAIT();
            { const int h = lane >> 3; const float rn = T[h];
              float f[8];
#pragma unroll
              for (int e = 0; e < 8; ++e) f[e] = kr[e] * rn * qk_norm_k[128 + c * 8 + e];
              if (lat) {
#pragma unroll
                  for (int e = 0; e < 8; ++e) { const float pr = dppf<DPP_XOR2>(f[e]); f[e] = first ? f[e] * cs[e] - pr * sn[e] : f[e] * cs[e] + pr * sn[e]; } }
              u32x4 w; w.x = pk2(f[0], f[1]); w.y = pk2(f[2], f[3]); w.z = pk2(f[4], f[5]); w.w = pk2(f[6], f[7]);
              *(u32x4*)(KF + ((size_t)(b * NH + h) * SKV + m) * QKD + 128 + c * 8) = w; }
            if (lat) {
                float r_q;
                { float s2 = 0.f;
                  s2 += bflo(qcw.x) * bflo(qcw.x) + bfhi(qcw.x) * bfhi(qcw.x); s2 += bflo(qcw.y) * bflo(qcw.y) + bfhi(qcw.y) * bfhi(qcw.y);
                  s2 += bflo(qcw.z) * bflo(qcw.z) + bfhi(qcw.z) * bfhi(qcw.z); s2 += bflo(qcw.w) * bflo(qcw.w) + bfhi(qcw.w) * bfhi(qcw.w);
                  r_q = 1.0f / sqrtf(wave_sum(s2) * (1.0f / QL) + EPS); }
                float qf[3][8];
#pragma unroll
                for (int j = 0; j < 3; ++j) { qf[j][0] = bflo(qw[j].x); qf[j][1] = bfhi(qw[j].x); qf[j][2] = bflo(qw[j].y); qf[j][3] = bfhi(qw[j].y); qf[j][4] = bflo(qw[j].z); qf[j][5] = bfhi(qw[j].z); qf[j][6] = bflo(qw[j].w); qf[j][7] = bfhi(qw[j].w); }
#pragma unroll
                for (int j = 0; j < 3; ++j) { float sq = 0.f;
#pragma unroll
                    for (int e = 0; e < 8; ++e) { qf[j][e] *= r_q; sq += qf[j][e] * qf[j][e]; }
                    sq = sum8(sq);
                    if (j < 2) { sq += dppf<DPP_MIR>(sq); if ((lane & 15) == 0) T[8 + 4 * j + (lane >> 4)] = sq; }
                    else { if ((lane & 7) == 0) T[16 + (lane >> 3)] = sq; } }
                LDS_WAIT();
#pragma unroll
                for (int j = 0; j < 2; ++j) { const int h = 4 * j + (lane >> 4);
                    const float rn = 1.0f / sqrtf((T[8 + h] + T[16 + h]) * (1.0f / QKD) + EPS);
                    float ov[8];
#pragma unroll
                    for (int e = 0; e < 8; ++e) ov[e] = qf[j][e] * rn * qk_norm_q[d8 + e];
                    u32x4 w; w.x = pk2(ov[0], ov[1]); w.y = pk2(ov[2], ov[3]); w.z = pk2(ov[4], ov[5]); w.w = pk2(ov[6], ov[7]);
                    *(u32x4*)(QF + ((size_t)(b * NH + h) * SEQ + n) * QKD + d8) = w; }
                { const int h = lane >> 3;
                  const float rn = 1.0f / sqrtf((T[8 + h] + T[16 + h]) * (1.0f / QKD) + EPS);
                  float f[8];
#pragma unroll
                  for (int e = 0; e < 8; ++e) f[e] = qf[2][e] * rn * qk_norm_q[128 + c * 8 + e];
#pragma unroll
                  for (int e = 0; e < 8; ++e) { const float pr = dppf<DPP_XOR2>(f[e]); f[e] = first ? f[e] * cs[e] - pr * sn[e] : f[e] * cs[e] + pr * sn[e]; }
                  u32x4 w; w.x = pk2(f[0], f[1]); w.y = pk2(f[2], f[3]); w.z = pk2(f[4], f[5]); w.w = pk2(f[6], f[7]);
                  *(u32x4*)(QF + ((size_t)(b * NH + h) * SEQ + n) * QKD + 128 + c * 8) = w; }
                LDS_WAIT();
                bf16_t* vp = (bf16_t*)Prow + PC_V;
                float f[16]; float s = 0.f;
#pragma unroll
                for (int j = 0; j < 2; ++j) { const u32x4 w = gvw[j];
                    f[j * 8 + 0] = bflo(w.x); f[j * 8 + 1] = bfhi(w.x); f[j * 8 + 2] = bflo(w.y); f[j * 8 + 3] = bfhi(w.y);
                    f[j * 8 + 4] = bflo(w.z); f[j * 8 + 5] = bfhi(w.z); f[j * 8 + 6] = bflo(w.w); f[j * 8 + 7] = bfhi(w.w); }
#pragma unroll
                for (int j = 0; j < 16; ++j) s += f[j];
                const float mu = wave_sum(s) * (1.0f / 1024.0f); float q = 0.f;
#pragma unroll
                for (int j = 0; j < 16; ++j) { f[j] -= mu; q += f[j] * f[j]; }
                const float rstd = 1.0f / sqrtf(wave_sum(q) * (1.0f / 1024.0f) + EPS);
#pragma unroll
                for (int j = 0; j < 2; ++j) { const int c0 = j * 512 + lane * 8; float o[8];
#pragma unroll
                    for (int e = 0; e < 8; ++e) o[e] = f[j * 8 + e] * rstd * sgu_norm_g[c0 + e] + sgu_norm_b[c0 + e];
                    u32x4 w; w.x = pk2(o[0], o[1]); w.y = pk2(o[2], o[3]); w.z = pk2(o[4], o[5]); w.w = pk2(o[6], o[7]);
                    *(u32x4*)(vp + c0) = w; }
            }
        }
    }
    SEAM(4);

    if (IN(5)) for (int rep_ = 0; rep_ < REPS(5); ++rep_) { if (rep_) cg::this_grid().sync(); PH_START(5);
        PH_START(12);
        {
            const int r32 = lane & 31, hi = lane >> 5, ib = wave & 3, chh = wave >> 2;
            LAS unsigned char* ldsl = (LAS unsigned char*)lds;
            const int vbw = (int)(uintptr_t)(char*)lds + att::v_rd_base(lane) + chh * 1024;
#define SGU_DMA(un_, slot_) do { const int ck_ = (un_) >> 3, g_ = (un_) & 7; const char* src_ = (const char*)(P + (size_t)ck_ * 128 * PCOLS + PC_V + g_ * 128); \
    _Pragma("unroll") for (int hb_ = 0; hb_ < 2; ++hb_) _Pragma("unroll") for (int i_ = 0; i_ < 2; ++i_) { const int p_ = i_ * 512 + tid, st_ = p_ >> 5, wi_ = p_ & 31, kk_ = (st_ >> 2) * 8 + (wi_ >> 2), c_ = (st_ & 3) * 32 + (wi_ & 3) * 8; \
        const int k_ = (kk_ & ~0xC) | ((kk_ & 4) << 1) | ((kk_ & 8) >> 1); const size_t vo_ = (size_t)(hb_ * 64 + k_) * (PCOLS * 2) + c_ * 2; \
        __builtin_amdgcn_global_load_lds((const unsigned*)(src_ + vo_), (LAS unsigned*)(ldsl + (slot_) * 32768 + hb_ * 16384 + i_ * 8192 + wave * 1024), 16, 0, 0); } } while (0)
#define SGU_AF(dst, un_) do { const int g_ = (un_) & 7; _Pragma("unroll") for (int ks_ = 0; ks_ < 8; ++ks_) dst[ks_] = *(const bf16x8*)(WSP + ((size_t)g_ * 128 + ib * 32 + r32) * 128 + ks_ * 16 + hi * 8); } while (0)
            bf16x8 af[8], afn[8];
            int un = vcu, slot = 0;
            if (un < 1024) { SGU_DMA(un, 0); SGU_AF(af, un); }
            for (; un < 1024; un += G, slot ^= 1) {
                const int ck = un >> 3, g = un & 7; const size_t t0 = (size_t)ck * 128;
                asm volatile("s_waitcnt vmcnt(0)" ::: "memory"); __syncthreads();
                const int un2 = un + G;
                if (un2 < 1024) { SGU_DMA(un2, slot ^ 1); SGU_AF(afn, un2); }
                f32x4 bsv[4];
#pragma unroll
                for (int q = 0; q < 4; ++q) bsv[q] = *(const f32x4*)(b_spatial + g * 128 + ib * 32 + 8 * q + 4 * hi);
                unsigned short uu[2][16];
#pragma unroll
                for (int d = 0; d < 2; ++d)
#pragma unroll
                    for (int r = 0; r < 16; ++r) uu[d][r] = P[(t0 + ib * 32 + att::crow(r, hi)) * PCOLS + PC_U + g * 128 + (2 * chh + d) * 32 + r32];
                f32x16 acc0 = {}, acc1 = {};
                const int vb = vbw + slot * 32768;
#define SGU_STEP(KS) do { const int vbk_ = vb + ((KS) >> 2) * 16384; \
    const s16x4 l0_ = att::tr_read<att::v_rd_off(0, (KS) & 3, 0)>(vbk_), h0_ = att::tr_read<att::v_rd_off(0, (KS) & 3, 1)>(vbk_), l1_ = att::tr_read<att::v_rd_off(1, (KS) & 3, 0)>(vbk_), h1_ = att::tr_read<att::v_rd_off(1, (KS) & 3, 1)>(vbk_); \
    asm volatile("s_waitcnt lgkmcnt(0)" ::: "memory"); __builtin_amdgcn_sched_barrier(0); \
    acc0 = __builtin_amdgcn_mfma_f32_32x32x16_bf16(af[KS], (bf16x8){l0_[0], l0_[1], l0_[2], l0_[3], h0_[0], h0_[1], h0_[2], h0_[3]}, acc0, 0, 0, 0); \
    acc1 = __builtin_amdgcn_mfma_f32_32x32x16_bf16(af[KS], (bf16x8){l1_[0], l1_[1], l1_[2], l1_[3], h1_[0], h1_[1], h1_[2], h1_[3]}, acc1, 0, 0, 0); } while (0)
                SGU_STEP(0); SGU_STEP(1); SGU_STEP(2); SGU_STEP(3); SGU_STEP(4); SGU_STEP(5); SGU_STEP(6); SGU_STEP(7);
#undef SGU_STEP
#pragma unroll
                for (int r = 0; r < 16; ++r) { const size_t t = t0 + ib * 32 + att::crow(r, hi); const int c = g * 128 + (2 * chh) * 32 + r32; const float bsr = bsv[r >> 2][r & 3];
                    AO[t * DM + 1024 + c] = (bf16_t)f2bf(bf2f(uu[0][r]) * (acc0[r] + bsr));
                    AO[t * DM + 1024 + c + 32] = (bf16_t)f2bf(bf2f(uu[1][r]) * (acc1[r] + bsr)); }
                if (un2 < 1024) {
#pragma unroll
                    for (int ks = 0; ks < 8; ++ks) af[ks] = afn[ks]; }
            }
            __syncthreads();
#undef SGU_DMA
#undef SGU_AF
        }
        PH_END(12);
        att::attn_offsets_init((char*)lds);
        for (int un = vcu; un < NB * NH * (SEQ / 256); un += G) {
            const int bh = un >> 4, qb = un & 15, b = bh >> 3, h = bh & 7;
            att::attn_unit(QF + ((size_t)bh * SEQ + qb * 256) * QKD, KF + (size_t)bh * SKV * QKD, VF + (size_t)bh * SKV * VD,
                           AO + ((size_t)b * SEQ + qb * 256) * DM + h * VD, (char*)lds, (LAS unsigned char*)lds);
        }
    }
    SEAM(5);

    if (IN(6)) for (int rep_ = 0; rep_ < REPS(6); ++rep_) { if (rep_) cg::this_grid().sync(); PH_START(6);
        pg8::Gemm g{AO, WBR, NTOK, DM, DM, DM, DM}; pg8::StaticOrder S; S.init(NTOK, DM, G, bx);
        pg8::EpiMerge E{(const unsigned char*)P + 2 * PC_GA, (const unsigned char*)P + 2 * PC_GA + 2048, 2 * PCOLS, MERGED};
        pg8::gemm_phase<pg8::EpiMerge, pg8::StaticOrder>((LAS unsigned char*)lds, g, S, E);
    }
    SEAM(6);

    if (IN(7)) for (int rep_ = 0; rep_ < REPS(7); ++rep_) { if (rep_) cg::this_grid().sync(); PH_START(7);
        pg8::Gemm g{MERGED, WOUT, NTOK, DM, DM, DM, DM}; pg8::StaticOrder S; S.init(NTOK, DM, G, bx);
        pg8::EpiResToBf16 E{x, XN, MOD + 2 * DM};
        pg8::gemm_phase<pg8::EpiResToBf16, pg8::StaticOrder>((LAS unsigned char*)lds, g, S, E);
    }
    SEAM(7);

    if (IN(8)) for (int rep_ = 0; rep_ < REPS(8); ++rep_) { if (rep_) cg::this_grid().sync(); PH_START(8);
        for (int row = gw; row < NTOK; row += NGW) {
            const bf16_t* src = XN + (size_t)row * DM; const int b = row / SEQ;
            const float* sh = MOD + (size_t)b * NMOD + 3 * DM; const float* scp = sh + DM;
            float v[4][8]; float ss = 0.f;
#pragma unroll
            for (int j = 0; j < 4; ++j) { const u32x4 w = *(const u32x4*)(src + (lane + 64 * j) * 8);
                v[j][0] = bflo(w.x); v[j][1] = bfhi(w.x); v[j][2] = bflo(w.y); v[j][3] = bfhi(w.y); v[j][4] = bflo(w.z); v[j][5] = bfhi(w.z); v[j][6] = bflo(w.w); v[j][7] = bfhi(w.w);
#pragma unroll
                for (int e = 0; e < 8; ++e) ss += v[j][e] * v[j][e]; }
            const float r = 1.0f / sqrtf(wave_sum(ss) * (1.0f / DM) + EPS);
#pragma unroll
            for (int j = 0; j < 4; ++j) { const int idx = (lane + 64 * j) * 8; float o[8];
#pragma unroll
                for (int h2 = 0; h2 < 2; ++h2) { const f32x4 g = *(const f32x4*)(norm2_g + idx + 4 * h2), s1 = *(const f32x4*)(scp + idx + 4 * h2), s0 = *(const f32x4*)(sh + idx + 4 * h2);
#pragma unroll
                    for (int e = 0; e < 4; ++e) o[4 * h2 + e] = (v[j][4 * h2 + e] * r * g[e]) * (s1[e] + 1.0f) + s0[e]; }
                u32x4 w; w.x = pk2(o[0], o[1]); w.y = pk2(o[2], o[3]); w.z = pk2(o[4], o[5]); w.w = pk2(o[6], o[7]); *(u32x4*)(H2 + (size_t)row * DM + idx) = w; }
        }
    }
    SEAM(8);

    if (IN(9)) for (int rep_ = 0; rep_ < REPS(9); ++rep_) { if (rep_) cg::this_grid().sync(); PH_START(9);
        pg8::Gemm g{H2, WFI, NTOK, 2 * DFF, DM, DM, DM}; pg8::StaticOrder S; S.init(NTOK, 2 * DFF, G, bx);
        pg8::EpiFfnIn E{ACT};
        pg8::gemm_phase<pg8::EpiFfnIn, pg8::StaticOrder>((LAS unsigned char*)lds, g, S, E);
    }
    SEAM(9);

    if (IN(10)) for (int rep_ = 0; rep_ < REPS(10); ++rep_) { if (rep_) cg::this_grid().sync(); PH_START(10);
        pg8::Gemm g{ACT, WFO, NTOK, DM, DFF, DFF, DFF}; pg8::StaticOrder S; S.init(NTOK, DM, G, bx);
        pg8::EpiResFromBf16 E{XN, out, MOD + 5 * DM};
        pg8::gemm_phase<pg8::EpiResFromBf16, pg8::StaticOrder>((LAS unsigned char*)lds, g, S, E);
    }
#undef IN
#undef SEAM
}

constexpr int N_PHASES = 11;

extern "C" void kernel_launch(void* const* d_in, const int* in_sizes, int n_in, void* d_out, int out_size, void* d_ws, size_t ws_size, hipStream_t stream) {
    static int grid = 0;
    if (grid == 0) {
        if (n_in != 24 || out_size != NTOK * DM || ws_size < WS_END) { fprintf(stderr, "kernel_launch: unexpected shapes n_in %d out %d ws %zu\n", n_in, out_size, ws_size); grid = -1; return; }
        int dev = 0, cus = 0, per_cu = 0;
        (void)hipGetDevice(&dev); (void)hipDeviceGetAttribute(&cus, hipDeviceAttributeMultiprocessorCount, dev);
        if (hipFuncSetAttribute((const void*)fwd_kernel, hipFuncAttributeMaxDynamicSharedMemorySize, LDS_BYTES) != hipSuccess) { fprintf(stderr, "kernel_launch: hipFuncSetAttribute failed\n"); grid = -1; return; }
        if (hipOccupancyMaxActiveBlocksPerMultiprocessor(&per_cu, (const void*)fwd_kernel, 512, LDS_BYTES) != hipSuccess || per_cu < 1) { fprintf(stderr, "kernel_launch: occupancy query says %d\n", per_cu); per_cu = 1; }
        (void)hipGetLastError();
        grid = cus * per_cu;
    }
    if (grid < 0) return;
    Args a{};
    for (int i = 0; i < 24; ++i) a.in[i] = (const float*)d_in[i];
    a.out = (float*)d_out; a.ws = (unsigned char*)d_ws;
#if MK_LAUNCH_PER_PHASE
    for (int p = 0; p < N_PHASES; ++p) { a.ph_lo = p; a.ph_hi = p + 1;
        hipLaunchKernelGGL(fwd_kernel, dim3(grid), dim3(512), LDS_BYTES, stream, a); }
#else
#ifndef PROBE_SPLIT
    (void)hipMemsetAsync((char*)d_ws + WS_BAR, 0, XCD_BAR_WORDS * 4, stream);
    a.ph_lo = 0; a.ph_hi = N_PHASES;
    void* kargs[] = {&a};
    hipError_t e = hipLaunchCooperativeKernel((const void*)fwd_kernel, dim3(grid), dim3(512), kargs, LDS_BYTES, stream);
    if (e != hipSuccess) fprintf(stderr, "cooperative launch failed: %s (grid %d)\n", hipGetErrorString(e), grid);
#else
    void* kargs[] = {&a};
    a.ph_lo = 0; a.ph_hi = PROBE_SPLIT + 1;
    (void)hipLaunchCooperativeKernel((const void*)fwd_kernel, dim3(grid), dim3(512), kargs, LDS_BYTES, stream);
    a.ph_lo = PROBE_SPLIT; a.ph_hi = N_PHASES;
    (void)hipLaunchCooperativeKernel((const void*)fwd_kernel, dim3(grid), dim3(512), kargs, LDS_BYTES, stream);
#endif
#endif
}
```

```cpp
#include <hip/hip_runtime.h>
#include <hip/hip_cooperative_groups.h>
#include <cstdio>
#include <cstdint>
namespace cg = cooperative_groups;

#ifndef MK_LAUNCH_PER_PHASE
#define MK_LAUNCH_PER_PHASE 0
#endif

#define LAS __attribute__((address_space(3)))
typedef unsigned short bf16_t;
typedef short bf16x8 __attribute__((ext_vector_type(8)));
typedef short s16x4 __attribute__((ext_vector_type(4)));
typedef float f32x2 __attribute__((ext_vector_type(2)));
typedef float f32x4 __attribute__((ext_vector_type(4)));
typedef float f32x16 __attribute__((ext_vector_type(16)));
typedef unsigned u32x2 __attribute__((ext_vector_type(2)));
typedef unsigned u32x4 __attribute__((ext_vector_type(4)));

constexpr int DM = 2048, NB = 4, SEQ = 4096, NTOK = NB * SEQ, CTXL = 256, NCTX = NB * CTXL, MROWS = NTOK + NCTX;
constexpr int NH = 8, QL = 512, KVL = 256, QKD = 192, VD = 128;
constexpr int DFF = 5632, NMOD = 6 * DM;
constexpr int SKV = SEQ + CTXL;
constexpr int PCOLS = 7168;
constexpr int PC_KV = 512, PC_KR = 768, PC_U = 1024, PC_V = 2048, PC_GA = 3072, PC_GS = 5120;
constexpr int IN_COLS = 6976;
constexpr float EPS = 1e-6f;

constexpr size_t MiB = 1u << 20;
constexpr size_t WS_MOD = 0;
constexpr size_t WS_RKV = 256 * 1024;
constexpr size_t WS_BAR = 768 * 1024;
constexpr size_t WS_WIN = 1 * MiB;
constexpr size_t WS_WUQ = 29 * MiB;
constexpr size_t WS_WUKV = 31 * MiB;
constexpr size_t WS_WBRA = 32 * MiB;
constexpr size_t WS_WBRS = 36 * MiB;
constexpr size_t WS_WOUT = 40 * MiB;
constexpr size_t WS_WFI = 48 * MiB;
constexpr size_t WS_WFO = 92 * MiB;
constexpr size_t WS_WSP = 114 * MiB;
constexpr size_t WS_H = 116 * MiB;
constexpr size_t WS_P = 184 * MiB;
constexpr size_t WS_KF = 422 * MiB;
constexpr size_t WS_VF = 473 * MiB;
constexpr size_t WS_MERGED = 422 * MiB;
constexpr size_t WS_END = 512 * MiB;
constexpr size_t DO_QF = 48 * MiB;

constexpr int LDS_BYTES = 139264, LDS_BARST = 139200;

__device__ __forceinline__ unsigned f2bf(float f) { unsigned u = __builtin_bit_cast(unsigned, f); return (u + 0x7fffu + ((u >> 16) & 1u)) >> 16; }
__device__ __forceinline__ unsigned pk2(float lo, float hi) { unsigned r; asm("v_cvt_pk_bf16_f32 %0, %1, %2" : "=v"(r) : "v"(lo), "v"(hi)); return r; }
__device__ __forceinline__ float bf2f(unsigned short b) { return __builtin_bit_cast(float, ((unsigned)b) << 16); }
__device__ __forceinline__ float bflo(unsigned w) { return __builtin_bit_cast(float, w << 16); }
__device__ __forceinline__ float bfhi(unsigned w) { return __builtin_bit_cast(float, w & 0xffff0000u); }
template <int CTRL> __device__ __forceinline__ float dppf(float v) { return __builtin_bit_cast(float, __builtin_amdgcn_update_dpp(0, __builtin_bit_cast(int, v), CTRL, 0xf, 0xf, true)); }
#define DPP_XOR1 0xB1
#define DPP_XOR2 0x4E
#define DPP_HMIR 0x141
#define DPP_MIR  0x140
__device__ __forceinline__ float sum4(float v) { v += dppf<DPP_XOR1>(v); v += dppf<DPP_XOR2>(v); return v; }
__device__ __forceinline__ float sum8(float v) { v = sum4(v); v += dppf<DPP_HMIR>(v); return v; }
__device__ __forceinline__ float sum16(float v) { v = sum8(v); v += dppf<DPP_MIR>(v); return v; }
__device__ __forceinline__ float wave_sum(float v) {
    v = sum16(v);
    const float a = __builtin_bit_cast(float, __builtin_amdgcn_readlane(__builtin_bit_cast(int, v), 0)), b = __builtin_bit_cast(float, __builtin_amdgcn_readlane(__builtin_bit_cast(int, v), 16));
    const float c = __builtin_bit_cast(float, __builtin_amdgcn_readlane(__builtin_bit_cast(int, v), 32)), d = __builtin_bit_cast(float, __builtin_amdgcn_readlane(__builtin_bit_cast(int, v), 48));
    return (a + b) + (c + d);
}
#define LDS_WAIT() asm volatile("s_waitcnt lgkmcnt(0)" ::: "memory")

namespace pg8 {
#define PG8_LAS __attribute__((address_space(3)))
constexpr int BM = 256, BK = 64, HALF = 128, HTB = HALF * BK * 2, STAGE_BYTES = 8 * HTB, NXCD = 8, WGM = 7;
__host__ __device__ __forceinline__ int lds_byte(int r, int c) { const int st = (r >> 4) * 2 + (c >> 5), rr = r & 15, cc = c & 31, ob = rr * 64 + cc * 2; return st * 1024 + (ob ^ (((ob >> 9) & 1) << 5)); }
__host__ __device__ __forceinline__ void stage_rc(int b, int& R, int& C) { const int st = b / 1024, sb = b % 1024, swz = sb ^ (((sb >> 9) & 1) << 5); R = (st >> 1) * 16 + swz / 64; C = (st & 1) * 32 + (swz % 64) / 2; }
__host__ __device__ __forceinline__ int perm32(int rho) { const int n = rho >> 4, i = rho & 15; return 8 * (i >> 2) + 4 * n + (i & 3); }

struct Unit { int pm, pn; };
struct Gemm { const bf16_t* A; const bf16_t* Bt; int M, N, K, lda, ldb; };

struct StaticOrder {
    int nM, nN, nwg, G, c;
    __device__ void init(int M, int N, int G_, int c_) { nM = M / BM; nN = N / BM; nwg = nM * nN; G = G_; c = c_; }
    __device__ bool next(int i, Unit& u) const {
        const long L = (long)i * G + c; if (L >= nwg) return false;
        int wgid = (int)L; { const int q = nwg / NXCD, r = nwg % NXCD, xcd = wgid % NXCD, off = wgid / NXCD; wgid = (xcd < r ? xcd * (q + 1) : r * (q + 1) + (xcd - r) * q) + off; }
        const int nig = WGM * nN, gid = wgid / nig, fm = gid * WGM, gsz = (nM - fm) < WGM ? (nM - fm) : WGM;
        u.pm = fm + ((wgid % nig) % gsz); u.pn = (wgid % nig) / gsz; return true;
    }
    __device__ __forceinline__ void a_ready(const Unit&) const {}
    __device__ __forceinline__ void done(const Unit&) const {}
};
struct ProjOrder {
    StaticOrder S; int G, c;
    __device__ void init(int G_, int c_) { S.init(NTOK, PCOLS, G_, c_); G = G_; c = c_; }
    __device__ bool next(int i, Unit& u) const {
        const long L = (long)i * G + c;
        if (L < S.nwg) return S.next(i, u);
        const int j = (int)(L - S.nwg); if (j >= 8) return false;
        u.pm = 64 + (j >> 1); u.pn = 2 + (j & 1); return true;
    }
    __device__ __forceinline__ void a_ready(const Unit&) const {}
    __device__ __forceinline__ void done(const Unit&) const {}
};

__device__ __forceinline__ unsigned cvt_pk_bf16(float lo, float hi) { unsigned r; asm volatile("v_cvt_pk_bf16_f32 %0, %1, %2" : "=v"(r) : "v"(lo), "v"(hi)); return r; }
__device__ __forceinline__ f32x2 gelu_pk(f32x2 v) {
    const f32x2 av = __builtin_elementwise_abs(v), d = av * 0.2316418882f + 1.0f;
    f32x2 t; t.x = __builtin_amdgcn_rcpf(d.x); t.y = __builtin_amdgcn_rcpf(d.y);
    f32x2 q = t * 0.5307027145f + (-0.7265760135f); q = q * t + 0.7107068705f; q = q * t + (-0.142248368f); q = q * t + 0.127414796f; q = q * t;
    const f32x2 s = (v * v) * (-0.72134752044f);
    f32x2 e; e.x = __builtin_amdgcn_exp2f(s.x); e.y = __builtin_amdgcn_exp2f(s.y);
    const f32x2 m = v * (q * e), r = v - m;
    f32x2 o; o.x = v.x < 0.f ? m.x : r.x; o.y = v.y < 0.f ? m.y : r.y; return o;
}
__device__ __forceinline__ float sigm(float x) { return __builtin_amdgcn_rcpf(1.0f + __builtin_amdgcn_exp2f(-1.4426950408889634f * x)); }

struct EpiProj {
    static constexpr bool PERM = true, AFTER_DRAIN = false, MID = false;
    bf16_t* O; int ldc; float* RKV;
    __device__ __forceinline__ void operator()(const f32x4 (&acc)[2][2][4][2], const Unit& u, int wr, int wc, int fr, int fq) const {
        const int row0 = u.pm * BM + wr * 64 + fr, col0 = u.pn * BM + wc * 32 + 8 * fq;
        const int act = (u.pn < 4) ? 0 : (u.pn < 12 ? 1 : 2);
#pragma unroll
        for (int ai = 0; ai < 2; ++ai)
#pragma unroll
            for (int m = 0; m < 4; ++m) { bf16_t* rowp = O + (size_t)(row0 + ai * HALF + m * 16) * ldc + col0;
                if (u.pn == 2) {
                    float ss = 0.f;
#pragma unroll
                    for (int bj = 0; bj < 2; ++bj)
#pragma unroll
                        for (int n = 0; n < 2; ++n) { const f32x4 q = acc[ai][bj][m][n]; ss += (q[0] * q[0] + q[1] * q[1]) + (q[2] * q[2] + q[3] * q[3]); }
                    ss += __shfl_xor(ss, 16); ss += __shfl_xor(ss, 32);
                    if (fq == 0) RKV[(size_t)(row0 + ai * HALF + m * 16) * 4 + wc] = ss; }
#pragma unroll
                for (int bj = 0; bj < 2; ++bj) { f32x4 v0 = acc[ai][bj][m][0], v1 = acc[ai][bj][m][1];
                    if (act == 1) { f32x2 a = gelu_pk((f32x2){v0[0], v0[1]}), b = gelu_pk((f32x2){v0[2], v0[3]}), c = gelu_pk((f32x2){v1[0], v1[1]}), d = gelu_pk((f32x2){v1[2], v1[3]});
                        v0 = (f32x4){a.x, a.y, b.x, b.y}; v1 = (f32x4){c.x, c.y, d.x, d.y}; }
                    else if (act == 2) {
                        unsigned lo = 0u, hi = 0u;
                        lo = __builtin_amdgcn_cvt_pk_u8_f32(sigm(v0[0]) * 255.f, 0, lo); lo = __builtin_amdgcn_cvt_pk_u8_f32(sigm(v0[1]) * 255.f, 1, lo);
                        lo = __builtin_amdgcn_cvt_pk_u8_f32(sigm(v0[2]) * 255.f, 2, lo); lo = __builtin_amdgcn_cvt_pk_u8_f32(sigm(v0[3]) * 255.f, 3, lo);
                        hi = __builtin_amdgcn_cvt_pk_u8_f32(sigm(v1[0]) * 255.f, 0, hi); hi = __builtin_amdgcn_cvt_pk_u8_f32(sigm(v1[1]) * 255.f, 1, hi);
                        hi = __builtin_amdgcn_cvt_pk_u8_f32(sigm(v1[2]) * 255.f, 2, hi); hi = __builtin_amdgcn_cvt_pk_u8_f32(sigm(v1[3]) * 255.f, 3, hi);
                        const int gidx = (u.pn - 12) * BM + bj * HALF + wc * 32 + 8 * fq;
                        unsigned char* rowb = (unsigned char*)(O + (size_t)(row0 + ai * HALF + m * 16) * ldc) + 6144 + gidx;
                        *(u32x2*)rowb = (u32x2){lo, hi};
                        continue; }
                    u32x4 w; w.x = cvt_pk_bf16(v0[0], v0[1]); w.y = cvt_pk_bf16(v0[2], v0[3]); w.z = cvt_pk_bf16(v1[0], v1[1]); w.w = cvt_pk_bf16(v1[2], v1[3]);
                    *(u32x4*)(rowp + bj * HALF) = w; } }
    }
};
struct EpiBf16 {
    static constexpr bool PERM = true, AFTER_DRAIN = false, MID = false;
    bf16_t* O; int ldc;
    __device__ __forceinline__ void operator()(const f32x4 (&acc)[2][2][4][2], const Unit& u, int wr, int wc, int fr, int fq) const {
        const int row0 = u.pm * BM + wr * 64 + fr, col0 = u.pn * BM + wc * 32 + 8 * fq;
#pragma unroll
        for (int ai = 0; ai < 2; ++ai)
#pragma unroll
            for (int m = 0; m < 4; ++m) { bf16_t* rowp = O + (size_t)(row0 + ai * HALF + m * 16) * ldc + col0;
#pragma unroll
                for (int bj = 0; bj < 2; ++bj) { const f32x4 v0 = acc[ai][bj][m][0], v1 = acc[ai][bj][m][1];
                    u32x4 w; w.x = cvt_pk_bf16(v0[0], v0[1]); w.y = cvt_pk_bf16(v0[2], v0[3]); w.z = cvt_pk_bf16(v1[0], v1[1]); w.w = cvt_pk_bf16(v1[2], v1[3]);
                    *(u32x4*)(rowp + bj * HALF) = w; } }
    }
};
struct EpiKV {
    static constexpr bool PERM = true, AFTER_DRAIN = false, MID = false;
    const float* RKV; bf16_t* KN; bf16_t* VF; int mode; int ldq;
    __device__ __forceinline__ void operator()(const f32x4 (&acc)[2][2][4][2], const Unit& u, int wr, int wc, int fr, int fq) const {
        if (mode == 0) {
            int row0 = u.pm * BM + wr * 64 + fr, col0 = u.pn * BM + wc * 32 + 8 * fq;
            asm volatile("" : "+v"(row0), "+v"(col0));
#pragma unroll
            for (int ai = 0; ai < 2; ++ai)
#pragma unroll
                for (int m = 0; m < 4; ++m) { bf16_t* rowp = KN + (size_t)(row0 + ai * HALF + m * 16) * ldq + col0;
#pragma unroll
                    for (int bj = 0; bj < 2; ++bj) { const f32x4 v0 = acc[ai][bj][m][0], v1 = acc[ai][bj][m][1];
                        u32x4 w; w.x = cvt_pk_bf16(v0[0], v0[1]); w.y = cvt_pk_bf16(v0[2], v0[3]); w.z = cvt_pk_bf16(v1[0], v1[1]); w.w = cvt_pk_bf16(v1[2], v1[3]);
                        *(u32x4*)(rowp + bj * HALF) = w; } }
            return;
        }
        const int h = u.pn; int d0 = wc * 32 + 8 * fq, rb = wr * 64 + fr;
        asm volatile("" : "+v"(d0), "+v"(rb));
        const int b = u.pm < 64 ? (u.pm >> 4) : (u.pm - 64), mb = u.pm < 64 ? (u.pm & 15) * BM : SEQ;
#pragma unroll
        for (int ai = 0; ai < 2; ++ai)
#pragma unroll
            for (int m = 0; m < 4; ++m) { const int rt = rb + ai * HALF + m * 16; const size_t t = (size_t)u.pm * BM + rt;
                const f32x4 p = *(const f32x4*)(RKV + t * 4);
                const float r = 1.0f / sqrtf(((p[0] + p[1]) + (p[2] + p[3])) * (1.0f / KVL) + EPS);
                { const f32x4 v0 = acc[ai][0][m][0] * r, v1 = acc[ai][0][m][1] * r;
                  u32x4 w; w.x = cvt_pk_bf16(v0[0], v0[1]); w.y = cvt_pk_bf16(v0[2], v0[3]); w.z = cvt_pk_bf16(v1[0], v1[1]); w.w = cvt_pk_bf16(v1[2], v1[3]);
                  *(u32x4*)(KN + t * 1024 + h * 128 + d0) = w; }
                { const f32x4 v0 = acc[ai][1][m][0] * r, v1 = acc[ai][1][m][1] * r;
                  u32x4 w; w.x = cvt_pk_bf16(v0[0], v0[1]); w.y = cvt_pk_bf16(v0[2], v0[3]); w.z = cvt_pk_bf16(v1[0], v1[1]); w.w = cvt_pk_bf16(v1[2], v1[3]);
                  *(u32x4*)(VF + ((size_t)(b * NH + h) * SKV + mb + rt) * VD + d0) = w; } }
    }
};
struct EpiMerge {
    static constexpr bool PERM = true, AFTER_DRAIN = false, MID = true;
    const unsigned char* GA; const unsigned char* GS; int ldgb; bf16_t* O;
#define EM_UB(W, I) ((float)(((W) >> (8 * (I))) & 0xffu))
    __device__ __forceinline__ void mid(f32x4 (&acc)[2][2][4][2], const Unit& u, int wr, int wc, int fr, int fq) const {
        int row0 = u.pm * BM + wr * 64 + fr, col0 = u.pn * BM + wc * 32 + 8 * fq;
        asm volatile("" : "+v"(row0), "+v"(col0));
#pragma unroll
        for (int ai = 0; ai < 2; ++ai)
#pragma unroll
            for (int m = 0; m < 4; ++m) { const size_t r = (size_t)(row0 + ai * HALF + m * 16);
#pragma unroll
                for (int bj = 0; bj < 2; ++bj) { const int c = col0 + bj * HALF;
                    const u32x2 ga = *(const u32x2*)(GA + r * ldgb + c), gs = *(const u32x2*)(GS + r * ldgb + c);
                    f32x4 r0, r1;
#pragma unroll
                    for (int j = 0; j < 4; ++j) { r0[j] = EM_UB(ga.x, j) * __builtin_amdgcn_rcpf(fmaxf(EM_UB(gs.x, j), 1.0f)); r1[j] = EM_UB(ga.y, j) * __builtin_amdgcn_rcpf(fmaxf(EM_UB(gs.y, j), 1.0f)); }
                    acc[ai][bj][m][0] = acc[ai][bj][m][0] * r0; acc[ai][bj][m][1] = acc[ai][bj][m][1] * r1; }
                asm volatile("" ::: "memory"); }
    }
    __device__ __forceinline__ void operator()(const f32x4 (&acc)[2][2][4][2], const Unit& u, int wr, int wc, int fr, int fq) const {
        int row0 = u.pm * BM + wr * 64 + fr, col0 = u.pn * BM + wc * 32 + 8 * fq;
        asm volatile("" : "+v"(row0), "+v"(col0));
#pragma unroll
        for (int ai = 0; ai < 2; ++ai)
#pragma unroll
            for (int m = 0; m < 4; ++m) { const size_t r = (size_t)(row0 + ai * HALF + m * 16);
#pragma unroll
                for (int bj = 0; bj < 2; ++bj) { const int c = col0 + bj * HALF;
                    const u32x2 g = *(const u32x2*)(GS + r * ldgb + c);
                    f32x4 g0, g1;
#pragma unroll
                    for (int j = 0; j < 4; ++j) { g0[j] = fmaxf(EM_UB(g.x, j), 1.0f) * (1.0f / 255.0f); g1[j] = fmaxf(EM_UB(g.y, j), 1.0f) * (1.0f / 255.0f); }
                    const f32x4 a0 = acc[ai][bj][m][0] * g0, a1 = acc[ai][bj][m][1] * g1;
                    u32x4 w; w.x = cvt_pk_bf16(a0[0], a0[1]); w.y = cvt_pk_bf16(a0[2], a0[3]); w.z = cvt_pk_bf16(a1[0], a1[1]); w.w = cvt_pk_bf16(a1[2], a1[3]);
                    *(u32x4*)(O + r * DM + c) = w; } }
    }
#undef EM_UB
};
struct EpiRes {
    static constexpr bool PERM = false, AFTER_DRAIN = false, MID = false;
    const float* base; float* out; const float* gate;
    __device__ __forceinline__ void operator()(const f32x4 (&acc)[2][2][4][2], const Unit& u, int wr, int wc, int fr, int fq) const {
        const int row0 = u.pm * BM + wr * 64 + fr, col0 = u.pn * BM + wc * 32 + 4 * fq;
        const float* gp = gate + (size_t)(u.pm >> 4) * NMOD + col0;
        f32x4 gv[2][2];
#pragma unroll
        for (int bj = 0; bj < 2; ++bj)
#pragma unroll
            for (int n = 0; n < 2; ++n) gv[bj][n] = *(const f32x4*)(gp + bj * HALF + n * 16);
#pragma unroll
        for (int ai = 0; ai < 2; ++ai)
#pragma unroll
            for (int m = 0; m < 4; ++m) { const size_t off = (size_t)(row0 + ai * HALF + m * 16) * DM + col0;
#pragma unroll
                for (int bj = 0; bj < 2; ++bj)
#pragma unroll
                    for (int n = 0; n < 2; ++n) { const f32x4 b = *(const f32x4*)(base + off + bj * HALF + n * 16);
                        *(f32x4*)(out + off + bj * HALF + n * 16) = b + gv[bj][n] * acc[ai][bj][m][n]; } }
    }
};
struct EpiResToBf16 {
    static constexpr bool PERM = true, AFTER_DRAIN = false, MID = false;
    const float* base; bf16_t* XN; const float* gate;
    __device__ __forceinline__ void operator()(const f32x4 (&acc)[2][2][4][2], const Unit& u, int wr, int wc, int fr, int fq) const {
        const int row0 = u.pm * BM + wr * 64 + fr, col0 = u.pn * BM + wc * 32 + 8 * fq;
        const float* gp = gate + (size_t)(u.pm >> 4) * NMOD + col0;
        f32x4 gv[2][2];
#pragma unroll
        for (int bj = 0; bj < 2; ++bj)
#pragma unroll
            for (int n = 0; n < 2; ++n) gv[bj][n] = *(const f32x4*)(gp + bj * HALF + 4 * n);
#pragma unroll
        for (int ai = 0; ai < 2; ++ai)
#pragma unroll
            for (int m = 0; m < 4; ++m) { const size_t off = (size_t)(row0 + ai * HALF + m * 16) * DM + col0;
#pragma unroll
                for (int bj = 0; bj < 2; ++bj) { const f32x4 b0 = __builtin_nontemporal_load((const f32x4*)(base + off + bj * HALF)), b1 = __builtin_nontemporal_load((const f32x4*)(base + off + bj * HALF + 4));
                    const f32x4 v0 = b0 + gv[bj][0] * acc[ai][bj][m][0], v1 = b1 + gv[bj][1] * acc[ai][bj][m][1];
                    u32x4 w; w.x = cvt_pk_bf16(v0[0], v0[1]); w.y = cvt_pk_bf16(v0[2], v0[3]); w.z = cvt_pk_bf16(v1[0], v1[1]); w.w = cvt_pk_bf16(v1[2], v1[3]);
                    *(u32x4*)(XN + off + bj * HALF) = w; } }
    }
};
struct EpiResFromBf16 {
    static constexpr bool PERM = false, AFTER_DRAIN = false, MID = false;
    const bf16_t* XN; float* out; const float* gate;
    __device__ __forceinline__ void operator()(const f32x4 (&acc)[2][2][4][2], const Unit& u, int wr, int wc, int fr, int fq) const {
        const int row0 = u.pm * BM + wr * 64 + fr, col0 = u.pn * BM + wc * 32 + 4 * fq;
        const float* gp = gate + (size_t)(u.pm >> 4) * NMOD + col0;
        f32x4 gv[2][2];
#pragma unroll
        for (int bj = 0; bj < 2; ++bj)
#pragma unroll
            for (int n = 0; n < 2; ++n) gv[bj][n] = *(const f32x4*)(gp + bj * HALF + n * 16);
#pragma unroll
        for (int ai = 0; ai < 2; ++ai)
#pragma unroll
            for (int m = 0; m < 4; ++m) { const size_t off = (size_t)(row0 + ai * HALF + m * 16) * DM + col0;
#pragma unroll
                for (int bj = 0; bj < 2; ++bj)
#pragma unroll
                    for (int n = 0; n < 2; ++n) { const u32x2 xb = *(const u32x2*)(XN + off + bj * HALF + n * 16);
                        const f32x4 b = (f32x4){bflo(xb.x), bfhi(xb.x), bflo(xb.y), bfhi(xb.y)};
                        *(f32x4*)(out + off + bj * HALF + n * 16) = b + gv[bj][n] * acc[ai][bj][m][n]; } }
    }
};
struct EpiFfnIn {
    static constexpr bool PERM = true, AFTER_DRAIN = false, MID = false;
    bf16_t* O;
    __device__ __forceinline__ void operator()(const f32x4 (&acc)[2][2][4][2], const Unit& u, int wr, int wc, int fr, int fq) const {
        const int row0 = u.pm * BM + wr * 64 + fr, col0 = u.pn * HALF + wc * 32 + 8 * fq;
#pragma unroll
        for (int ai = 0; ai < 2; ++ai)
#pragma unroll
            for (int m = 0; m < 4; ++m) { bf16_t* rowp = O + (size_t)(row0 + ai * HALF + m * 16) * DFF + col0;
                float o[8];
#pragma unroll
                for (int n = 0; n < 2; ++n)
#pragma unroll
                    for (int j = 0; j < 4; ++j) { const float a = acc[ai][0][m][n][j], b = acc[ai][1][m][n][j]; o[n * 4 + j] = a * sigm(a) * b; }
                u32x4 w; w.x = cvt_pk_bf16(o[0], o[1]); w.y = cvt_pk_bf16(o[2], o[3]); w.z = cvt_pk_bf16(o[4], o[5]); w.w = cvt_pk_bf16(o[6], o[7]);
                *(u32x4*)rowp = w; }
    }
};

template <class Epi, class Sched, bool ALIGN_EPI = true, bool SP2 = true>
__device__ __forceinline__ void gemm_phase(PG8_LAS unsigned char* lds, const Gemm g, const Sched& S, const Epi& E) {
    const int tid = threadIdx.x, wid = __builtin_amdgcn_readfirstlane(tid >> 6), lane = tid & 63, wr = wid >> 2, wc = wid & 3, fr = lane & 15, fq = lane >> 4;
    const int K = g.K, nt = K / BK;
    unsigned voffA[2], voffB[2];
#pragma unroll
    for (int i = 0; i < 2; ++i) { int R, C; stage_rc(tid * 16 + i * 8192, R, C); const int Rb = Epi::PERM ? ((R & ~31) + perm32(R & 31)) : R;
        voffA[i] = (unsigned)(R * g.lda + C) * 2u; voffB[i] = (unsigned)(Rb * g.ldb + C) * 2u; }
    const size_t kstep = (size_t)(BK * 2);
    const size_t hstepA = (size_t)HALF * g.lda * 2, hstepB = (size_t)HALF * g.ldb * 2;
    const size_t tstepA = 2 * hstepA, tstepB = 2 * hstepB;
    const unsigned ldsw = (unsigned)wid * 1024u;
    const int aoff = lds_byte(wr * 64 + fr, fq * 8), boff = lds_byte(wc * 32 + fr, fq * 8);
#define PG8_SA(b, h) (((b) * 2 + (h)) * HTB)
#define PG8_SB(b, h) ((4 + (b) * 2 + (h)) * HTB)
#define PG8_STAGE(bufoff, gbase, voff) do { _Pragma("unroll") for (int _i = 0; _i < 2; ++_i) \
        __builtin_amdgcn_global_load_lds((const unsigned*)((const char*)(gbase) + (voff)[_i]), (PG8_LAS unsigned*)(lds + (bufoff) + ldsw + _i * 8192), 16, 0, 0); } while (0)
#define PG8_LDA(dst, b, h) do { _Pragma("unroll") for (int m = 0; m < 4; ++m) _Pragma("unroll") for (int k = 0; k < 2; ++k) dst[m][k] = *(const PG8_LAS bf16x8*)(lds + PG8_SA(b, h) + aoff + m * 2048 + k * 1024); } while (0)
#define PG8_LDB(dst, b, h) do { _Pragma("unroll") for (int n = 0; n < 2; ++n) _Pragma("unroll") for (int k = 0; k < 2; ++k) dst[n][k] = *(const PG8_LAS bf16x8*)(lds + PG8_SB(b, h) + boff + n * 2048 + k * 1024); } while (0)
#define PG8_MMA(ai, bj, At, Bt) do { __builtin_amdgcn_s_setprio(1); _Pragma("unroll") for (int m = 0; m < 4; ++m) _Pragma("unroll") for (int n = 0; n < 2; ++n) _Pragma("unroll") for (int k = 0; k < 2; ++k) \
        acc[ai][bj][m][n] = __builtin_amdgcn_mfma_f32_16x16x32_bf16(Bt[n][k], At[m][k], acc[ai][bj][m][n], 0, 0, 0); __builtin_amdgcn_s_setprio(0); } while (0)
#define PG8_WAIT_V(n) asm volatile("s_waitcnt vmcnt(" #n ")" ::: "memory")
#define PG8_WAIT_L(n) asm volatile("s_waitcnt lgkmcnt(" #n ")" ::: "memory")
#define PG8_BAR __builtin_amdgcn_s_barrier()
#define PG8_SCHED __builtin_amdgcn_sched_barrier(0)
    Unit cur, nxt; int ui = 0;
    if (!S.next(0, cur)) return;
    f32x4 acc[2][2][4][2];
#pragma unroll
    for (int a = 0; a < 2; ++a)
#pragma unroll
        for (int b = 0; b < 2; ++b)
#pragma unroll
            for (int m = 0; m < 4; ++m)
#pragma unroll
                for (int n = 0; n < 2; ++n) acc[a][b][m][n] = (f32x4){0.f, 0.f, 0.f, 0.f};
    bf16x8 At[4][2], B0[2][2], B1[2][2];
    const char* cA = (const char*)g.A + (size_t)cur.pm * tstepA; const char* cB = (const char*)g.Bt + (size_t)cur.pn * tstepB;
    S.a_ready(cur);
    if constexpr (SP2) {
        PG8_STAGE(PG8_SB(0, 0), cB, voffB); PG8_STAGE(PG8_SB(0, 1), cB + hstepB, voffB); PG8_STAGE(PG8_SA(0, 0), cA, voffA); PG8_STAGE(PG8_SA(0, 1), cA + hstepA, voffA);
        if (wr == 1) PG8_BAR;
        PG8_WAIT_V(2); PG8_BAR;
        PG8_STAGE(PG8_SB(1, 0), cB + kstep, voffB); PG8_STAGE(PG8_SA(1, 0), cA + kstep, voffA); PG8_STAGE(PG8_SB(1, 1), cB + hstepB + kstep, voffB);
        PG8_WAIT_V(6); PG8_BAR;
    } else {
        PG8_STAGE(PG8_SB(0, 0), cB, voffB); PG8_STAGE(PG8_SA(0, 0), cA, voffA); PG8_STAGE(PG8_SB(0, 1), cB + hstepB, voffB); PG8_STAGE(PG8_SA(0, 1), cA + hstepA, voffA);
        if (wr == 1) PG8_BAR;
        PG8_WAIT_V(4); PG8_BAR;
        PG8_STAGE(PG8_SB(1, 0), cB + kstep, voffB); PG8_STAGE(PG8_SA(1, 0), cA + kstep, voffA); PG8_STAGE(PG8_SB(1, 1), cB + hstepB + kstep, voffB);
        PG8_WAIT_V(6); PG8_BAR;
    }
    for (;;) {
        const bool has_next = S.next(ui + 1, nxt);
        const char* nA = has_next ? (const char*)g.A + (size_t)nxt.pm * tstepA : cA; const char* nB = has_next ? (const char*)g.Bt + (size_t)nxt.pn * tstepB : cB;
        for (int t = 0; t < nt; t += 2) {
            const bool last = (t == nt - 2);
            const char* a1 = cA + (size_t)(t + 1) * kstep;
            const char* a2 = last ? nA : cA + (size_t)(t + 2) * kstep; const char* b2 = last ? nB : cB + (size_t)(t + 2) * kstep;
            const char* a3 = a2 + kstep; const char* b3 = b2 + kstep;
            if constexpr (Epi::MID) { if (t == nt / 2) { PG8_SCHED; E.mid(acc, cur, wr, wc, fr, fq); PG8_SCHED; } }
            if (last && has_next) S.a_ready(nxt);
            if constexpr (SP2) {
            PG8_LDB(B0, 0, 0); PG8_LDB(B1, 0, 1); PG8_SCHED; PG8_LDA(At, 0, 0); PG8_STAGE(PG8_SA(1, 1), a1 + hstepA, voffA);
            PG8_WAIT_V(8); PG8_WAIT_L(0); PG8_BAR; PG8_MMA(0, 0, At, B0); PG8_MMA(0, 1, At, B1); PG8_BAR; PG8_SCHED;
            PG8_LDA(At, 0, 1); PG8_STAGE(PG8_SB(0, 0), b2, voffB); PG8_STAGE(PG8_SB(0, 1), b2 + hstepB, voffB); PG8_STAGE(PG8_SA(0, 0), a2, voffA);
            PG8_WAIT_V(8); PG8_WAIT_L(0); PG8_BAR; PG8_MMA(1, 0, At, B0); PG8_MMA(1, 1, At, B1); PG8_BAR; PG8_SCHED;
            PG8_LDB(B0, 1, 0); PG8_LDB(B1, 1, 1); PG8_SCHED; PG8_LDA(At, 1, 0); PG8_STAGE(PG8_SA(0, 1), a2 + hstepA, voffA);
            PG8_WAIT_V(8); PG8_WAIT_L(0); PG8_BAR; PG8_MMA(0, 0, At, B0); PG8_MMA(0, 1, At, B1); PG8_BAR; PG8_SCHED;
            PG8_LDA(At, 1, 1); PG8_STAGE(PG8_SB(1, 0), b3, voffB); PG8_STAGE(PG8_SB(1, 1), b3 + hstepB, voffB); PG8_STAGE(PG8_SA(1, 0), a3, voffA);
            PG8_WAIT_V(8); PG8_WAIT_L(0); PG8_BAR; PG8_MMA(1, 0, At, B0); PG8_MMA(1, 1, At, B1); PG8_BAR; PG8_SCHED;
            } else {
            PG8_LDB(B0, 0, 0); PG8_SCHED; PG8_LDA(At, 0, 0); PG8_STAGE(PG8_SA(1, 1), a1 + hstepA, voffA);
            PG8_WAIT_L(8); PG8_BAR; PG8_WAIT_L(0); PG8_MMA(0, 0, At, B0); PG8_BAR; PG8_SCHED;
            PG8_LDB(B1, 0, 1); PG8_STAGE(PG8_SB(0, 0), b2, voffB);
            PG8_BAR; PG8_WAIT_L(0); PG8_MMA(0, 1, At, B1); PG8_BAR;
            PG8_LDA(At, 0, 1); PG8_STAGE(PG8_SA(0, 0), a2, voffA);
            PG8_BAR; PG8_WAIT_L(0); PG8_MMA(1, 0, At, B0); PG8_BAR; PG8_SCHED;
            PG8_STAGE(PG8_SB(0, 1), b2 + hstepB, voffB);
            PG8_WAIT_V(6); PG8_BAR; PG8_MMA(1, 1, At, B1); PG8_BAR;
            PG8_LDB(B0, 1, 0); PG8_SCHED; PG8_LDA(At, 1, 0); PG8_STAGE(PG8_SA(0, 1), a2 + hstepA, voffA);
            PG8_WAIT_L(8); PG8_BAR; PG8_WAIT_L(0); PG8_MMA(0, 0, At, B0); PG8_BAR; PG8_SCHED;
            PG8_LDB(B1, 1, 1); PG8_STAGE(PG8_SB(1, 0), b3, voffB);
            PG8_BAR; PG8_WAIT_L(0); PG8_MMA(0, 1, At, B1); PG8_BAR;
            PG8_LDA(At, 1, 1); PG8_STAGE(PG8_SA(1, 0), a3, voffA);
            PG8_BAR; PG8_WAIT_L(0); PG8_MMA(1, 0, At, B0); PG8_BAR; PG8_SCHED;
            PG8_STAGE(PG8_SB(1, 1), b3 + hstepB, voffB);
            PG8_WAIT_V(6); PG8_BAR; PG8_MMA(1, 1, At, B1); PG8_BAR;
            }
        }
        if constexpr (ALIGN_EPI) { if (wr == 0) PG8_BAR; }
        if constexpr (!Epi::AFTER_DRAIN) { E(acc, cur, wr, wc, fr, fq); S.done(cur); }
        if (!has_next) break;
#pragma unroll
        for (int a = 0; a < 2; ++a)
#pragma unroll
            for (int b = 0; b < 2; ++b)
#pragma unroll
                for (int m = 0; m < 4; ++m)
#pragma unroll
                    for (int n = 0; n < 2; ++n) acc[a][b][m][n] = (f32x4){0.f, 0.f, 0.f, 0.f};
        cur = nxt; cA = nA; cB = nB; ++ui;
        if constexpr (ALIGN_EPI) { if (wr == 1) PG8_BAR; }
    }
    PG8_WAIT_V(0);
    if constexpr (!ALIGN_EPI) { if (wr == 0) PG8_BAR; }
    PG8_BAR;
#undef PG8_SA
#undef PG8_SB
#undef PG8_STAGE
#undef PG8_LDA
#undef PG8_LDB
#undef PG8_MMA
#undef PG8_WAIT_V
#undef PG8_WAIT_L
#undef PG8_BAR
#undef PG8_SCHED
}
}

namespace att {
constexpr int NW = 8, QBLK = 32, KVBLK = 64;
constexpr float SCALE = 0.07216878364870323f;
constexpr float THR = 8.f;
constexpr size_t SHM_V = KVBLK * VD * 2, SHM_K = KVBLK * QKD * 2;
constexpr size_t SHM_ATTN = 2 * SHM_V + 2 * SHM_K + NW * 64 * 4;
#define KSWZ(row, colB) ((row) * 384 + ((colB) ^ (((row) & 7) << 4)))
#define SBAR() __builtin_amdgcn_sched_barrier(0)
__device__ __forceinline__ int crow(int r, int hi) { return (r & 3) + 8 * (r >> 2) + 4 * hi; }
__device__ __forceinline__ unsigned cvtpk(float lo, float hi) { unsigned r; asm volatile("v_cvt_pk_bf16_f32 %0, %1, %2" : "=v"(r) : "v"(lo), "v"(hi)); return r; }

__device__ __forceinline__ void partialSM(f32x16& p0, f32x16& p1, float& m_reg, float& mn, float& alpha) {
  constexpr float C = SCALE * 1.4426950408889634f;
  float pmax = p0[0];
#pragma unroll
  for (int r = 1; r < 16; ++r) pmax = fmaxf(pmax, p0[r]);
#pragma unroll
  for (int r = 0; r < 16; ++r) pmax = fmaxf(pmax, p1[r]);
  { auto rr = __builtin_amdgcn_permlane32_swap(__float_as_uint(pmax), __float_as_uint(pmax), false, false);
    pmax = fmaxf(__uint_as_float(rr[0]), __uint_as_float(rr[1])); }
  if (__builtin_expect(__all(pmax - m_reg <= THR / SCALE), 1)) { mn = m_reg; alpha = 1.f; }
  else { mn = fmaxf(m_reg, pmax); alpha = __builtin_amdgcn_exp2f((m_reg - mn) * C); m_reg = mn; }
  float mnC = -mn * C;
#pragma unroll
  for (int r = 0; r < 16; ++r) p0[r] = fmaf(p0[r], C, mnC);
#pragma unroll
  for (int r = 0; r < 16; ++r) p1[r] = fmaf(p1[r], C, mnC);
#pragma unroll
  for (int r = 0; r < 16; ++r) p0[r] = __builtin_amdgcn_exp2f(p0[r]);
}
__device__ __forceinline__ void finishSM(f32x16& p0, f32x16& p1, float alpha, float& l_reg, bf16x8& pa0, bf16x8& pa1, bf16x8& pa2, bf16x8& pa3) {
#pragma unroll
  for (int r = 0; r < 16; ++r) p1[r] = __builtin_amdgcn_exp2f(p1[r]);
  float ps = 0;
#pragma unroll
  for (int r = 0; r < 16; ++r) ps += p0[r];
#pragma unroll
  for (int r = 0; r < 16; ++r) ps += p1[r];
  { auto rr = __builtin_amdgcn_permlane32_swap(__float_as_uint(ps), __float_as_uint(ps), false, false);
    ps = __uint_as_float(rr[0]) + __uint_as_float(rr[1]); }
  l_reg = l_reg * alpha + ps;
#define PK4(P, BASE, OUT) do { unsigned a0 = cvtpk(P[BASE + 0], P[BASE + 1]), a1 = cvtpk(P[BASE + 2], P[BASE + 3]);   \
    unsigned b0 = cvtpk(P[BASE + 4], P[BASE + 5]), b1 = cvtpk(P[BASE + 6], P[BASE + 7]);                              \
    auto r0 = __builtin_amdgcn_permlane32_swap(a0, b0, false, false); auto r1 = __builtin_amdgcn_permlane32_swap(a1, b1, false, false); \
    u32x4 w = {r0[0], r1[0], r0[1], r1[1]}; OUT = *reinterpret_cast<bf16x8*>(&w); } while (0)
  PK4(p0, 0, pa0); PK4(p0, 8, pa1); PK4(p1, 0, pa2); PK4(p1, 8, pa3);
#undef PK4
}
__device__ __forceinline__ void qkt(f32x16& p0, f32x16& p1, const char* Ks, const bf16x8* qr, int r32, int hi) {
  p0 = f32x16{}; p1 = f32x16{};
  int rsw = ((r32 >> 1) & 7) << 4; asm volatile("" : "+v"(rsw));
  const char* Kr = Ks + r32 * 384;
#pragma unroll
  for (int d0 = 0; d0 < 12; ++d0) { int cb = (d0 * 16 + hi * 8) * 2;
    bf16x8 b0 = *reinterpret_cast<const bf16x8*>(Kr + (cb ^ rsw));
    bf16x8 b1 = *reinterpret_cast<const bf16x8*>(Kr + 32 * 384 + (cb ^ rsw));
    p0 = __builtin_amdgcn_mfma_f32_32x32x16_bf16(b0, qr[d0], p0, 0, 0, 0);
    p1 = __builtin_amdgcn_mfma_f32_32x32x16_bf16(b1, qr[d0], p1, 0, 0, 0); }
}
#define QKF_PK4(P, BASE, OUT) do { unsigned a0_ = cvtpk(P[BASE + 0], P[BASE + 1]), a1_ = cvtpk(P[BASE + 2], P[BASE + 3]);   \
    unsigned b0_ = cvtpk(P[BASE + 4], P[BASE + 5]), b1_ = cvtpk(P[BASE + 6], P[BASE + 7]);                              \
    auto r0_ = __builtin_amdgcn_permlane32_swap(a0_, b0_, false, false); auto r1_ = __builtin_amdgcn_permlane32_swap(a1_, b1_, false, false); \
    u32x4 w_ = {r0_[0], r1_[0], r0_[1], r1_[1]}; OUT = *reinterpret_cast<bf16x8*>(&w_); } while (0)
__device__ __forceinline__ void qk_fsm(f32x16& x0, f32x16& x1, const char* Ks, const bf16x8* qr, int r32, int hi,
                                       f32x16& y0, f32x16& y1, float alpha, float& l_reg, bf16x8& pa0, bf16x8& pa1, bf16x8& pa2, bf16x8& pa3) {
  x0 = f32x16{}; x1 = f32x16{};
  int rsw = ((r32 >> 1) & 7) << 4; asm volatile("" : "+v"(rsw));
  const char* Kr = Ks + r32 * 384;
#define QKF_RD(D0, B0, B1) do { const int cb_ = ((D0) * 16 + hi * 8) * 2; B0 = *reinterpret_cast<const bf16x8*>(Kr + (cb_ ^ rsw)); B1 = *reinterpret_cast<const bf16x8*>(Kr + 32 * 384 + (cb_ ^ rsw)); } while (0)
#define QKF_MM(D0, B0, B1) do { x0 = __builtin_amdgcn_mfma_f32_32x32x16_bf16(B0, qr[D0], x0, 0, 0, 0); x1 = __builtin_amdgcn_mfma_f32_32x32x16_bf16(B1, qr[D0], x1, 0, 0, 0); } while (0)
#define QKF_EXP(K) do { y1[2 * (K)] = __builtin_amdgcn_exp2f(y1[2 * (K)]); y1[2 * (K) + 1] = __builtin_amdgcn_exp2f(y1[2 * (K) + 1]); ps += y0[2 * (K)] + y0[2 * (K) + 1]; \
    if ((K) >= 1) ps += y1[2 * (K) - 2] + y1[2 * (K) - 1]; } while (0)
  bf16x8 a0, a1, b0, b1; float ps = 0.f;
  QKF_RD(0, a0, a1);
  QKF_RD(1, b0, b1);  QKF_MM(0, a0, a1);  QKF_EXP(0); SBAR();
  QKF_RD(2, a0, a1);  QKF_MM(1, b0, b1);  QKF_EXP(1); SBAR();
  QKF_RD(3, b0, b1);  QKF_MM(2, a0, a1);  QKF_EXP(2); SBAR();
  QKF_RD(4, a0, a1);  QKF_MM(3, b0, b1);  QKF_EXP(3); SBAR();
  QKF_RD(5, b0, b1);  QKF_MM(4, a0, a1);  QKF_EXP(4); SBAR();
  QKF_RD(6, a0, a1);  QKF_MM(5, b0, b1);  QKF_EXP(5); SBAR();
  QKF_RD(7, b0, b1);  QKF_MM(6, a0, a1);  QKF_EXP(6); SBAR();
  QKF_RD(8, a0, a1);  QKF_MM(7, b0, b1);  QKF_EXP(7); SBAR();
  QKF_RD(9, b0, b1);  QKF_MM(8, a0, a1);
  ps += y1[14] + y1[15];
  { auto rr = __builtin_amdgcn_permlane32_swap(__float_as_uint(ps), __float_as_uint(ps), false, false); ps = __uint_as_float(rr[0]) + __uint_as_float(rr[1]); }
  l_reg = l_reg * alpha + ps; QKF_PK4(y0, 0, pa0); SBAR();
  QKF_RD(10, a0, a1); QKF_MM(9, b0, b1);  QKF_PK4(y0, 8, pa1); SBAR();
  QKF_RD(11, b0, b1); QKF_MM(10, a0, a1); QKF_PK4(y1, 0, pa2); SBAR();
  QKF_MM(11, b0, b1); QKF_PK4(y1, 8, pa3);
#undef QKF_RD
#undef QKF_MM
#undef QKF_EXP
}
#undef QKF_PK4
__device__ __forceinline__ int v_st(int k, int c) { const int kk = (k & ~0xC) | ((k & 4) << 1) | ((k & 8) >> 1); return ((kk >> 3) * 4 + (c >> 5)) * 512 + ((kk & 7) * 32 + (c & 31)) * 2; }
__device__ __forceinline__ int v_rd_base(int lane) { return ((lane & 3) << 3) | (((lane >> 2) & 3) << 6) | (((lane >> 4) & 1) << 5) | (((lane >> 5) & 1) << 8); }
constexpr int v_rd_off(int d0, int ks, int half) { return d0 * 512 + ks * 4096 + half * 2048; }
template <int OFF> __device__ __forceinline__ s16x4 tr_read(int vb) {
  s16x4 r; asm volatile("ds_read_b64_tr_b16 %0, %1 offset:%2" : "=&v"(r) : "v"(vb), "i"(OFF) : "memory"); return r;
}
template <int KS> __device__ __forceinline__ void pv_step(f32x16* o, int vb, bf16x8 pa) {
  const s16x4 l0 = tr_read<v_rd_off(0, KS, 0)>(vb), h0 = tr_read<v_rd_off(0, KS, 1)>(vb), l1 = tr_read<v_rd_off(1, KS, 0)>(vb), h1 = tr_read<v_rd_off(1, KS, 1)>(vb);
  const s16x4 l2 = tr_read<v_rd_off(2, KS, 0)>(vb), h2 = tr_read<v_rd_off(2, KS, 1)>(vb), l3 = tr_read<v_rd_off(3, KS, 0)>(vb), h3 = tr_read<v_rd_off(3, KS, 1)>(vb);
  asm volatile("s_waitcnt lgkmcnt(0)" ::: "memory"); SBAR();
#define PK(L, H) (bf16x8){L[0], L[1], L[2], L[3], H[0], H[1], H[2], H[3]}
  o[0] = __builtin_amdgcn_mfma_f32_32x32x16_bf16(pa, PK(l0, h0), o[0], 0, 0, 0);
  o[1] = __builtin_amdgcn_mfma_f32_32x32x16_bf16(pa, PK(l1, h1), o[1], 0, 0, 0);
  o[2] = __builtin_amdgcn_mfma_f32_32x32x16_bf16(pa, PK(l2, h2), o[2], 0, 0, 0);
  o[3] = __builtin_amdgcn_mfma_f32_32x32x16_bf16(pa, PK(l3, h3), o[3], 0, 0, 0);
#undef PK
}
__device__ __forceinline__ void pv_d0(f32x16* o, int vb, bf16x8 pa0, bf16x8 pa1, bf16x8 pa2, bf16x8 pa3) {
  pv_step<0>(o, vb, pa0); pv_step<1>(o, vb, pa1); pv_step<2>(o, vb, pa2); pv_step<3>(o, vb, pa3);
}
#define PVS_READS(KS) const s16x4 l0_##KS = tr_read<v_rd_off(0, KS, 0)>(vb), h0_##KS = tr_read<v_rd_off(0, KS, 1)>(vb), l1_##KS = tr_read<v_rd_off(1, KS, 0)>(vb), h1_##KS = tr_read<v_rd_off(1, KS, 1)>(vb), \
    l2_##KS = tr_read<v_rd_off(2, KS, 0)>(vb), h2_##KS = tr_read<v_rd_off(2, KS, 1)>(vb), l3_##KS = tr_read<v_rd_off(3, KS, 0)>(vb), h3_##KS = tr_read<v_rd_off(3, KS, 1)>(vb)
#define PVS_PK(L, H) (bf16x8){L[0], L[1], L[2], L[3], H[0], H[1], H[2], H[3]}
#define PVS_MMA(KS, PA) do { asm volatile("s_waitcnt lgkmcnt(0)" ::: "memory"); SBAR(); \
    o[0] = __builtin_amdgcn_mfma_f32_32x32x16_bf16(PA, PVS_PK(l0_##KS, h0_##KS), o[0], 0, 0, 0); o[1] = __builtin_amdgcn_mfma_f32_32x32x16_bf16(PA, PVS_PK(l1_##KS, h1_##KS), o[1], 0, 0, 0); \
    o[2] = __builtin_amdgcn_mfma_f32_32x32x16_bf16(PA, PVS_PK(l2_##KS, h2_##KS), o[2], 0, 0, 0); o[3] = __builtin_amdgcn_mfma_f32_32x32x16_bf16(PA, PVS_PK(l3_##KS, h3_##KS), o[3], 0, 0, 0); SBAR(); } while (0)
__device__ __forceinline__ void pv_psm(f32x16* o, int vb, bf16x8 pa0, bf16x8 pa1, bf16x8 pa2, bf16x8 pa3, f32x16& p0, f32x16& p1, float& m_reg, float& mn, float& alpha) {
  constexpr float C = SCALE * 1.4426950408889634f;
  PVS_READS(0);
  PVS_MMA(0, pa0);
  PVS_READS(1);
  float pmax = p0[0];
#pragma unroll
  for (int r = 1; r < 16; ++r) pmax = fmaxf(pmax, p0[r]);
#pragma unroll
  for (int r = 0; r < 16; ++r) pmax = fmaxf(pmax, p1[r]);
  PVS_MMA(1, pa1);
  PVS_READS(2);
  { auto rr = __builtin_amdgcn_permlane32_swap(__float_as_uint(pmax), __float_as_uint(pmax), false, false);
    pmax = fmaxf(__uint_as_float(rr[0]), __uint_as_float(rr[1])); }
  if (__builtin_expect(__all(pmax - m_reg <= THR / SCALE), 1)) { mn = m_reg; alpha = 1.f; }
  else { mn = fmaxf(m_reg, pmax); alpha = __builtin_amdgcn_exp2f((m_reg - mn) * C); m_reg = mn; }
  const float mnC = -mn * C;
  PVS_MMA(2, pa2);
  PVS_READS(3);
#pragma unroll
  for (int r = 0; r < 16; ++r) p0[r] = fmaf(p0[r], C, mnC);
#pragma unroll
  for (int r = 0; r < 16; ++r) p1[r] = fmaf(p1[r], C, mnC);
  PVS_MMA(3, pa3);
#pragma unroll
  for (int r = 0; r < 16; ++r) p0[r] = __builtin_amdgcn_exp2f(p0[r]);
}
#undef PVS_READS
#undef PVS_PK
#undef PVS_MMA

constexpr size_t OFFTAB = 3 * SHM_V + 3 * SHM_K + NW * 64 * 4;
__device__ __forceinline__ void attn_offsets_init(char* lds) {
  const int tid = threadIdx.x; u32x4 r;
  { const int p = tid, row = p / 24, ch = p - row * 24; r.x = (unsigned)(row * 384 + ((ch ^ ((row >> 1) & 7)) << 4)); }
  { const int p = 512 + tid, row = p / 24, ch = p - row * 24; r.y = (unsigned)(row * 384 + ((ch ^ ((row >> 1) & 7)) << 4)); }
  { const int p = 1024 + tid, row = p / 24, ch = p - row * 24; r.z = (unsigned)(row * 384 + ((ch ^ ((row >> 1) & 7)) << 4)); }
  { const int p = tid, st = p >> 5, wi = p & 31, kk = (st >> 2) * 8 + (wi >> 2), c = (st & 3) * 32 + (wi & 3) * 8;
    const int k = (kk & ~0xC) | ((kk & 4) << 1) | ((kk & 8) >> 1); r.w = (unsigned)(k * 256 + c * 2); }
  *(reinterpret_cast<u32x4*>(lds + OFFTAB) + tid) = r;
  __syncthreads();
}
constexpr size_t RING_V = 0, RING_K = 3 * SHM_V, RING_END = 3 * SHM_V + 3 * SHM_K;
__device__ __forceinline__ void attn_unit(const bf16_t* __restrict__ Qb, const bf16_t* __restrict__ Kh, const bf16_t* __restrict__ Vh, bf16_t* __restrict__ Ob, char* lds, LAS unsigned char* ldsl) {
  const int tid = threadIdx.x, wid = tid >> 6, lane = tid & 63, r32 = lane & 31, hi = lane >> 5;
  char* V_lds = lds + RING_V; char* K_lds = lds + RING_K;
  float* wsf = (float*)(lds + RING_END) + wid * 64; float* li_l = wsf; float* al_l = wsf + 32;
  float m_reg = -1e30f, l_reg = 0; f32x16 o[4] = {}; bf16x8 qr[12];
  const bf16_t* Qw = Qb + (long)(wid * QBLK + r32) * QKD + hi * 8;
#pragma unroll
  for (int d0 = 0; d0 < 12; ++d0) qr[d0] = *reinterpret_cast<const bf16x8*>(Qw + d0 * 16);
  const int widu = __builtin_amdgcn_readfirstlane(wid);
  const int vb0 = (int)(uintptr_t)V_lds + v_rd_base(lane);
  const u32x4* offrec = reinterpret_cast<const u32x4*>(lds + OFFTAB) + tid;
#define DMA_K(tile, buf) do { const char* kg_ = (const char*)Kh + (size_t)(tile) * (KVBLK * QKD * 2); const u32x4 vo_ = *offrec; \
    __builtin_amdgcn_global_load_lds((const unsigned*)(kg_ + vo_.x), (LAS unsigned*)(ldsl + RING_K + (buf) * SHM_K + 0 * 8192 + widu * 1024), 16, 0, 0); \
    __builtin_amdgcn_global_load_lds((const unsigned*)(kg_ + vo_.y), (LAS unsigned*)(ldsl + RING_K + (buf) * SHM_K + 1 * 8192 + widu * 1024), 16, 0, 0); \
    __builtin_amdgcn_global_load_lds((const unsigned*)(kg_ + vo_.z), (LAS unsigned*)(ldsl + RING_K + (buf) * SHM_K + 2 * 8192 + widu * 1024), 16, 0, 0); } while (0)
#define DMA_V(tile, buf) do { const char* vg_ = (const char*)Vh + (size_t)(tile) * (KVBLK * VD * 2); const unsigned vo_ = (*offrec).w; \
    __builtin_amdgcn_global_load_lds((const unsigned*)(vg_ + vo_), (LAS unsigned*)(ldsl + RING_V + (buf) * SHM_V + 0 * 8192 + widu * 1024), 16, 0, 0); \
    __builtin_amdgcn_global_load_lds((const unsigned*)(vg_ + vo_ + 8192u), (LAS unsigned*)(ldsl + RING_V + (buf) * SHM_V + 1 * 8192 + widu * 1024), 16, 0, 0); } while (0)
#define RESC(a) do { if (__any((a) < 1.f)) { if (hi == 0) al_l[r32] = (a); asm volatile("s_waitcnt lgkmcnt(0)" ::: "memory"); \
    _Pragma("unroll") for (int d = 0; d < 4; ++d) _Pragma("unroll") for (int r = 0; r < 16; ++r) o[d][r] *= al_l[crow(r, hi)]; } } while (0)
#define TILE_BAR() do { asm volatile("s_waitcnt vmcnt(0)" ::: "memory"); __syncthreads(); } while (0)
  f32x16 pA0, pA1, pB0, pB1; float mnA, mnB, alA, alB; bf16x8 pa0, pa1, pa2, pa3; constexpr int NT = SKV / KVBLK;
  DMA_K(0, 0); DMA_K(1, 1); DMA_V(0, 0);
  TILE_BAR();
  DMA_K(2, 2); DMA_V(1, 1);
  qkt(pA0, pA1, K_lds, qr, r32, hi); partialSM(pA0, pA1, m_reg, mnA, alA);
  int b1 = 1, b0 = 0;
  for (int j = 1; j + 1 < NT; j += 2) {
    TILE_BAR();
    { const int b2 = (b1 == 2) ? 0 : b1 + 1;
      if (j + 2 < NT) DMA_K(j + 2, b0);
      DMA_V(j + 1, b2);
      SBAR(); qk_fsm(pB0, pB1, K_lds + b1 * SHM_K, qr, r32, hi, pA0, pA1, alA, l_reg, pa0, pa1, pa2, pa3); SBAR();
      pv_psm(o, vb0 + b0 * (int)SHM_V, pa0, pa1, pa2, pa3, pB0, pB1, m_reg, mnB, alB);
      RESC(alB);
      b0 = b1; b1 = b2; }
    TILE_BAR();
    { const int b2 = (b1 == 2) ? 0 : b1 + 1;
      if (j + 3 < NT) DMA_K(j + 3, b0);
      if (j + 2 < NT) DMA_V(j + 2, b2);
      SBAR(); qk_fsm(pA0, pA1, K_lds + b1 * SHM_K, qr, r32, hi, pB0, pB1, alB, l_reg, pa0, pa1, pa2, pa3); SBAR();
      pv_psm(o, vb0 + b0 * (int)SHM_V, pa0, pa1, pa2, pa3, pA0, pA1, m_reg, mnA, alA);
      RESC(alA);
      b0 = b1; b1 = b2; }
  }
  TILE_BAR();
  SBAR(); qk_fsm(pB0, pB1, K_lds + b1 * SHM_K, qr, r32, hi, pA0, pA1, alA, l_reg, pa0, pa1, pa2, pa3); SBAR();
  pv_psm(o, vb0 + b0 * (int)SHM_V, pa0, pa1, pa2, pa3, pB0, pB1, m_reg, mnB, alB);
  RESC(alB);
  finishSM(pB0, pB1, alB, l_reg, pa0, pa1, pa2, pa3); SBAR();
  pv_d0(o, vb0 + b1 * (int)SHM_V, pa0, pa1, pa2, pa3);
  if (hi == 0) li_l[r32] = l_reg; asm volatile("s_waitcnt lgkmcnt(0)" ::: "memory");
  float rli[16];
#pragma unroll
  for (int r = 0; r < 16; ++r) rli[r] = __builtin_amdgcn_rcpf(li_l[crow(r, hi)]);
  bf16_t* Ow = Ob + (long)(wid * QBLK) * DM;
#pragma unroll
  for (int r = 0; r < 16; ++r) { int orow = crow(r, hi);
#pragma unroll
    for (int d0 = 0; d0 < 4; ++d0) Ow[(long)orow * DM + d0 * 32 + r32] = (bf16_t)f2bf(o[d0][r] * rli[r]); }
  __syncthreads();
#undef DMA_K
#undef DMA_V
#undef RESC
#undef TILE_BAR
}
}


#define XB_TMO      128
#define XB_XCNT(j)  (256  + 64 * (j))
#define XB_XSUB(j)  (1280 + 64 * (j))
#define XB_XGEN(j)  (2304 + 64 * (j))
#define XB_TOP      3328
#define XB_TOPGEN   3392
#define XCD_BAR_WORDS 3456
#define XB_SPIN_CAP (1u << 18)
__device__ __forceinline__ unsigned xb_ld(unsigned* p)              { return __hip_atomic_load(p, __ATOMIC_RELAXED, __HIP_MEMORY_SCOPE_AGENT); }
__device__ __forceinline__ unsigned xb_add(unsigned* p, unsigned v) { return __hip_atomic_fetch_add(p, v, __ATOMIC_RELAXED, __HIP_MEMORY_SCOPE_AGENT); }
__device__ __forceinline__ unsigned xb_xcc_id() { return (unsigned)__builtin_amdgcn_s_getreg((3 << 11) | 20) & 0xFu; }
#define XB_SPIN(cond, bar) do { unsigned _sp = 0; while (cond) { __builtin_amdgcn_s_sleep(1); \
    if ((++_sp & 255u) == 0u) { if (xb_ld(&(bar)[XB_TMO])) break; if (_sp > XB_SPIN_CAP) { atomicAdd(&(bar)[XB_TMO], 1u); break; } } } } while (0)
struct XcdBarrier { unsigned* bar; unsigned x; volatile LAS unsigned* st; };
__device__ __forceinline__ XcdBarrier xcd_barrier_post(unsigned* bar, volatile LAS unsigned* st) {
    XcdBarrier b; b.bar = bar; b.x = xb_xcc_id(); b.st = st;
    if (threadIdx.x == 0) (void)xb_add(&bar[XB_XCNT(b.x)], 1u);
    return b;
}
__device__ __forceinline__ void xcd_barrier_complete(unsigned* bar, unsigned x, unsigned& nloc, unsigned& nx) {
    const unsigned G = gridDim.x * gridDim.y * gridDim.z;
    unsigned sum, cnt, mine, sp = 0u;
    for (;;) {
        sum = 0u; cnt = 0u; mine = 0u;
#pragma unroll
        for (unsigned j = 0; j < 16; ++j) { const unsigned c = xb_ld(&bar[XB_XCNT(j)]); sum += c; cnt += (c > 0u) ? 1u : 0u; mine = (j == x) ? c : mine; }
        if (sum == G) break;
        __builtin_amdgcn_s_sleep(1);
        if ((++sp & 255u) == 0u) { if (xb_ld(&bar[XB_TMO])) break; if (sp > XB_SPIN_CAP) { atomicAdd(&bar[XB_TMO], 1u); break; } }
    }
    nloc = mine > 0u ? mine : 1u; nx = cnt > 0u ? cnt : 1u;
}
__device__ __forceinline__ void xcd_barrier(const XcdBarrier& b) {
    asm volatile("s_waitcnt vmcnt(0)" ::: "memory");
    __syncthreads();
    if (threadIdx.x == 0) {
        unsigned* bar = b.bar;
        __builtin_amdgcn_s_waitcnt(0);
        unsigned nloc = b.st[0], nx = b.st[1];
        if (nloc == 0u) { xcd_barrier_complete(bar, b.x, nloc, nx); b.st[0] = nloc; b.st[1] = nx; }
        const unsigned old = xb_add(&bar[XB_XSUB(b.x)], 1u);
        const unsigned gen = old / nloc;
        if (old + 1u == (gen + 1u) * nloc) {
            __builtin_amdgcn_fence(__ATOMIC_RELEASE, "agent");
            asm volatile("s_waitcnt vmcnt(0)" ::: "memory");
            const unsigned og = xb_add(&bar[XB_TOP], 1u);
            const unsigned tg = og / nx;
            if (og + 1u == (tg + 1u) * nx) xb_add(&bar[XB_TOPGEN], 1u);
            else XB_SPIN(xb_ld(&bar[XB_TOPGEN]) == tg, bar);
            __builtin_amdgcn_fence(__ATOMIC_ACQUIRE, "agent");
            xb_add(&bar[XB_XGEN(b.x)], 1u);
            asm volatile("s_waitcnt vmcnt(0)" ::: "memory");
        } else {
            XB_SPIN(xb_ld(&bar[XB_XGEN(b.x)]) == gen, bar);
            __builtin_amdgcn_fence(__ATOMIC_ACQUIRE, "agent");
            asm volatile("s_waitcnt vmcnt(0)" ::: "memory");
        }
    }
    __syncthreads();
}

struct Args { const float* in[24]; float* out; unsigned char* ws; int ph_lo, ph_hi; };

template <int MODE> __device__ __forceinline__ int src_col(int n) {
    if (MODE == 1) return n < 832 ? n : (n < 1024 ? -1 : n - 192);
    if (MODE == 2) { const int pn = n >> 8, j = n & 255; return j < 128 ? pn * 128 + j : DFF + pn * 128 + (j - 128); }
    if (MODE == 3) return n < 1024 ? (n >> 7) * 192 + (n & 127) : ((n - 1024) >> 6) * 192 + 128 + ((n - 1024) & 63);
    return n;
}
template <int MODE> __device__ __forceinline__ void tr_item(const float* __restrict__ W, int ldw, int k0, int n0, bf16_t* __restrict__ WT, int ldt, const float* __restrict__ gk, LAS float* scr, int lane) {
    const int sc = src_col<MODE>(n0 + (lane & 31) * 4);
    f32x4 vv[16];
#pragma unroll
    for (int i = 0; i < 16; ++i) { const int kk = 2 * i + (lane >> 5); vv[i] = (f32x4){0.f, 0.f, 0.f, 0.f};
        if (sc >= 0) { vv[i] = *(const f32x4*)(W + (size_t)(k0 + kk) * ldw + sc); } }
#pragma unroll
    for (int i = 0; i < 16; ++i) { const int kk = 2 * i + (lane >> 5); f32x4 v = vv[i]; if (gk) v = v * gk[k0 + kk];
        LAS float* d = scr + kk * 129 + (lane & 31) * 4; d[0] = v.x; d[1] = v.y; d[2] = v.z; d[3] = v.w; }
    LDS_WAIT();
    const int c = lane & 3;
#pragma unroll
    for (int j = 0; j < 8; ++j) { const int n = (lane >> 2) + 16 * j; const LAS float* sp = scr + (8 * c) * 129 + n;
        u32x4 o; o.x = pk2(sp[0 * 129], sp[1 * 129]); o.y = pk2(sp[2 * 129], sp[3 * 129]); o.z = pk2(sp[4 * 129], sp[5 * 129]); o.w = pk2(sp[6 * 129], sp[7 * 129]);
        *(u32x4*)(WT + (size_t)(n0 + n) * ldt + k0 + 8 * c) = o; }
    LDS_WAIT();
}

__global__ void __launch_bounds__(512, 2) fwd_kernel(Args args) {
    extern __shared__ __attribute__((aligned(16))) unsigned char lds[];
    const int tid = threadIdx.x, lane = tid & 63, wave = __builtin_amdgcn_readfirstlane(tid >> 6);
    const int G = gridDim.x, bx = blockIdx.x;
    const int vcu = (G % 8 == 0) ? (bx % 8) * (G / 8) + bx / 8 : bx;
    const int gw = vcu * 8 + wave, NGW = G * 8;
    unsigned char* ws = args.ws;
    const float* x = args.in[0]; const float* cvec = args.in[1]; const float* ctx = args.in[2]; const float* c_ctx = args.in[3];
    const float* w_mod = args.in[4]; const float* b_mod = args.in[5]; const float* norm1_g = args.in[6]; const float* w_in = args.in[7];
    const float* q_norm_g = args.in[8]; const float* kv_norm_g = args.in[9]; const float* w_uq = args.in[10]; const float* w_ukv = args.in[11];
    const float* qk_norm_q = args.in[12]; const float* qk_norm_k = args.in[13]; const float* sgu_norm_g = args.in[14]; const float* sgu_norm_b = args.in[15];
    const float* w_spatial = args.in[16]; const float* b_spatial = args.in[17]; const float* w_br_attn = args.in[18]; const float* w_br_sgu = args.in[19];
    const float* w_out = args.in[20]; const float* norm2_g = args.in[21]; const float* w_ffn_in = args.in[22]; const float* w_ffn_out = args.in[23];
    float* out = args.out;
    float* MOD = (float*)(ws + WS_MOD);
    bf16_t* WIN = (bf16_t*)(ws + WS_WIN); bf16_t* WUQ = (bf16_t*)(ws + WS_WUQ); bf16_t* WUKV = (bf16_t*)(ws + WS_WUKV);
    bf16_t* WBR = (bf16_t*)(ws + WS_WBRA); bf16_t* WOUT = (bf16_t*)(ws + WS_WOUT);
    bf16_t* WFI = (bf16_t*)(ws + WS_WFI); bf16_t* WFO = (bf16_t*)(ws + WS_WFO); bf16_t* WSP = (bf16_t*)(ws + WS_WSP);
    bf16_t* H = (bf16_t*)(ws + WS_H); bf16_t* KVUP = H; bf16_t* AO = H; bf16_t* H2 = H;
    bf16_t* P = (bf16_t*)(ws + WS_P); bf16_t* XN = P; bf16_t* ACT = (bf16_t*)(ws + WS_P + 64 * MiB);
    bf16_t* KF = (bf16_t*)(ws + WS_KF); bf16_t* VF = (bf16_t*)(ws + WS_VF); bf16_t* MERGED = (bf16_t*)(ws + WS_MERGED);
    bf16_t* QUP = (bf16_t*)out; bf16_t* QF = (bf16_t*)((unsigned char*)out + DO_QF);
    const int lo = args.ph_lo, hi = args.ph_hi;
#ifndef PH_MASK
#define PH_MASK 0x7ff
#endif
#define IN(k) ((((PH_MASK) >> (k)) & 1) && lo <= (k) && (k) < hi)
#ifndef PROBE_DUP
#define PROBE_DUP 0
#endif
#define REPS(k) ((((PROBE_DUP) >> (k)) & 1) ? 2 : 1)
#ifdef PROBE_SPIN
    unsigned long long pt0_ = 0;
#define PH_START(k) do { if ((k) == PROBE_SPIN) pt0_ = __builtin_amdgcn_s_memrealtime(); } while (0)
#define PH_END(k) do { if ((k) == PROBE_SPIN) { const unsigned long long t1_ = __builtin_amdgcn_s_memrealtime(), d_ = 4 * (t1_ - pt0_); while (__builtin_amdgcn_s_memrealtime() - t1_ < d_) __builtin_amdgcn_s_sleep(8); } } while (0)
#else
#define PH_START(k) do {} while (0)
#define PH_END(k) do {} while (0)
#endif
#if !MK_LAUNCH_PER_PHASE && !defined(PROBE_SPLIT) && !defined(MK_CG_SYNC)
    volatile LAS unsigned* barst = (volatile LAS unsigned*)((LAS unsigned char*)lds + LDS_BARST);
    if (tid < 2) barst[tid] = 0u;
    __syncthreads();
    const XcdBarrier gbar = xcd_barrier_post((unsigned*)(ws + WS_BAR), barst);
    if (args.ph_lo < 0) cg::this_grid().sync();
#define SEAM(k) do { PH_END(k); if (IN(k) && IN((k) + 1)) { xcd_barrier(gbar); } } while (0)
#else
#define SEAM(k) do { PH_END(k); if (IN(k) && IN((k) + 1)) { cg::this_grid().sync(); } } while (0)
#endif

    if (IN(0)) for (int rep_ = 0; rep_ < REPS(0); ++rep_) { if (rep_) cg::this_grid().sync(); PH_START(0);
        LAS float* sact = (LAS float*)lds;
        LAS float* red = (LAS float*)(lds + 40960);
        for (int i = tid; i < 5 * DM; i += 512) { const float v = (i < 4 * DM) ? cvec[i] : c_ctx[i - 4 * DM]; sact[i] = v / (1.0f + __expf(-v)); }
        __syncthreads();
        for (int cb = bx; cb < NMOD / 48; cb += G) {
            const int n0 = cb * 48, c4 = tid % 12, kg = tid / 12;
            if (kg < 42) {
                f32x4 a[5];
#pragma unroll
                for (int r = 0; r < 5; ++r) a[r] = (f32x4){0.f, 0.f, 0.f, 0.f};
                for (int k0 = kg; k0 < DM; k0 += 42 * 7) {
                    f32x4 w[7];
#pragma unroll
                    for (int u = 0; u < 7; ++u) { const int k = k0 + 42 * u; w[u] = (k < DM) ? *(const f32x4*)(w_mod + (size_t)k * NMOD + n0 + c4 * 4) : (f32x4){0.f, 0.f, 0.f, 0.f}; }
#pragma unroll
                    for (int u = 0; u < 7; ++u) { const int k = (k0 + 42 * u < DM) ? k0 + 42 * u : 0;
#pragma unroll
                        for (int r = 0; r < 5; ++r) a[r] += w[u] * sact[r * DM + k]; } }
#pragma unroll
                for (int r = 0; r < 5; ++r)
#pragma unroll
                    for (int j = 0; j < 4; ++j) red[(kg * 5 + r) * 48 + c4 * 4 + j] = a[r][j];
            }
            __syncthreads();
            if (tid < 240) { const int r = tid / 48, col = tid % 48; float s = 0.f;
                for (int k2 = 0; k2 < 42; ++k2) s += red[(k2 * 5 + r) * 48 + col];
                MOD[(size_t)r * NMOD + n0 + col] = s + b_mod[n0 + col]; }
            __syncthreads();
        }
        LAS float* scr = (LAS float*)(lds + wave * 16512);
        constexpr int I_IN = 64 * 56, I_UQ = 16 * 12, I_UKV = 8 * 16;
        constexpr int NEARLY = I_IN + I_UQ + I_UKV;
        for (int it = gw; it < NEARLY; it += NGW) {
            int r = it;
            if (r < I_IN) { tr_item<1>(w_in, IN_COLS, (r / 56) * 32, (r % 56) * 128, WIN, DM, nullptr, scr, lane); continue; } r -= I_IN;
            if (r < I_UQ) { tr_item<3>(w_uq, NH * QKD, (r / 12) * 32, (r % 12) * 128, WUQ, QL, q_norm_g, scr, lane); continue; } r -= I_UQ;
            tr_item<0>(w_ukv, 2048, (r / 16) * 32, (r % 16) * 128, WUKV, KVL, kv_norm_g, scr, lane);
        }
        for (int i = (bx * 512 + tid); i < 8 * 128 * 128 / 2; i += G * 512) { const f32x2 v = *(const f32x2*)(w_spatial + 2 * (size_t)i); ((unsigned*)WSP)[i] = pk2(v.x, v.y); }
    }
    SEAM(0);

    if (IN(1)) for (int rep_ = 0; rep_ < REPS(1); ++rep_) { if (rep_) cg::this_grid().sync(); PH_START(1);
        for (int row = gw; row < MROWS; row += NGW) {
            const float* src = row < NTOK ? x + (size_t)row * DM : ctx + (size_t)(row - NTOK) * DM;
            const int b = row < NTOK ? row / SEQ : 4;
            const float* sh = MOD + (size_t)b * NMOD; const float* scp = sh + DM;
            f32x4 v[8]; float ss = 0.f;
#pragma unroll
            for (int j = 0; j < 8; ++j) { v[j] = __builtin_nontemporal_load((const f32x4*)(src + (lane + 64 * j) * 4)); ss += (v[j].x * v[j].x + v[j].y * v[j].y) + (v[j].z * v[j].z + v[j].w * v[j].w); }
            const float r = 1.0f / sqrtf(wave_sum(ss) * (1.0f / DM) + EPS);
#pragma unroll
            for (int j = 0; j < 8; ++j) { const int idx = (lane + 64 * j) * 4; const f32x4 g = *(const f32x4*)(norm1_g + idx), s1 = *(const f32x4*)(scp + idx), s0 = *(const f32x4*)(sh + idx);
                const f32x4 o = (v[j] * r * g) * (s1 + 1.0f) + s0;
                u32x2 w; w.x = pk2(o.x, o.y); w.y = pk2(o.z, o.w); *(u32x2*)(H + (size_t)row * DM + idx) = w; }
        }
    }
    SEAM(1);

    if (IN(2)) for (int rep_ = 0; rep_ < REPS(2); ++rep_) { if (rep_) cg::this_grid().sync(); PH_START(2);
        pg8::Gemm g{H, WIN, MROWS, PCOLS, DM, DM, DM}; pg8::ProjOrder S; S.init(G, bx);
        pg8::EpiProj E{P, PCOLS, (float*)(ws + WS_RKV)};
        pg8::gemm_phase<pg8::EpiProj, pg8::ProjOrder>((LAS unsigned char*)lds, g, S, E);
        { constexpr int NU = 64 * 28 + 8; const int nlead = NU % G;
          if (bx >= nlead) {
            LAS float* scr = (LAS float*)(lds + wave * 16512);
            constexpr int I_BR = 32 * 16, I_OUT = 64 * 16, I_FI = 64 * 88, I_FO = 176 * 16;
            constexpr int NLATE = 2 * I_BR + I_OUT + I_FI + I_FO;
            const int NW2 = (G - nlead) * 8;
            for (int it = (bx - nlead) * 8 + wave; it < NLATE; it += NW2) {
                int r = it;
                if (r < I_BR) { tr_item<0>(w_br_attn, DM, (r / 16) * 32, (r % 16) * 128, WBR, DM, nullptr, scr, lane); continue; } r -= I_BR;
                if (r < I_BR) { tr_item<0>(w_br_sgu, DM, (r / 16) * 32, (r % 16) * 128, WBR + 1024, DM, nullptr, scr, lane); continue; } r -= I_BR;
                if (r < I_OUT) { tr_item<0>(w_out, DM, (r / 16) * 32, (r % 16) * 128, WOUT, DM, nullptr, scr, lane); continue; } r -= I_OUT;
                if (r < I_FI) { tr_item<2>(w_ffn_in, 2 * DFF, (r / 88) * 32, (r % 88) * 128, WFI, DM, nullptr, scr, lane); continue; } r -= I_FI;
                tr_item<0>(w_ffn_out, DM, (r / 16) * 32, (r % 16) * 128, WFO, DFF, nullptr, scr, lane);
            }
          } }
    }
    SEAM(2);

    if (IN(3)) for (int rep_ = 0; rep_ < REPS(3); ++rep_) { if (rep_) cg::this_grid().sync(); PH_START(3);
        const bool split = (G % 16 == 0);
        for (int pass = 0; pass < (split ? 1 : 2); ++pass) {
            const int sel = split ? ((bx >> 3) & 1) : pass;
            const int Ge = split ? G / 2 : G, ce = split ? ((bx >> 4) * 8 + (bx & 7)) : bx;
            pg8::Gemm g; pg8::EpiKV E;
            if (sel == 0) { g = pg8::Gemm{P, WUQ, NTOK, NH * QKD, QL, PCOLS, QL}; E = pg8::EpiKV{nullptr, QUP, nullptr, 0, NH * QKD}; }
            else { g = pg8::Gemm{P + PC_KV, WUKV, MROWS, 2048, KVL, PCOLS, KVL}; E = pg8::EpiKV{(const float*)(ws + WS_RKV), KVUP, VF, 1, 0}; }
            pg8::StaticOrder S; S.init(g.M, g.N, Ge, ce);
            pg8::gemm_phase<pg8::EpiKV, pg8::StaticOrder>((LAS unsigned char*)lds, g, S, E);
        }
    }
    SEAM(3);

    if (IN(4)) for (int rep_ = 0; rep_ < REPS(4); ++rep_) { if (rep_) cg::this_grid().sync(); PH_START(4);
        LAS float* T = (LAS float*)(lds + wave * 128);
        for (int t = gw; t < MROWS; t += NGW) {
            const bool lat = t < NTOK;
            const bf16_t* Prow = P + (size_t)t * PCOLS;
            int b, n, m;
            if (lat) { b = t / SEQ; n = t % SEQ; m = n; } else { const int tc = t - NTOK; b = tc / CTXL; n = 0; m = SEQ + tc % CTXL; }
            u32x4 kvw[2];
#pragma unroll
            for (int j = 0; j < 2; ++j) kvw[j] = *(const u32x4*)(KVUP + (size_t)t * 1024 + j * 512 + lane * 8);
            const u32x4 krw = *(const u32x4*)(Prow + PC_KR + (lane & 7) * 8);
            u32x4 qw[3] = {}, qcw = {}, gvw[2] = {};
            if (lat) {
#pragma unroll
                for (int j = 0; j < 3; ++j) qw[j] = *(const u32x4*)(QUP + (size_t)t * (NH * QKD) + j * 512 + lane * 8);
                qcw = *(const u32x4*)(Prow + lane * 8);
#pragma unroll
                for (int j = 0; j < 2; ++j) gvw[j] = *(const u32x4*)(Prow + PC_V + j * 512 + lane * 8);
            }
            const int c = lane & 7; const bool first = (c & 2) == 0;
            float cs[8], sn[8];
#pragma unroll
            for (int e = 0; e < 8; ++e) { cs[e] = 1.f; sn[e] = 0.f; }
            if (lat) { const float pos = (float)((c < 4) ? (n >> 6) : (n & 63));
#pragma unroll
                for (int e = 0; e < 8; ++e) { const int i = (c & 1) * 8 + e; const float freq = exp2f(-(float)i * (13.287712379549449f / 16.0f));
                    float rev = pos * freq * 0.15915494309189535f; rev -= floorf(rev); cs[e] = __builtin_amdgcn_cosf(rev); sn[e] = __builtin_amdgcn_sinf(rev); } }
            float kr[8]; kr[0] = bflo(krw.x); kr[1] = bfhi(krw.x); kr[2] = bflo(krw.y); kr[3] = bfhi(krw.y); kr[4] = bflo(krw.z); kr[5] = bfhi(krw.z); kr[6] = bflo(krw.w); kr[7] = bfhi(krw.w);
            float ss_r = 0.f;
#pragma unroll
            for (int e = 0; e < 8; ++e) ss_r += kr[e] * kr[e];
            ss_r = sum8(ss_r);
            const int d8 = (lane & 15) * 8;
#pragma unroll
            for (int j = 0; j < 2; ++j) {
                float f[8]; f[0] = bflo(kvw[j].x); f[1] = bfhi(kvw[j].x); f[2] = bflo(kvw[j].y); f[3] = bfhi(kvw[j].y); f[4] = bflo(kvw[j].z); f[5] = bfhi(kvw[j].z); f[6] = bflo(kvw[j].w); f[7] = bfhi(kvw[j].w);
                float ssn = 0.f;
#pragma unroll
                for (int e = 0; e < 8; ++e) ssn += f[e] * f[e];
                ssn = sum16(ssn);
                const int h = 4 * j + (lane >> 4);
                const float rn = 1.0f / sqrtf((ssn + ss_r) * (1.0f / QKD) + EPS);
                if ((lane & 15) == 0) T[h] = rn;
                float ov[8];
#pragma unroll
                for (int e = 0; e < 8; ++e) ov[e] = f[e] * rn * qk_norm_k[d8 + e];
                u32x4 w; w.x = pk2(ov[0], ov[1]); w.y = pk2(ov[2], ov[3]); w.z = pk2(ov[4], ov[5]); w.w = pk2(ov[6], ov[7]);
                *(u32x4*)(KF + ((size_t)(b * NH + h) * SKV + m) * QKD + d8) = w;
            }
            LDS_WAIT();
            { const int h = lane >> 3; const float rn = T[h];
              float f[8];
#pragma unroll
              for (int e = 0; e < 8; ++e) f[e] = kr[e] * rn * qk_norm_k[128 + c * 8 + e];
              if (lat) {
#pragma unroll
                  for (int e = 0; e < 8; ++e) { const float pr = dppf<DPP_XOR2>(f[e]); f[e] = first ? f[e] * cs[e] - pr * sn[e] : f[e] * cs[e] + pr * sn[e]; } }
              u32x4 w; w.x = pk2(f[0], f[1]); w.y = pk2(f[2], f[3]); w.z = pk2(f[4], f[5]); w.w = pk2(f[6], f[7]);
              *(u32x4*)(KF + ((size_t)(b * NH + h) * SKV + m) * QKD + 128 + c * 8) = w; }
            if (lat) {
                float r_q;
                { float s2 = 0.f;
                  s2 += bflo(qcw.x) * bflo(qcw.x) + bfhi(qcw.x) * bfhi(qcw.x); s2 += bflo(qcw.y) * bflo(qcw.y) + bfhi(qcw.y) * bfhi(qcw.y);
                  s2 += bflo(qcw.z) * bflo(qcw.z) + bfhi(qcw.z) * bfhi(qcw.z); s2 += bflo(qcw.w) * bflo(qcw.w) + bfhi(qcw.w) * bfhi(qcw.w);
                  r_q = 1.0f / sqrtf(wave_sum(s2) * (1.0f / QL) + EPS); }
                float qf[3][8];
#pragma unroll
                for (int j = 0; j < 3; ++j) { qf[j][0] = bflo(qw[j].x); qf[j][1] = bfhi(qw[j].x); qf[j][2] = bflo(qw[j].y); qf[j][3] = bfhi(qw[j].y); qf[j][4] = bflo(qw[j].z); qf[j][5] = bfhi(qw[j].z); qf[j][6] = bflo(qw[j].w); qf[j][7] = bfhi(qw[j].w); }
#pragma unroll
                for (int j = 0; j < 3; ++j) { float sq = 0.f;
#pragma unroll
                    for (int e = 0; e < 8; ++e) { qf[j][e] *= r_q; sq += qf[j][e] * qf[j][e]; }
                    sq = sum8(sq);
                    if (j < 2) { sq += dppf<DPP_MIR>(sq); if ((lane & 15) == 0) T[8 + 4 * j + (lane >> 4)] = sq; }
                    else { if ((lane & 7) == 0) T[16 + (lane >> 3)] = sq; } }
                LDS_WAIT();
#pragma unroll
                for (int j = 0; j < 2; ++j) { const int h = 4 * j + (lane >> 4);
                    const float rn = 1.0f / sqrtf((T[8 + h] + T[16 + h]) * (1.0f / QKD) + EPS);
                    float ov[8];
#pragma unroll
                    for (int e = 0; e < 8; ++e) ov[e] = qf[j][e] * rn * qk_norm_q[d8 + e];
                    u32x4 w; w.x = pk2(ov[0], ov[1]); w.y = pk2(ov[2], ov[3]); w.z = pk2(ov[4], ov[5]); w.w = pk2(ov[6], ov[7]);
                    *(u32x4*)(QF + ((size_t)(b * NH + h) * SEQ + n) * QKD + d8) = w; }
                { const int h = lane >> 3;
                  const float rn = 1.0f / sqrtf((T[8 + h] + T[16 + h]) * (1.0f / QKD) + EPS);
                  float f[8];
#pragma unroll
                  for (int e = 0; e < 8; ++e) f[e] = qf[2][e] * rn * qk_norm_q[128 + c * 8 + e];
#pragma unroll
                  for (int e = 0; e < 8; ++e) { const float pr = dppf<DPP_XOR2>(f[e]); f[e] = first ? f[e] * cs[e] - pr * sn[e] : f[e] * cs[e] + pr * sn[e]; }
                  u32x4 w; w.x = pk2(f[0], f[1]); w.y = pk2(f[2], f[3]); w.z = pk2(f[4], f[5]); w.w = pk2(f[6], f[7]);
                  *(u32x4*)(QF + ((size_t)(b * NH + h) * SEQ + n) * QKD + 128 + c * 8) = w; }
                LDS_WAIT();
                bf16_t* vp = (bf16_t*)Prow + PC_V;
                float f[16]; float s = 0.f;
#pragma unroll
                for (int j = 0; j < 2; ++j) { const u32x4 w = gvw[j];
                    f[j * 8 + 0] = bflo(w.x); f[j * 8 + 1] = bfhi(w.x); f[j * 8 + 2] = bflo(w.y); f[j * 8 + 3] = bfhi(w.y);
                    f[j * 8 + 4] = bflo(w.z); f[j * 8 + 5] = bfhi(w.z); f[j * 8 + 6] = bflo(w.w); f[j * 8 + 7] = bfhi(w.w); }
#pragma unroll
                for (int j = 0; j < 16; ++j) s += f[j];
                const float mu = wave_sum(s) * (1.0f / 1024.0f); float q = 0.f;
#pragma unroll
                for (int j = 0; j < 16; ++j) { f[j] -= mu; q += f[j] * f[j]; }
                const float rstd = 1.0f / sqrtf(wave_sum(q) * (1.0f / 1024.0f) + EPS);
#pragma unroll
                for (int j = 0; j < 2; ++j) { const int c0 = j * 512 + lane * 8; float o[8];
#pragma unroll
                    for (int e = 0; e < 8; ++e) o[e] = f[j * 8 + e] * rstd * sgu_norm_g[c0 + e] + sgu_norm_b[c0 + e];
                    u32x4 w; w.x = pk2(o[0], o[1]); w.y = pk2(o[2], o[3]); w.z = pk2(o[4], o[5]); w.w = pk2(o[6], o[7]);
                    *(u32x4*)(vp + c0) = w; }
            }
        }
    }
    SEAM(4);

    if (IN(5)) for (int rep_ = 0; rep_ < REPS(5); ++rep_) { if (rep_) cg::this_grid().sync(); PH_START(5);
        PH_START(12);
        {
            const int r32 = lane & 31, hi = lane >> 5, ib = wave & 3, chh = wave >> 2;
            LAS unsigned char* ldsl = (LAS unsigned char*)lds;
            const int vbw = (int)(uintptr_t)(char*)lds + att::v_rd_base(lane) + chh * 1024;
#define SGU_DMA(un_, slot_) do { const int ck_ = (un_) >> 3, g_ = (un_) & 7; const char* src_ = (const char*)(P + (size_t)ck_ * 128 * PCOLS + PC_V + g_ * 128); \
    _Pragma("unroll") for (int hb_ = 0; hb_ < 2; ++hb_) _Pragma("unroll") for (int i_ = 0; i_ < 2; ++i_) { const int p_ = i_ * 512 + tid, st_ = p_ >> 5, wi_ = p_ & 31, kk_ = (st_ >> 2) * 8 + (wi_ >> 2), c_ = (st_ & 3) * 32 + (wi_ & 3) * 8; \
        const int k_ = (kk_ & ~0xC) | ((kk_ & 4) << 1) | ((kk_ & 8) >> 1); const size_t vo_ = (size_t)(hb_ * 64 + k_) * (PCOLS * 2) + c_ * 2; \
        __builtin_amdgcn_global_load_lds((const unsigned*)(src_ + vo_), (LAS unsigned*)(ldsl + (slot_) * 32768 + hb_ * 16384 + i_ * 8192 + wave * 1024), 16, 0, 0); } } while (0)
#define SGU_AF(dst, un_) do { const int g_ = (un_) & 7; _Pragma("unroll") for (int ks_ = 0; ks_ < 8; ++ks_) dst[ks_] = *(const bf16x8*)(WSP + ((size_t)g_ * 128 + ib * 32 + r32) * 128 + ks_ * 16 + hi * 8); } while (0)
            bf16x8 af[8], afn[8];
            int un = vcu, slot = 0;
            if (un < 1024) { SGU_DMA(un, 0); SGU_AF(af, un); }
            for (; un < 1024; un += G, slot ^= 1) {
                const int ck = un >> 3, g = un & 7; const size_t t0 = (size_t)ck * 128;
                asm volatile("s_waitcnt vmcnt(0)" ::: "memory"); __syncthreads();
                const int un2 = un + G;
                if (un2 < 1024) { SGU_DMA(un2, slot ^ 1); SGU_AF(afn, un2); }
                f32x4 bsv[4];
#pragma unroll
                for (int q = 0; q < 4; ++q) bsv[q] = *(const f32x4*)(b_spatial + g * 128 + ib * 32 + 8 * q + 4 * hi);
                unsigned short uu[2][16];
#pragma unroll
                for (int d = 0; d < 2; ++d)
#pragma unroll
                    for (int r = 0; r < 16; ++r) uu[d][r] = P[(t0 + ib * 32 + att::crow(r, hi)) * PCOLS + PC_U + g * 128 + (2 * chh + d) * 32 + r32];
                f32x16 acc0 = {}, acc1 = {};
                const int vb = vbw + slot * 32768;
#define SGU_STEP(KS) do { const int vbk_ = vb + ((KS) >> 2) * 16384; \
    const s16x4 l0_ = att::tr_read<att::v_rd_off(0, (KS) & 3, 0)>(vbk_), h0_ = att::tr_read<att::v_rd_off(0, (KS) & 3, 1)>(vbk_), l1_ = att::tr_read<att::v_rd_off(1, (KS) & 3, 0)>(vbk_), h1_ = att::tr_read<att::v_rd_off(1, (KS) & 3, 1)>(vbk_); \
    asm volatile("s_waitcnt lgkmcnt(0)" ::: "memory"); __builtin_amdgcn_sched_barrier(0); \
    acc0 = __builtin_amdgcn_mfma_f32_32x32x16_bf16(af[KS], (bf16x8){l0_[0], l0_[1], l0_[2], l0_[3], h0_[0], h0_[1], h0_[2], h0_[3]}, acc0, 0, 0, 0); \
    acc1 = __builtin_amdgcn_mfma_f32_32x32x16_bf16(af[KS], (bf16x8){l1_[0], l1_[1], l1_[2], l1_[3], h1_[0], h1_[1], h1_[2], h1_[3]}, acc1, 0, 0, 0); } while (0)
                SGU_STEP(0); SGU_STEP(1); SGU_STEP(2); SGU_STEP(3); SGU_STEP(4); SGU_STEP(5); SGU_STEP(6); SGU_STEP(7);
#undef SGU_STEP
#pragma unroll
                for (int r = 0; r < 16; ++r) { const size_t t = t0 + ib * 32 + att::crow(r, hi); const int c = g * 128 + (2 * chh) * 32 + r32; const float bsr = bsv[r >> 2][r & 3];
                    AO[t * DM + 1024 + c] = (bf16_t)f2bf(bf2f(uu[0][r]) * (acc0[r] + bsr));
                    AO[t * DM + 1024 + c + 32] = (bf16_t)f2bf(bf2f(uu[1][r]) * (acc1[r] + bsr)); }
                if (un2 < 1024) {
#pragma unroll
                    for (int ks = 0; ks < 8; ++ks) af[ks] = afn[ks]; }
            }
            __syncthreads();
#undef SGU_DMA
#undef SGU_AF
        }
        PH_END(12);
        att::attn_offsets_init((char*)lds);
        for (int un = vcu; un < NB * NH * (SEQ / 256); un += G) {
            const int bh = un >> 4, qb = un & 15, b = bh >> 3, h = bh & 7;
            att::attn_unit(QF + ((size_t)bh * SEQ + qb * 256) * QKD, KF + (size_t)bh * SKV * QKD, VF + (size_t)bh * SKV * VD,
                           AO + ((size_t)b * SEQ + qb * 256) * DM + h * VD, (char*)lds, (LAS unsigned char*)lds);
        }
    }
    SEAM(5);

    if (IN(6)) for (int rep_ = 0; rep_ < REPS(6); ++rep_) { if (rep_) cg::this_grid().sync(); PH_START(6);
        pg8::Gemm g{AO, WBR, NTOK, DM, DM, DM, DM}; pg8::StaticOrder S; S.init(NTOK, DM, G, bx);
        pg8::EpiMerge E{(const unsigned char*)P + 2 * PC_GA, (const unsigned char*)P + 2 * PC_GA + 2048, 2 * PCOLS, MERGED};
        pg8::gemm_phase<pg8::EpiMerge, pg8::StaticOrder>((LAS unsigned char*)lds, g, S, E);
    }
    SEAM(6);

    if (IN(7)) for (int rep_ = 0; rep_ < REPS(7); ++rep_) { if (rep_) cg::this_grid().sync(); PH_START(7);
        pg8::Gemm g{MERGED, WOUT, NTOK, DM, DM, DM, DM}; pg8::StaticOrder S; S.init(NTOK, DM, G, bx);
        pg8::EpiResToBf16 E{x, XN, MOD + 2 * DM};
        pg8::gemm_phase<pg8::EpiResToBf16, pg8::StaticOrder>((LAS unsigned char*)lds, g, S, E);
    }
    SEAM(7);

    if (IN(8)) for (int rep_ = 0; rep_ < REPS(8); ++rep_) { if (rep_) cg::this_grid().sync(); PH_START(8);
        for (int row = gw; row < NTOK; row += NGW) {
            const bf16_t* src = XN + (size_t)row * DM; const int b = row / SEQ;
            const float* sh = MOD + (size_t)b * NMOD + 3 * DM; const float* scp = sh + DM;
            float v[4][8]; float ss = 0.f;
#pragma unroll
            for (int j = 0; j < 4; ++j) { const u32x4 w = *(const u32x4*)(src + (lane + 64 * j) * 8);
                v[j][0] = bflo(w.x); v[j][1] = bfhi(w.x); v[j][2] = bflo(w.y); v[j][3] = bfhi(w.y); v[j][4] = bflo(w.z); v[j][5] = bfhi(w.z); v[j][6] = bflo(w.w); v[j][7] = bfhi(w.w);
#pragma unroll
                for (int e = 0; e < 8; ++e) ss += v[j][e] * v[j][e]; }
            const float r = 1.0f / sqrtf(wave_sum(ss) * (1.0f / DM) + EPS);
#pragma unroll
            for (int j = 0; j < 4; ++j) { const int idx = (lane + 64 * j) * 8; float o[8];
#pragma unroll
                for (int h2 = 0; h2 < 2; ++h2) { const f32x4 g = *(const f32x4*)(norm2_g + idx + 4 * h2), s1 = *(const f32x4*)(scp + idx + 4 * h2), s0 = *(const f32x4*)(sh + idx + 4 * h2);
#pragma unroll
                    for (int e = 0; e < 4; ++e) o[4 * h2 + e] = (v[j][4 * h2 + e] * r * g[e]) * (s1[e] + 1.0f) + s0[e]; }
                u32x4 w; w.x = pk2(o[0], o[1]); w.y = pk2(o[2], o[3]); w.z = pk2(o[4], o[5]); w.w = pk2(o[6], o[7]); *(u32x4*)(H2 + (size_t)row * DM + idx) = w; }
        }
    }
    SEAM(8);

    if (IN(9)) for (int rep_ = 0; rep_ < REPS(9); ++rep_) { if (rep_) cg::this_grid().sync(); PH_START(9);
        pg8::Gemm g{H2, WFI, NTOK, 2 * DFF, DM, DM, DM}; pg8::StaticOrder S; S.init(NTOK, 2 * DFF, G, bx);
        pg8::EpiFfnIn E{ACT};
        pg8::gemm_phase<pg8::EpiFfnIn, pg8::StaticOrder>((LAS unsigned char*)lds, g, S, E);
    }
    SEAM(9);

    if (IN(10)) for (int rep_ = 0; rep_ < REPS(10); ++rep_) { if (rep_) cg::this_grid().sync(); PH_START(10);
        pg8::Gemm g{ACT, WFO, NTOK, DM, DFF, DFF, DFF}; pg8::StaticOrder S; S.init(NTOK, DM, G, bx);
        pg8::EpiResFromBf16 E{XN, out, MOD + 5 * DM};
        pg8::gemm_phase<pg8::EpiResFromBf16, pg8::StaticOrder>((LAS unsigned char*)lds, g, S, E);
    }
#undef IN
#undef SEAM
}

constexpr int N_PHASES = 11;

extern "C" void kernel_launch(void* const* d_in, const int* in_sizes, int n_in, void* d_out, int out_size, void* d_ws, size_t ws_size, hipStream_t stream) {
    static int grid = 0;
    if (grid == 0) {
        if (n_in != 24 || out_size != NTOK * DM || ws_size < WS_END) { fprintf(stderr, "kernel_launch: unexpected shapes n_in %d out %d ws %zu\n", n_in, out_size, ws_size); grid = -1; return; }
        int dev = 0, cus = 0, per_cu = 0;
        (void)hipGetDevice(&dev); (void)hipDeviceGetAttribute(&cus, hipDeviceAttributeMultiprocessorCount, dev);
        if (hipFuncSetAttribute((const void*)fwd_kernel, hipFuncAttributeMaxDynamicSharedMemorySize, LDS_BYTES) != hipSuccess) { fprintf(stderr, "kernel_launch: hipFuncSetAttribute failed\n"); grid = -1; return; }
        if (hipOccupancyMaxActiveBlocksPerMultiprocessor(&per_cu, (const void*)fwd_kernel, 512, LDS_BYTES) != hipSuccess || per_cu < 1) { fprintf(stderr, "kernel_launch: occupancy query says %d\n", per_cu); per_cu = 1; }
        (void)hipGetLastError();
        grid = cus * per_cu;
    }
    if (grid < 0) return;
    Args a{};
    for (int i = 0; i < 24; ++i) a.in[i] = (const float*)d_in[i];
    a.out = (float*)d_out; a.ws = (unsigned char*)d_ws;
#if MK_LAUNCH_PER_PHASE
    for (int p = 0; p < N_PHASES; ++p) { a.ph_lo = p; a.ph_hi = p + 1;
        hipLaunchKernelGGL(fwd_kernel, dim3(grid), dim3(512), LDS_BYTES, stream, a); }
#else
#ifndef PROBE_SPLIT
    (void)hipMemsetAsync((char*)d_ws + WS_BAR, 0, XCD_BAR_WORDS * 4, stream);
    a.ph_lo = 0; a.ph_hi = N_PHASES;
    void* kargs[] = {&a};
    hipError_t e = hipLaunchCooperativeKernel((const void*)fwd_kernel, dim3(grid), dim3(512), kargs, LDS_BYTES, stream);
    if (e != hipSuccess) fprintf(stderr, "cooperative launch failed: %s (grid %d)\n", hipGetErrorString(e), grid);
#else
    void* kargs[] = {&a};
    a.ph_lo = 0; a.ph_hi = PROBE_SPLIT + 1;
    (void)hipLaunchCooperativeKernel((const void*)fwd_kernel, dim3(grid), dim3(512), kargs, LDS_BYTES, stream);
    a.ph_lo = PROBE_SPLIT; a.ph_hi = N_PHASES;
    (void)hipLaunchCooperativeKernel((const void*)fwd_kernel, dim3(grid), dim3(512), kargs, LDS_BYTES, stream);
#endif
#endif
}
```
